# Optimizing an MI355X kernel written in HIP

```python
import jax, jax.numpy as jnp
from jax import lax
import numpy as np

D_MODEL = 1024
BATCH = 8
SEQ = 2048
DEPTH = 4

MIX_WIDTH = D_MODEL
POOL_WIDTH = MIX_WIDTH // 4
POOL_WINDOWS = (2, 4, 8, 16)
POOL_GROUPS = len(POOL_WINDOWS)
POOL_GROUP_DIM = POOL_WIDTH // POOL_GROUPS
HEAD_DIM = 64
ATTN_WIDTH = MIX_WIDTH - POOL_WIDTH
N_HEADS = ATTN_WIDTH // HEAD_DIM
DILATED_PATTERNS = ((128, 1), (512, 4), (2048, 16))
ROPE_THETA = 500000.0
ROPE_DIM = HEAD_DIM // 4
D_FF = 2816
IN_PROJ_WIDTH = POOL_WIDTH + 3 * ATTN_WIDTH
NORM_EPS = 1e-6
MASK_VALUE = -1e30

kernel_name = "hybrid_pool_dilated_attn_macaron_encoder"


def rmsnorm(x, g):
    xf = x.astype(jnp.float32)
    y = xf * lax.rsqrt(jnp.mean(xf * xf, axis=-1, keepdims=True) + NORM_EPS)
    return (y * g.astype(jnp.float32)).astype(x.dtype)


def swiglu(h, w_gate, w_up, w_down):
    return (jax.nn.silu(h @ w_gate) * (h @ w_up)) @ w_down


def rope_tables(positions):
    inv_freq = ROPE_THETA ** (-jnp.arange(0, ROPE_DIM, 2, dtype=jnp.float32) / ROPE_DIM)
    ang = positions.astype(jnp.float32)[..., None] * inv_freq
    return jnp.cos(ang)[:, :, None, :], jnp.sin(ang)[:, :, None, :]


def apply_partial_rope(t, cos, sin):
    tf = t.astype(jnp.float32)
    half = ROPE_DIM // 2
    t1, t2, rest = tf[..., :half], tf[..., half:ROPE_DIM], tf[..., ROPE_DIM:]
    rot = jnp.concatenate([t1 * cos - t2 * sin, t2 * cos + t1 * sin, rest], axis=-1)
    return rot.astype(t.dtype)


def multiscale_pool(v, pool_w, pool_scale):
    B, S, _ = v.shape
    vf = v.astype(jnp.float32).reshape(B, S, POOL_GROUPS, POOL_GROUP_DIM)
    cs = jnp.pad(lax.cumsum(vf, axis=1), ((0, 0), (1, 0), (0, 0), (0, 0)))
    pos = jnp.arange(S)
    means = []
    for g, w in enumerate(POOL_WINDOWS):
        lo = jnp.maximum(pos - w // 2, 0)
        hi = jnp.minimum(pos + w - 1 - w // 2, S - 1)
        cnt = (hi - lo + 1).astype(jnp.float32)
        means.append((cs[:, hi + 1, g] - cs[:, lo, g]) / cnt[None, :, None])
    pooled = jnp.stack(means, axis=2)
    diff = (pooled - vf).astype(v.dtype)
    y = jnp.einsum('bsgc,gcd->bsgd', diff, pool_w).reshape(B, S, POOL_WIDTH)
    return y * pool_scale


def dilated_branch(q, k, v, window, dilation):
    B, S, H, Dh = q.shape
    half = window // (2 * dilation)
    blk = half
    L = S // dilation
    nb = -(-L // blk)
    Lp = nb * blk

    def to_compressed(t):
        t = t.astype(jnp.float32).reshape(B, L, dilation, H, Dh)
        return jnp.pad(t, ((0, 0), (0, Lp - L), (0, 0), (0, 0), (0, 0)))

    def band(t):
        tp = jnp.pad(t, ((0, 0), (blk, blk), (0, 0), (0, 0), (0, 0)))
        tp = tp.reshape(B, nb + 2, blk, dilation, H, Dh)
        return jnp.concatenate([tp[:, :-2], tp[:, 1:-1], tp[:, 2:]], axis=2)

    qb = to_compressed(q).reshape(B, nb, blk, dilation, H, Dh)
    kb = band(to_compressed(k))
    vb = band(to_compressed(v))

    t_idx = jnp.arange(nb)[:, None] * blk + jnp.arange(blk)[None, :]
    j_idx = jnp.arange(nb)[:, None] * blk - blk + jnp.arange(3 * blk)[None, :]
    jj = j_idx[:, None, :]
    valid = (jnp.abs(jj - t_idx[:, :, None]) <= half) & (jj >= 0) & (jj < L)

    scale = 1.0 / np.sqrt(Dh)
    s = jnp.einsum('bnqrhd,bnkrhd->bnrhqk', qb, kb) * scale
    s = jnp.where(valid[None, :, None, None], s, MASK_VALUE)
    m = jnp.max(s, axis=-1, keepdims=True)
    p = jnp.exp(s - m)
    denom = jnp.sum(p, axis=-1)
    num = jnp.einsum('bnrhqk,bnkrhd->bnqrhd', p, vb)

    num = num.reshape(B, Lp, dilation, H, Dh)[:, :L].reshape(B, S, H, Dh)

    def stat_back(t):
        t = jnp.transpose(t, (0, 1, 4, 2, 3)).reshape(B, Lp, dilation, H)
        return t[:, :L].reshape(B, S, H)

    return num, stat_back(m[..., 0]), stat_back(denom)


def dilated_mixture_attention(q, k, v):
    branches = [dilated_branch(q, k, v, w, d) for (w, d) in DILATED_PATTERNS]
    m_all = jnp.stack([b[1] for b in branches], axis=0)
    wts = jnp.exp(m_all - jnp.max(m_all, axis=0, keepdims=True))
    num = sum(wts[i][..., None] * branches[i][0] for i in range(len(branches)))
    den = sum(wts[i] * branches[i][2] for i in range(len(branches)))
    return (num / den[..., None]).astype(q.dtype)


def setup_inputs(seed: int = 0) -> dict:
    key = jax.random.key(seed)
    ks = jax.random.split(key, 20)
    f32 = jnp.float32

    def normal(k, shape, fan_in):
        return jax.random.normal(k, shape, f32) * (fan_in ** -0.5)

    def gain(k, shape):
        return jnp.ones(shape, f32) + 0.02 * jax.random.normal(k, shape, f32)

    x = jax.random.normal(ks[0], (BATCH, SEQ, D_MODEL), f32)
    start = jax.random.randint(ks[1], (BATCH, 1), 0, 4096, dtype=jnp.int32)
    positions = start + jnp.arange(SEQ, dtype=jnp.int32)[None, :]
    return {
        "x": x,
        "positions": positions,
        "ffn1_norm": gain(ks[2], (DEPTH, D_MODEL)),
        "ffn1_w_gate": normal(ks[3], (DEPTH, D_MODEL, D_FF), D_MODEL),
        "ffn1_w_up": normal(ks[4], (DEPTH, D_MODEL, D_FF), D_MODEL),
        "ffn1_w_down": normal(ks[5], (DEPTH, D_FF, D_MODEL), D_FF),
        "mix_norm": gain(ks[6], (DEPTH, D_MODEL)),
        "w_in": normal(ks[7], (DEPTH, D_MODEL, IN_PROJ_WIDTH), D_MODEL),
        "pool_w": normal(ks[8], (DEPTH, POOL_GROUPS, POOL_GROUP_DIM, POOL_GROUP_DIM), POOL_GROUP_DIM),
        "pool_scale": gain(ks[9], (DEPTH, POOL_WIDTH)),
        "w_out": normal(ks[10], (DEPTH, MIX_WIDTH, D_MODEL), MIX_WIDTH),
        "ffn2_norm": gain(ks[11], (DEPTH, D_MODEL)),
        "ffn2_w_gate": normal(ks[12], (DEPTH, D_MODEL, D_FF), D_MODEL),
        "ffn2_w_up": normal(ks[13], (DEPTH, D_MODEL, D_FF), D_MODEL),
        "ffn2_w_down": normal(ks[14], (DEPTH, D_FF, D_MODEL), D_FF),
        "final_norm": gain(ks[15], (D_MODEL,)),
    }


def reference(x, positions, ffn1_norm, ffn1_w_gate, ffn1_w_up, ffn1_w_down, mix_norm, w_in,
              pool_w, pool_scale, w_out, ffn2_norm, ffn2_w_gate, ffn2_w_up, ffn2_w_down, final_norm):
    B, S, _ = x.shape
    cos, sin = rope_tables(positions)
    for l in range(DEPTH):
        x = x + 0.5 * swiglu(rmsnorm(x, ffn1_norm[l]), ffn1_w_gate[l], ffn1_w_up[l], ffn1_w_down[l])

        h = rmsnorm(x, mix_norm[l])
        proj = h @ w_in[l]
        v_pool = proj[..., :POOL_WIDTH]
        q = proj[..., POOL_WIDTH:POOL_WIDTH + ATTN_WIDTH].reshape(B, S, N_HEADS, HEAD_DIM)
        k = proj[..., POOL_WIDTH + ATTN_WIDTH:POOL_WIDTH + 2 * ATTN_WIDTH].reshape(B, S, N_HEADS, HEAD_DIM)
        v = proj[..., POOL_WIDTH + 2 * ATTN_WIDTH:].reshape(B, S, N_HEADS, HEAD_DIM)

        y_pool = multiscale_pool(v_pool, pool_w[l], pool_scale[l])
        q = apply_partial_rope(q, cos, sin)
        k = apply_partial_rope(k, cos, sin)
        y_attn = dilated_mixture_attention(q, k, v).reshape(B, S, ATTN_WIDTH)

        mixed = jnp.concatenate([y_pool.astype(x.dtype), y_attn.astype(x.dtype)], axis=-1)
        x = x + mixed @ w_out[l]

        x = x + 0.5 * swiglu(rmsnorm(x, ffn2_norm[l]), ffn2_w_gate[l], ffn2_w_up[l], ffn2_w_down[l])
    return rmsnorm(x, final_norm)
```

```cpp
#include <hip/hip_runtime.h>
#include <hip/hip_cooperative_groups.h>
#include <cstdio>
#include <cstdint>
#include <cmath>
namespace cg = cooperative_groups;
namespace pg8 {
#define PG8_LAS __attribute__((address_space(3)))
typedef unsigned short bf16_t;
typedef short bf16x8 __attribute__((ext_vector_type(8)));
typedef float f32x4 __attribute__((ext_vector_type(4)));
typedef unsigned u32x4 __attribute__((ext_vector_type(4)));
constexpr int BM = 256, BK = 64, HALF = 128, HTB = HALF * BK * 2  , STAGE_BYTES = 8 * HTB, NXCD = 8, WGM = 8;

__host__ __device__ __forceinline__ int lds_byte(int r, int c) { const int st = (r >> 4) * 2 + (c >> 5), rr = r & 15, cc = c & 31, ob = rr * 64 + cc * 2; return st * 1024 + (ob ^ (((ob >> 9) & 1) << 5)); }
__host__ __device__ __forceinline__ void stage_rc(int b, int& R, int& C) { const int st = b / 1024, sb = b % 1024, swz = sb ^ (((sb >> 9) & 1) << 5); R = (st >> 1) * 16 + swz / 64; C = (st & 1) * 32 + (swz % 64) / 2; }
__host__ __device__ __forceinline__ int perm32(int rho) { const int n = rho >> 4, i = rho & 15; return 8 * (i >> 2) + 4 * n + (i & 3); }

struct Unit { int pm, pn, par, roff; };
struct Gemm { const bf16_t* A; const bf16_t* Bt; int M, N, K, nkt; };

struct StaticOrder {
    int nM, nN, nwg, G, c, imax;
    __host__ __device__ void init(int M, int N, int G_, int c_) { nM = M / BM; nN = N / BM; nwg = nM * nN; G = G_; c = c_; imax = 1 << 30; }
    __host__ __device__ void decode(long L, Unit& u) const {
        int wgid = (int)L; { const int q = nwg / NXCD, r = nwg % NXCD, xcd = wgid % NXCD, off = wgid / NXCD; wgid = (xcd < r ? xcd * (q + 1) : r * (q + 1) + (xcd - r) * q) + off; }
        const int nig = WGM * nN, gid = wgid / nig, fm = gid * WGM, gsz = (nM - fm) < WGM ? (nM - fm) : WGM;
        u.pm = fm + ((wgid % nig) % gsz); u.pn = (wgid % nig) / gsz;
    }
    __host__ __device__ bool next(int i, Unit& u) const {
        const long L = (long)i * G + c; if (i >= imax || L >= nwg) return false;
        decode(L, u); u.par = i & 1; u.roff = 0; return true;
    }
    __device__ __forceinline__ void a_ready(const Unit&) const {}
    __device__ __forceinline__ void done(const Unit&) const {}
};
struct HalfOrder : StaticOrder {
    int nfull;
    __host__ __device__ bool next(int i, Unit& u) const {
        if (i != 0) return false;
        const int xcd = c % NXCD, rho = c / NXCD; const long L = ((long)nfull * (G / NXCD) + (rho >> 1)) * NXCD + xcd; if (L >= nwg) return false;
        decode(L, u); u.par = 0; u.roff = 0; return true;
    }
};
__device__ __forceinline__ unsigned cvt_pk_bf16(float lo, float hi) { unsigned r; asm volatile("v_cvt_pk_bf16_f32 %0, %1, %2" : "=v"(r) : "v"(lo), "v"(hi)); return r; }
template <class Epi, class Sched, bool ALIGN_EPI = false, bool SP2 = false, bool HALFM = false>
__device__ __forceinline__ void gemm_phase(PG8_LAS unsigned char* lds, const Gemm g, const Sched& S, const Epi& E) {
    int tid_ = threadIdx.x; asm volatile("" : "+v"(tid_));
    const int tid = tid_, wid = __builtin_amdgcn_readfirstlane(tid >> 6), lane = tid & 63, wr = wid >> 2, wc = wid & 3, fr = lane & 15, fq = lane >> 4;
    static_assert(!HALFM || SP2, "HALFM is written for the SP2 loop");
    const int K = g.K, nt = g.nkt ? g.nkt : K / BK;
    unsigned voffA[2], voffB[2];
#pragma unroll
    for (int i = 0; i < 2; ++i) { int R, C; stage_rc(tid * 16 + i * 8192, R, C); const int Rb = Epi::PERM ? ((R & ~31) + perm32(R & 31)) : R;
        voffA[i] = (unsigned)(R * K + C) * 2u; voffB[i] = (unsigned)(Rb * K + C) * 2u; }
    const size_t kstep = (size_t)(BK * 2);
    const size_t hstep = (size_t)HALF * K * 2;
    const size_t tstep = 2 * hstep;
    const unsigned ldsw = (unsigned)wid * 1024u;
    const int aoff = lds_byte(wr * 64 + fr, fq * 8), boff = lds_byte(wc * 32 + fr, fq * 8);
#define PG8_SA(b, h) (((b) * 2 + (h)) * HTB)
#define PG8_SB(b, h) ((4 + (b) * 2 + (h)) * HTB)
#define PG8_STAGE(bufoff, gbase, voff) do { _Pragma("unroll") for (int _i = 0; _i < 2; ++_i) \
        __builtin_amdgcn_global_load_lds((const unsigned*)((const char*)(gbase) + (voff)[_i]), (PG8_LAS unsigned*)(lds + (bufoff) + ldsw + _i * 8192), 16, 0, 0); } while (0)
#define PG8_LDA(dst, b, h) do { _Pragma("unroll") for (int m = 0; m < 4; ++m) _Pragma("unroll") for (int k = 0; k < 2; ++k) dst[m][k] = *(const PG8_LAS bf16x8*)(lds + PG8_SA(b, h) + aoff + m * 2048 + k * 1024); } while (0)
#define PG8_LDB(dst, b, h) do { _Pragma("unroll") for (int n = 0; n < 2; ++n) _Pragma("unroll") for (int k = 0; k < 2; ++k) dst[n][k] = *(const PG8_LAS bf16x8*)(lds + PG8_SB(b, h) + boff + n * 2048 + k * 1024); } while (0)
#define PG8_MMA(ai, bj, At, Bt) do { __builtin_amdgcn_s_setprio(1); _Pragma("unroll") for (int m = 0; m < 4; ++m) _Pragma("unroll") for (int n = 0; n < 2; ++n) _Pragma("unroll") for (int k = 0; k < 2; ++k) \
        acc[ai][bj][m][n] = __builtin_amdgcn_mfma_f32_16x16x32_bf16(Bt[n][k], At[m][k], acc[ai][bj][m][n], 0, 0, 0); __builtin_amdgcn_s_setprio(0); } while (0)
#define PG8_WAIT_V(n) asm volatile("s_waitcnt vmcnt(" #n ")" ::: "memory")
#define PG8_WAIT_L(n) asm volatile("s_waitcnt lgkmcnt(" #n ")" ::: "memory")
#define PG8_BAR __builtin_amdgcn_s_barrier()
#define PG8_SCHED __builtin_amdgcn_sched_barrier(0)
    Unit cur, nxt; int ui = 0;
    if (!S.next(0, cur)) return;
    f32x4 acc[2][2][4][2];
#pragma unroll
    for (int a = 0; a < 2; ++a)
#pragma unroll
        for (int b = 0; b < 2; ++b)
#pragma unroll
            for (int m = 0; m < 4; ++m)
#pragma unroll
                for (int n = 0; n < 2; ++n) acc[a][b][m][n] = (f32x4){0.f, 0.f, 0.f, 0.f};
    bf16x8 At[4][2], B0[2][2], B1[2][2];
    const char* cA = (const char*)g.A + (size_t)cur.pm * tstep + (size_t)cur.roff * K * 2; const char* cB = (const char*)g.Bt + (size_t)cur.pn * tstep;
    S.a_ready(cur);
    if constexpr (SP2) {
        PG8_STAGE(PG8_SB(0, 0), cB, voffB); PG8_STAGE(PG8_SB(0, 1), cB + hstep, voffB); PG8_STAGE(PG8_SA(0, 0), cA, voffA); PG8_STAGE(PG8_SA(0, 1), cA + hstep, voffA);
        if (wr == 1) PG8_BAR;
        PG8_WAIT_V(2); PG8_BAR;
        PG8_STAGE(PG8_SB(1, 0), cB + kstep, voffB); PG8_STAGE(PG8_SA(1, 0), cA + kstep, voffA); PG8_STAGE(PG8_SB(1, 1), cB + hstep + kstep, voffB);
        PG8_WAIT_V(6); PG8_BAR;
    } else {
        PG8_STAGE(PG8_SB(0, 0), cB, voffB); PG8_STAGE(PG8_SA(0, 0), cA, voffA); PG8_STAGE(PG8_SB(0, 1), cB + hstep, voffB); PG8_STAGE(PG8_SA(0, 1), cA + hstep, voffA);
        if (wr == 1) PG8_BAR;
        PG8_WAIT_V(4); PG8_BAR;
        PG8_STAGE(PG8_SB(1, 0), cB + kstep, voffB); PG8_STAGE(PG8_SA(1, 0), cA + kstep, voffA); PG8_STAGE(PG8_SB(1, 1), cB + hstep + kstep, voffB);
        PG8_WAIT_V(6); PG8_BAR;
    }
    for (;;) {
        const bool has_next = S.next(ui + 1, nxt);
        const char* nA = has_next ? (const char*)g.A + (size_t)nxt.pm * tstep + (size_t)nxt.roff * K * 2 : cA; const char* nB = has_next ? (const char*)g.Bt + (size_t)nxt.pn * tstep : cB;
        for (int t = 0; t < nt; t += 2) {
            const bool last = (t == nt - 2);
            const char* a1 = cA + (size_t)(t + 1) * kstep;
            const char* a2 = last ? nA : cA + (size_t)(t + 2) * kstep; const char* b2 = last ? nB : cB + (size_t)(t + 2) * kstep;
            const char* a3 = a2 + kstep; const char* b3 = b2 + kstep;
            if (last && has_next) S.a_ready(nxt);
            if constexpr (SP2) {
            PG8_LDB(B0, 0, 0); PG8_LDB(B1, 0, 1); PG8_SCHED; PG8_LDA(At, 0, 0); PG8_STAGE(PG8_SA(1, 1), a1 + hstep, voffA);
            PG8_WAIT_V(8); PG8_WAIT_L(0); PG8_BAR; PG8_MMA(0, 0, At, B0); PG8_MMA(0, 1, At, B1); PG8_BAR; PG8_SCHED;
            if constexpr (!HALFM) PG8_LDA(At, 0, 1); PG8_STAGE(PG8_SB(0, 0), b2, voffB); PG8_STAGE(PG8_SB(0, 1), b2 + hstep, voffB); PG8_STAGE(PG8_SA(0, 0), a2, voffA);
            PG8_WAIT_V(8); PG8_WAIT_L(0); PG8_BAR; if constexpr (!HALFM) { PG8_MMA(1, 0, At, B0); PG8_MMA(1, 1, At, B1); } PG8_BAR; PG8_SCHED;
            PG8_LDB(B0, 1, 0); PG8_LDB(B1, 1, 1); PG8_SCHED; PG8_LDA(At, 1, 0); PG8_STAGE(PG8_SA(0, 1), a2 + hstep, voffA);
            PG8_WAIT_V(8); PG8_WAIT_L(0); PG8_BAR; PG8_MMA(0, 0, At, B0); PG8_MMA(0, 1, At, B1); PG8_BAR; PG8_SCHED;
            if constexpr (!HALFM) PG8_LDA(At, 1, 1); PG8_STAGE(PG8_SB(1, 0), b3, voffB); PG8_STAGE(PG8_SB(1, 1), b3 + hstep, voffB); PG8_STAGE(PG8_SA(1, 0), a3, voffA);
            PG8_WAIT_V(8); PG8_WAIT_L(0); PG8_BAR; if constexpr (!HALFM) { PG8_MMA(1, 0, At, B0); PG8_MMA(1, 1, At, B1); } PG8_BAR; PG8_SCHED;
            } else {
            PG8_LDB(B0, 0, 0); PG8_SCHED; PG8_LDA(At, 0, 0); PG8_STAGE(PG8_SA(1, 1), a1 + hstep, voffA);
            PG8_WAIT_L(8); PG8_BAR; PG8_WAIT_L(0); PG8_MMA(0, 0, At, B0); PG8_BAR; PG8_SCHED;
            PG8_LDB(B1, 0, 1); PG8_STAGE(PG8_SB(0, 0), b2, voffB);
            PG8_BAR; PG8_WAIT_L(0); PG8_MMA(0, 1, At, B1); PG8_BAR;
            PG8_LDA(At, 0, 1); PG8_STAGE(PG8_SA(0, 0), a2, voffA);
            PG8_BAR; PG8_WAIT_L(0); PG8_MMA(1, 0, At, B0); PG8_BAR; PG8_SCHED;
            PG8_STAGE(PG8_SB(0, 1), b2 + hstep, voffB);
            PG8_WAIT_V(6); PG8_BAR; PG8_MMA(1, 1, At, B1); PG8_BAR;
            PG8_LDB(B0, 1, 0); PG8_SCHED; PG8_LDA(At, 1, 0); PG8_STAGE(PG8_SA(0, 1), a2 + hstep, voffA);
            PG8_WAIT_L(8); PG8_BAR; PG8_WAIT_L(0); PG8_MMA(0, 0, At, B0); PG8_BAR; PG8_SCHED;
            PG8_LDB(B1, 1, 1); PG8_STAGE(PG8_SB(1, 0), b3, voffB);
            PG8_BAR; PG8_WAIT_L(0); PG8_MMA(0, 1, At, B1); PG8_BAR;
            PG8_LDA(At, 1, 1); PG8_STAGE(PG8_SA(1, 0), a3, voffA);
            PG8_BAR; PG8_WAIT_L(0); PG8_MMA(1, 0, At, B0); PG8_BAR; PG8_SCHED;
            PG8_STAGE(PG8_SB(1, 1), b3 + hstep, voffB);
            PG8_WAIT_V(6); PG8_BAR; PG8_MMA(1, 1, At, B1); PG8_BAR;
            }
        }
        if constexpr (ALIGN_EPI) { if (wr == 0) PG8_BAR; }
        if constexpr (!Epi::AFTER_DRAIN) { E(acc, cur, wr, wc, fr, fq); S.done(cur); }
        if (!has_next) break;
#pragma unroll
        for (int a = 0; a < 2; ++a)
#pragma unroll
            for (int b = 0; b < 2; ++b)
#pragma unroll
                for (int m = 0; m < 4; ++m)
#pragma unroll
                    for (int n = 0; n < 2; ++n) acc[a][b][m][n] = (f32x4){0.f, 0.f, 0.f, 0.f};
        cur = nxt; cA = nA; cB = nB; ++ui;
        if constexpr (ALIGN_EPI) { if (wr == 1) PG8_BAR; }
    }
    PG8_WAIT_V(0);
    if constexpr (!ALIGN_EPI) { if (wr == 0) PG8_BAR; }
    PG8_BAR;
    if constexpr (Epi::AFTER_DRAIN) { E.fused(acc, cur, wr, wc, fr, fq, lds, wid, lane); S.done(cur); }
#undef PG8_SA
#undef PG8_SB
#undef PG8_STAGE
#undef PG8_LDA
#undef PG8_LDB
#undef PG8_MMA
#undef PG8_WAIT_V
#undef PG8_WAIT_L
#undef PG8_BAR
#undef PG8_SCHED
}
}

constexpr int DM = 1024, BATCH = 8, SEQ = 2048, DEPTH = 4, M = BATCH * SEQ;
constexpr int DFF = 2816, NGU = 2 * DFF, NIN = 2560, AW = 768, PWD = 256, NH = 12, HD = 64;
constexpr float NORM_EPS = 1e-6f;
constexpr float QSCALE = 0.125f * 1.4426950408889634f;

#define GAS __attribute__((address_space(1)))
#define LAS __attribute__((address_space(3)))
typedef unsigned short bf16_t;
typedef unsigned u32x4 __attribute__((ext_vector_type(4)));
typedef unsigned u32x2 __attribute__((ext_vector_type(2)));
typedef float f32x4 __attribute__((ext_vector_type(4)));
typedef float f32x16 __attribute__((ext_vector_type(16)));
typedef short bf16x8 __attribute__((ext_vector_type(8)));
typedef short s16x4 __attribute__((ext_vector_type(4)));

constexpr size_t MiB = 1u << 20;
constexpr size_t W_GU = (size_t)NGU * DM * 2, W_D = (size_t)DM * DFF * 2, W_IN = (size_t)NIN * DM * 2, W_OUT = (size_t)DM * DM * 2;
constexpr size_t LW_GU1 = 0, LW_D1 = LW_GU1 + W_GU, LW_IN = LW_D1 + W_D, LW_OUT = LW_IN + W_IN, LW_GU2 = LW_OUT + W_OUT, LW_D2 = LW_GU2 + W_GU, LW_SIZE = LW_D2 + W_D;
static_assert(LW_SIZE == 40 * MiB, "per-layer weight block");
constexpr size_t WS_W = 0;
constexpr size_t WS_XB = 160 * MiB;
constexpr size_t WS_A = 192 * MiB;
__host__ __device__ constexpr size_t off_q(int b) { return WS_A + (size_t)b * 8 * MiB; }
__host__ __device__ constexpr size_t off_vp(int b) { return WS_A + 4 * MiB + (size_t)b * 10 * MiB; }
__host__ __device__ constexpr size_t off_k(int b) { return WS_A + 5 * MiB + (size_t)b * 8 * MiB; }
__host__ __device__ constexpr size_t off_v(int b) { return WS_A + 8 * MiB + (size_t)b * 8 * MiB; }
__host__ __device__ constexpr size_t off_mix(int b) { return WS_A + (size_t)b * 7 * MiB; }
constexpr size_t WS_O = 280 * MiB;
constexpr size_t WS_STAT = 352 * MiB;
constexpr size_t WS_SSQ = 357 * MiB;
constexpr size_t WS_ROPE = 358 * MiB;
constexpr size_t WS_CTL = 359 * MiB, CTL_BYTES = 32768;
constexpr size_t WS_END = 360 * MiB;
static_assert((size_t)M * DFF * 2 <= 88 * MiB && (size_t)3 * M * NH * 2 * 4 <= 5 * MiB, "ws map");

struct Args {
    const float* x; const int* pos;
    const float *n1, *g1, *u1, *d1, *nm, *win, *pw, *ps, *wout, *n2, *g2, *u2, *d2, *nf;
    float* out; unsigned char* ws;
    float inv_freq[8];
    int never, pad;
};

namespace epi {
using pg8::Unit; using pg8::BM; using pg8::HALF;
__device__ __forceinline__ float rinv_of(const float* P, int row) {
    const f32x4* p = (const f32x4*)(P + (size_t)row * 16);
    const f32x4 a = p[0], b = p[1], c = p[2], d = p[3];
    const float s = ((a[0] + a[1]) + (a[2] + a[3])) + ((b[0] + b[1]) + (b[2] + b[3])) + ((c[0] + c[1]) + (c[2] + c[3])) + ((d[0] + d[1]) + (d[2] + d[3]));
    return __builtin_amdgcn_rsqf(s * (1.0f / DM) + NORM_EPS);
}
template <class Base> struct RinvOrder : Base {
    const float* P; LAS float* tab; int pm0;
    __device__ __forceinline__ void a_ready(const Unit& u) const { if (u.pm == pm0) return; int t = threadIdx.x; asm volatile("" : "+v"(t)); if (t < 256 - u.roff) tab[u.par * 256 + t] = rinv_of(P, u.pm * BM + u.roff + t); }
};
__device__ __forceinline__ float silu_mul(float g, float u) {
    const float e = __builtin_amdgcn_exp2f(-1.4426950408889634f * g);
    return g * __builtin_amdgcn_rcpf(1.0f + e) * u;
}
template <int NAI> struct EpiSwiGLU {
    static constexpr bool PERM = true, AFTER_DRAIN = false;
    bf16_t* O; const LAS float* tab;
    __device__ __forceinline__ void operator()(const f32x4 (&acc)[2][2][4][2], const Unit& u, int wr, int wc, int fr, int fq) const {
        const int row0 = u.pm * BM + u.roff + wr * 64 + fr, col0 = u.pn * HALF + wc * 32 + 8 * fq;
#pragma unroll
        for (int ai = 0; ai < NAI; ++ai)
#pragma unroll
            for (int m = 0; m < 4; ++m) {
                const int row = row0 + ai * HALF + m * 16; const float ri = tab[u.par * 256 + ai * HALF + wr * 64 + m * 16 + fr];
                const f32x4 g0 = acc[ai][0][m][0] * ri, g1 = acc[ai][0][m][1] * ri, u0 = acc[ai][1][m][0] * ri, u1 = acc[ai][1][m][1] * ri;
                u32x4 w;
                w.x = pg8::cvt_pk_bf16(silu_mul(g0[0], u0[0]), silu_mul(g0[1], u0[1])); w.y = pg8::cvt_pk_bf16(silu_mul(g0[2], u0[2]), silu_mul(g0[3], u0[3]));
                w.z = pg8::cvt_pk_bf16(silu_mul(g1[0], u1[0]), silu_mul(g1[1], u1[1])); w.w = pg8::cvt_pk_bf16(silu_mul(g1[2], u1[2]), silu_mul(g1[3], u1[3]));
                *(u32x4*)(O + (size_t)row * DFF + col0) = w;
                if (m & 1) asm volatile("" ::: "memory");
            }
    }
};
struct EpiResid {
    static constexpr bool PERM = true, AFTER_DRAIN = false;
    const float* Xin; float* X; bf16_t* XB; float* P; float scale;
    __device__ __forceinline__ void operator()(const f32x4 (&acc)[2][2][4][2], const Unit& u, int wr, int wc, int fr, int fq) const {
        const int row0 = u.pm * BM + wr * 64 + fr, col0 = u.pn * BM + wc * 32 + 8 * fq;
#pragma unroll
        for (int g2 = 0; g2 < 4; ++g2) {
            const int ai = g2 >> 1;
            f32x4 xa[2][2][2];
#pragma unroll
            for (int mm = 0; mm < 2; ++mm)
#pragma unroll
                for (int bj = 0; bj < 2; ++bj) { const float* xp = Xin + (size_t)(row0 + ai * HALF + ((g2 & 1) * 2 + mm) * 16) * DM + col0 + bj * HALF; xa[mm][bj][0] = *(const f32x4*)xp; xa[mm][bj][1] = *(const f32x4*)(xp + 4); }
#pragma unroll
            for (int mm = 0; mm < 2; ++mm) {
                const int m = (g2 & 1) * 2 + mm;
                const int row = row0 + ai * HALF + m * 16; float ss = 0.f;
#pragma unroll
                for (int bj = 0; bj < 2; ++bj) {
                    const f32x4 a = xa[mm][bj][0] + acc[ai][bj][m][0] * scale, b = xa[mm][bj][1] + acc[ai][bj][m][1] * scale;
                    float* xp = X + (size_t)row * DM + col0 + bj * HALF;
                    *(f32x4*)xp = a; *(f32x4*)(xp + 4) = b;
                    u32x4 w; w.x = pg8::cvt_pk_bf16(a[0], a[1]); w.y = pg8::cvt_pk_bf16(a[2], a[3]); w.z = pg8::cvt_pk_bf16(b[0], b[1]); w.w = pg8::cvt_pk_bf16(b[2], b[3]);
                    *(u32x4*)(XB + (size_t)row * DM + col0 + bj * HALF) = w;
                    ss += (a[0] * a[0] + a[1] * a[1]) + (a[2] * a[2] + a[3] * a[3]) + (b[0] * b[0] + b[1] * b[1]) + (b[2] * b[2] + b[3] * b[3]);
                }
                ss += __shfl_xor(ss, 16); ss += __shfl_xor(ss, 32);
                if (fq == 0) P[(size_t)row * 16 + u.pn * 4 + wc] = ss;
            }
            asm volatile("" ::: "memory");
        }
    }
};
template <int NAI> struct EpiProj {
    static constexpr bool PERM = true, AFTER_DRAIN = false;
    bf16_t *VP, *Q, *K, *V; const LAS float* tab; const float* CS;
    __device__ __forceinline__ void operator()(const f32x4 (&acc)[2][2][4][2], const Unit& u, int wr, int wc, int fr, int fq) const {
        const int pn = u.pn;
        bf16_t* dst; int ld, cb;
        if (pn == 0) { dst = VP; ld = PWD; cb = 0; } else if (pn < 4) { dst = Q; ld = AW; cb = (pn - 1) * 256; } else if (pn < 7) { dst = K; ld = AW; cb = (pn - 4) * 256; } else { dst = V; ld = AW; cb = (pn - 7) * 256; }
        const bool ropetile = (pn >= 1 && pn <= 6);
        const bool ropelane = ropetile && !(wc & 1) && (fq < 2);
        const float sgn = (fq == 0) ? -1.f : 1.f;
        const float qs = (pn >= 1 && pn < 4) ? QSCALE : 1.f;
        const int row0 = u.pm * BM + u.roff + wr * 64 + fr, col0 = cb + wc * 32 + 8 * fq;
#pragma unroll
        for (int ai = 0; ai < NAI; ++ai)
#pragma unroll
            for (int m = 0; m < 4; ++m) {
                const int row = row0 + ai * HALF + m * 16; const float ri = tab[u.par * 256 + ai * HALF + wr * 64 + m * 16 + fr];
                f32x4 c0 = {1.f, 1.f, 1.f, 1.f}, c1 = c0, s0 = {0.f, 0.f, 0.f, 0.f}, s1 = s0;
                if (ropelane) { const f32x4* cs = (const f32x4*)(CS + (size_t)row * 16); c0 = cs[0]; c1 = cs[1]; s0 = cs[2]; s1 = cs[3]; }
#pragma unroll
                for (int bj = 0; bj < 2; ++bj) {
                    f32x4 v0 = acc[ai][bj][m][0] * ri, v1 = acc[ai][bj][m][1] * ri;
                    if (ropetile) {
                        f32x4 p0, p1;
#pragma unroll
                        for (int j = 0; j < 4; ++j) { p0[j] = __shfl_xor(v0[j], 16); p1[j] = __shfl_xor(v1[j], 16); }
                        if (ropelane) { v0 = v0 * c0 + p0 * s0 * sgn; v1 = v1 * c1 + p1 * s1 * sgn; }
                    }
                    v0 = v0 * qs; v1 = v1 * qs;
                    u32x4 w; w.x = pg8::cvt_pk_bf16(v0[0], v0[1]); w.y = pg8::cvt_pk_bf16(v0[2], v0[3]); w.z = pg8::cvt_pk_bf16(v1[0], v1[1]); w.w = pg8::cvt_pk_bf16(v1[2], v1[3]);
                    *(u32x4*)(dst + (size_t)row * ld + col0 + bj * HALF) = w;
                }
                if (m & 1) asm volatile("" ::: "memory");
            }
    }
};
}

namespace att {
constexpr int NSLOT = 448, KCS = NSLOT * 16 + 16, VDS = NSLOT * 64 + 64;
constexpr int L_K = 0, L_V = 8 * KCS, L_WS = L_V + 2 * VDS, L_OST = L_WS + 8 * 256, L_END = L_OST + 8 * 4096;
static_assert(L_END <= 149760, "attention LDS");
__device__ __forceinline__ int crow(int r, int hi) { return (r & 3) + 8 * (r >> 2) + 4 * hi; }
__device__ __forceinline__ s16x4 vtr(const LAS unsigned char* p) { return __builtin_bit_cast(s16x4, __builtin_amdgcn_ds_read_tr16_b64_v4i16((LAS s16x4*)p)); }
struct UD { int b, h, br, u; };
__device__ __forceinline__ UD decode(int uidg) { UD x; x.u = uidg & 7; x.br = (uidg >> 3) % 3; const int bh = uidg / 24; x.b = bh / NH; x.h = bh % NH; return x; }

__device__ __forceinline__ void load_kv(u32x4 (&val)[14], const UD& x, const unsigned char* ws, int tid) {
    const int br = x.br, u = x.u, sub = tid & 15, s0 = tid >> 4;
    const bf16_t* base = (const bf16_t*)(ws + ((sub < 8) ? off_k(x.b) : off_v(x.b))) + (size_t)x.b * SEQ * AW + x.h * HD + (sub & 7) * 8;
    if (br < 2) {
        const int d = (br == 0) ? 1 : 4, L = SEQ / d, T0 = (br == 0) ? 256 * u : 256 * (u & 1), cls = (br == 0) ? 0 : (u >> 1);
        const int k0 = T0 - 64 + s0;
        const bf16_t* p0 = base + ((long)k0 * d + cls) * AW; const long stride = (long)32 * d * AW;
#pragma unroll
        for (int i = 0; i < 14; ++i) { const int key = k0 + 32 * i; val[i] = (u32x4){0u, 0u, 0u, 0u};
            if ((i < 12) && (key >= 0) && (key < L)) val[i] = *(const u32x4*)(p0 + i * stride); }
    } else {
        const bf16_t* pa = base + ((long)(s0 - 64) * 16 + 2 * u) * AW; const bf16_t* pb = base + ((long)s0 * 16 + 2 * u + 1) * AW; const long stride = (long)32 * 16 * AW;
#pragma unroll
        for (int i = 0; i < 14; ++i) { val[i] = (u32x4){0u, 0u, 0u, 0u};
            if (i < 8) { const int key = s0 + 32 * i - 64; if ((key >= 0) && (key < 128)) val[i] = *(const u32x4*)(pa + i * stride); }
            else if (i < 12) val[i] = *(const u32x4*)(pb + (i - 8) * stride); }
    }
}
__device__ __forceinline__ void store_kv(LAS unsigned char* lds, const u32x4 (&val)[14], int tid) {
#pragma unroll
    for (int i = 0; i < 14; ++i) {
        const int piece = tid + 512 * i, slot = piece >> 4, sub = piece & 15;
        const int off = (sub < 8) ? (L_K + sub * KCS + slot * 16) : (L_V + ((sub - 8) >> 2) * VDS + slot * 64 + ((sub - 8) & 3) * 16);
        *(LAS u32x4*)(lds + off) = val[i];
    }
}
__device__ __forceinline__ void wave_geo(const UD& x, int wid, int& d, int& L, int& cls, int& t0, int& sbase) {
    const int br = x.br, u = x.u; d = (br == 0) ? 1 : (br == 1) ? 4 : 16; L = SEQ / d;
    if (br < 2) { const int T0 = (br == 0) ? 256 * u : 256 * (u & 1); cls = (br == 0) ? 0 : (u >> 1); t0 = T0 + 32 * wid; sbase = 32 * wid; }
    else { const int hw = wid >> 2; cls = 2 * u + hw; t0 = 32 * (wid & 3); sbase = 192 * hw + 32 * (wid & 3); }
}
__device__ __forceinline__ void load_q(bf16x8 (&qr)[4], const UD& x, const unsigned char* ws, int wid, int r32, int hi) {
    int d, L, cls, t0, sbase; wave_geo(x, wid, d, L, cls, t0, sbase);
    const bf16_t* Qb = (const bf16_t*)(ws + off_q(x.b));
    const size_t qtok = (size_t)x.b * SEQ + (size_t)(t0 + r32) * d + cls;
#pragma unroll
    for (int d0 = 0; d0 < 4; ++d0) qr[d0] = *(const bf16x8*)(Qb + qtok * AW + x.h * HD + d0 * 16 + hi * 8);
}
__device__ __forceinline__ void compute_a(LAS unsigned char* lds, const UD& x, const bf16x8 (&qr)[4], int wid, int lane, u32x4 (&pw)[10], float& mx_o, float& l_o) {
    const int r32 = lane & 31, hi = lane >> 5;
    int d, L, cls, t0, sbase; wave_geo(x, wid, d, L, cls, t0, sbase);
    f32x16 s[5];
#pragma unroll
    for (int ht = 0; ht < 5; ++ht) {
        const LAS unsigned char* kb = lds + L_K + hi * KCS + (sbase + 32 * ht + r32) * 16;
        f32x16 a = {};
#pragma unroll
        for (int d0 = 0; d0 < 4; ++d0) { const bf16x8 kf = *(const LAS bf16x8*)(kb + d0 * 2 * KCS); a = __builtin_amdgcn_mfma_f32_32x32x16_bf16(kf, qr[d0], a, 0, 0, 0); }
        s[ht] = a;
    }
    {
        const int dq = r32 - 4 * hi;
#pragma unroll
        for (int r = 0; r < 16; ++r) { const int cr = (r & 3) + 8 * (r >> 2); s[0][r] = (cr >= dq) ? s[0][r] : -INFINITY; s[4][r] = (cr <= dq) ? s[4][r] : -INFINITY; }
        if (t0 < 64) {
#pragma unroll
            for (int r = 0; r < 16; ++r) s[0][r] = -INFINITY;
            if (t0 < 32) {
#pragma unroll
                for (int r = 0; r < 16; ++r) s[1][r] = -INFINITY;
            }
        }
        if (t0 + 96 > L) {
#pragma unroll
            for (int r = 0; r < 16; ++r) s[4][r] = -INFINITY;
            if (t0 + 64 > L) {
#pragma unroll
                for (int r = 0; r < 16; ++r) s[3][r] = -INFINITY;
            }
        }
    }
    float mx = s[2][0];
#pragma unroll
    for (int ht = 0; ht < 5; ++ht)
#pragma unroll
        for (int r = 0; r < 16; ++r) mx = fmaxf(mx, s[ht][r]);
    mx = fmaxf(mx, __shfl_xor(mx, 32));
    float lsum = 0.f;
#pragma unroll
    for (int ht = 0; ht < 5; ++ht)
#pragma unroll
        for (int r = 0; r < 16; ++r) { const float p = __builtin_amdgcn_exp2f(s[ht][r] - mx); s[ht][r] = p; lsum += p; }
    lsum += __shfl_xor(lsum, 32);
#pragma unroll
    for (int g = 0; g < 10; ++g) {
        const int ht = g >> 1, rb = (g & 1) * 8;
        pw[g].x = pg8::cvt_pk_bf16(s[ht][rb + 0], s[ht][rb + 1]); pw[g].y = pg8::cvt_pk_bf16(s[ht][rb + 2], s[ht][rb + 3]); pw[g].z = pg8::cvt_pk_bf16(s[ht][rb + 4], s[ht][rb + 5]); pw[g].w = pg8::cvt_pk_bf16(s[ht][rb + 6], s[ht][rb + 7]);
    }
    mx_o = mx; l_o = lsum;
}
__device__ __forceinline__ void compute_b(LAS unsigned char* lds, const UD& x, unsigned char* ws, int wid, int lane, const u32x4 (&pw)[10], float mx, float lsum) {
    const int r32 = lane & 31, hi = lane >> 5;
    int d, L, cls, t0, sbase; wave_geo(x, wid, d, L, cls, t0, sbase);
    const size_t tokb = (size_t)x.b * SEQ;
    const size_t qtok = tokb + (size_t)(t0 + r32) * d + cls;
    f32x16 o[2]; o[0] = f32x16{}; o[1] = f32x16{};
    const int vlane = ((lane >> 4) & 1) * 32 + (lane & 3) * 8 + (4 * hi + ((lane & 15) >> 2)) * 64;
#pragma unroll
    for (int g = 0; g < 10; ++g) {
        const bf16x8 pa = __builtin_bit_cast(bf16x8, pw[g]);
#pragma unroll
        for (int d0 = 0; d0 < 2; ++d0) {
            const LAS unsigned char* vp = lds + L_V + d0 * VDS + (sbase + 16 * g) * 64 + vlane;
            const s16x4 lo = vtr(vp), hh = vtr(vp + 512);
            const bf16x8 vf = (bf16x8){lo[0], lo[1], lo[2], lo[3], hh[0], hh[1], hh[2], hh[3]};
            o[d0] = __builtin_amdgcn_mfma_f32_32x32x16_bf16(pa, vf, o[d0], 0, 0, 0);
        }
    }
    LAS float* wsf = (LAS float*)(lds + L_WS + wid * 256);
    LAS bf16_t* stg = (LAS bf16_t*)(lds + L_OST + wid * 4096);
    if (hi == 0) {
        wsf[r32] = lsum;
        float* st = (float*)(ws + WS_STAT) + (((size_t)x.br * M + qtok) * NH + x.h) * 2; st[0] = mx; st[1] = lsum;
    }
    asm volatile("s_waitcnt lgkmcnt(0)" ::: "memory");
#pragma unroll
    for (int r = 0; r < 16; ++r) {
        const int qrow = crow(r, hi); const float rl = __builtin_amdgcn_rcpf(wsf[qrow]);
        const unsigned a = pg8::cvt_pk_bf16(o[0][r] * rl, o[1][r] * rl);
        stg[qrow * 64 + r32] = (bf16_t)(a & 0xffffu); stg[qrow * 64 + 32 + r32] = (bf16_t)(a >> 16);
    }
    asm volatile("s_waitcnt lgkmcnt(0)" ::: "memory");
    bf16_t* Ob = (bf16_t*)(ws + WS_O) + (size_t)x.br * M * AW;
#pragma unroll
    for (int i = 0; i < 4; ++i) {
        const int row = i * 8 + (lane >> 3), ch = lane & 7;
        const u32x4 v = *(const LAS u32x4*)(stg + row * 64 + ch * 8);
        *(u32x4*)(Ob + (tokb + (size_t)(t0 + row) * d + cls) * AW + x.h * HD + ch * 8) = v;
    }
}
__device__ __forceinline__ void phase(LAS unsigned char* lds, unsigned char* ws, int first, int step, int limit) {
    int tid_ = threadIdx.x; asm volatile("" : "+v"(tid_));
    const int tid = tid_, lane = tid & 63; const int wid = __builtin_amdgcn_readfirstlane(tid >> 6);
    if (first >= limit) return;
    u32x4 val[14];
    load_kv(val, decode(first), ws, tid);
    for (int uid = first; uid < limit; uid += step) {
        const UD x = decode(uid);
        bf16x8 qr[4]; load_q(qr, x, ws, wid, lane & 31, lane >> 5);
        store_kv(lds, val, tid);
        __syncthreads();
        u32x4 pw[10]; float mx, lsum;
        compute_a(lds, x, qr, wid, lane, pw, mx, lsum);
        if (uid + step < limit) load_kv(val, decode(uid + step), ws, tid);
        compute_b(lds, x, ws, wid, lane, pw, mx, lsum);
        __syncthreads();
    }
}
}

__device__ __forceinline__ float bf2f(unsigned short h) { return __uint_as_float((unsigned)h << 16); }
__device__ __forceinline__ float wave_sum(float v) {
#pragma unroll
    for (int o = 1; o < 64; o <<= 1) v += __shfl_xor(v, o);
    return v;
}
__device__ __forceinline__ unsigned f2bf(float f) { unsigned u = __float_as_uint(f); return (u + 0x7fffu + ((u >> 16) & 1u)) >> 16; }
__device__ __forceinline__ unsigned pk2(float lo, float hi) { return f2bf(lo) | (f2bf(hi) << 16); }

struct TrItem { const float* W; const float* gain; bf16_t* WT; int N, k0, n0, ldw, drow0; };
__device__ __forceinline__ void tr_load(f32x4 (&v)[16], const TrItem& t, int lane) {
    const int kr = lane >> 4, nc = 4 * (lane & 15);
#pragma unroll
    for (int i = 0; i < 16; ++i) v[i] = *(const f32x4*)(t.W + (size_t)(t.k0 + 4 * i + kr) * t.N + t.n0 + nc);
}
__device__ __forceinline__ void tr_finish(const f32x4 (&v)[16], const TrItem& t, LAS float* scr, int lane) {
    const int kr = lane >> 4, nc = 4 * (lane & 15);
#pragma unroll
    for (int i = 0; i < 16; ++i) { const int kk = 4 * i + kr; const float gg = t.gain ? t.gain[t.k0 + kk] : 1.f; LAS float* s = scr + kk * 65 + nc;
        s[0] = v[i][0] * gg; s[1] = v[i][1] * gg; s[2] = v[i][2] * gg; s[3] = v[i][3] * gg; }
    asm volatile("s_waitcnt lgkmcnt(0)" ::: "memory");
    const int c = lane & 7;
#pragma unroll
    for (int j = 0; j < 8; ++j) { const int n = (lane >> 3) + 8 * j; const LAS float* s = scr + (8 * c) * 65 + n;
        u32x4 o; o.x = pk2(s[0 * 65], s[1 * 65]); o.y = pk2(s[2 * 65], s[3 * 65]); o.z = pk2(s[4 * 65], s[5 * 65]); o.w = pk2(s[6 * 65], s[7 * 65]);
        *(u32x4*)(t.WT + (size_t)(t.drow0 + n) * t.ldw + t.k0 + 8 * c) = o; }
    asm volatile("s_waitcnt lgkmcnt(0)" ::: "memory");
}
constexpr int I_G = 16 * 44, I_D = 44 * 16, I_IN = 16 * 40, I_O = 12 * 16, I_LAYER = 6 * I_G + I_IN + I_O;
static_assert(I_G == I_D, "item counts");
__device__ __forceinline__ TrItem tr_decode(const Args& a, int it) {
    TrItem t; const int l = it / I_LAYER; int r = it % I_LAYER;
    unsigned char* wl = a.ws + WS_W + (size_t)l * LW_SIZE;
    if (r < 6 * I_G) {
        const int seg = r / I_G; r = r % I_G;
        const int ffn = seg / 3, kind = seg % 3;
        if (kind < 2) {
            t.W = (kind == 0 ? (ffn ? a.g2 : a.g1) : (ffn ? a.u2 : a.u1)) + (size_t)l * DM * DFF; t.gain = (ffn ? a.n2 : a.n1) + (size_t)l * DM;
            t.WT = (bf16_t*)(wl + (ffn ? LW_GU2 : LW_GU1)); t.N = DFF; t.ldw = DM;
            const int kb = r / 44, nb = r % 44; t.k0 = 64 * kb; t.n0 = 64 * nb; t.drow0 = 256 * (t.n0 / 128) + 128 * kind + (t.n0 % 128);
        } else {
            t.W = (ffn ? a.d2 : a.d1) + (size_t)l * DFF * DM; t.gain = nullptr; t.WT = (bf16_t*)(wl + (ffn ? LW_D2 : LW_D1)); t.N = DM; t.ldw = DFF;
            const int kb = r / 16, nb = r % 16; t.k0 = 64 * kb; t.n0 = 64 * nb; t.drow0 = 64 * nb;
        }
    } else if (r < 6 * I_G + I_IN) {
        r -= 6 * I_G; const int kb = r / 40, nb = r % 40;
        t.W = a.win + (size_t)l * DM * NIN; t.gain = a.nm + (size_t)l * DM; t.WT = (bf16_t*)(wl + LW_IN); t.N = NIN; t.ldw = DM; t.k0 = 64 * kb; t.n0 = 64 * nb; t.drow0 = 64 * nb;
    } else {
        r -= 6 * I_G + I_IN; const int kb = 4 + r / 16, nb = r % 16;
        t.W = a.wout + (size_t)l * DM * DM; t.gain = nullptr; t.WT = (bf16_t*)(wl + LW_OUT); t.N = DM; t.ldw = DM; t.k0 = 64 * kb; t.n0 = 64 * nb; t.drow0 = 64 * nb;
    }
    return t;
}

__device__ __forceinline__ void prologue(const Args& a, LAS unsigned char* lds, int vcu, int G) {
    const int tid = threadIdx.x, lane = tid & 63, wave = __builtin_amdgcn_readfirstlane(tid >> 6);
    LAS float* scr = (LAS float*)(lds + wave * 16640);
    const int gw = vcu * 8 + wave, NGW = G * 8;
    unsigned char* ws = a.ws;
    if (gw < DEPTH * I_LAYER) {
        TrItem cur = tr_decode(a, gw); f32x4 va[16]; tr_load(va, cur, lane);
        for (int it = gw; it < DEPTH * I_LAYER; it += NGW) {
            const bool more = it + NGW < DEPTH * I_LAYER;
            TrItem nxt = cur; f32x4 vb[16];
            if (more) { nxt = tr_decode(a, it + NGW); tr_load(vb, nxt, lane); }
            tr_finish(va, cur, scr, lane);
            if (more) {
#pragma unroll
                for (int i = 0; i < 16; ++i) va[i] = vb[i];
                cur = nxt; }
        }
    }
    for (int it = gw; it < DEPTH * 4 * 8 * 16; it += NGW) {
        const int l = it >> 9, g = (it >> 7) & 3, c8 = (it >> 4) & 7, n = (it & 15) * 64 + lane;
        const float* wo = a.wout + (size_t)l * DM * DM + (size_t)(g * 64) * DM + n;
        const float* sc = a.ps + (size_t)l * PWD + g * 64;
        const float* pr = a.pw + (((size_t)l * 4 + g) * 64 + c8 * 8) * 64;
        float acc[8] = {0.f, 0.f, 0.f, 0.f, 0.f, 0.f, 0.f, 0.f};
#pragma unroll 4
        for (int dd = 0; dd < 64; ++dd) { const float wv = wo[(size_t)dd * DM] * sc[dd];
#pragma unroll
            for (int e = 0; e < 8; ++e) acc[e] += pr[e * 64 + dd] * wv; }
        u32x4 o; o.x = pk2(acc[0], acc[1]); o.y = pk2(acc[2], acc[3]); o.z = pk2(acc[4], acc[5]); o.w = pk2(acc[6], acc[7]);
        *(u32x4*)((bf16_t*)(ws + WS_W + (size_t)l * LW_SIZE + LW_OUT) + (size_t)n * DM + g * 64 + c8 * 8) = o;
    }
    bf16_t* XB = (bf16_t*)(ws + WS_XB); float* P = (float*)(ws + WS_SSQ); float* CS = (float*)(ws + WS_ROPE);
    for (int mp = gw; mp < M; mp += 2 * NGW) {
        f32x4 v[2][4];
#pragma unroll
        for (int q = 0; q < 2; ++q) { const int m = (mp + q * NGW < M) ? mp + q * NGW : mp; const f32x4* xr = (const f32x4*)(a.x + (size_t)m * DM) + lane;
#pragma unroll
            for (int j = 0; j < 4; ++j) v[q][j] = xr[64 * j]; }
#pragma unroll
        for (int q = 0; q < 2; ++q) {
            const int m = (mp + q * NGW < M) ? mp + q * NGW : mp;
            u32x2* xb = (u32x2*)(XB + (size_t)m * DM) + lane;
            float s = 0.f;
#pragma unroll
            for (int j = 0; j < 4; ++j) { const f32x4 x4 = v[q][j]; s += (x4[0] * x4[0] + x4[1] * x4[1]) + (x4[2] * x4[2] + x4[3] * x4[3]);
                u32x2 w; w.x = pk2(x4[0], x4[1]); w.y = pk2(x4[2], x4[3]); xb[64 * j] = w; }
            s = wave_sum(s);
            if (lane < 16) P[(size_t)m * 16 + lane] = (lane == 0) ? s : 0.f;
            if (lane < 8) {
                const float ang = (float)a.pos[m] * a.inv_freq[lane];
                double rev = (double)ang * 0.15915494309189535; rev -= floor(rev);
                const float fr = (float)rev;
                CS[(size_t)m * 16 + lane] = __builtin_amdgcn_cosf(fr); CS[(size_t)m * 16 + 8 + lane] = __builtin_amdgcn_sinf(fr);
            }
        }
    }
}

__device__ __forceinline__ void combine_phase(const Args& a, int wv0, int nwv, int tok0, int ntok) {
    int tid_ = threadIdx.x; asm volatile("" : "+v"(tid_));
    const int tid = tid_, lane = tid & 63, wave = __builtin_amdgcn_readfirstlane(tid >> 6);
    const int gw = wv0 + wave, NGW = nwv;
    unsigned char* ws = a.ws;
    const bf16_t* __restrict__ O = (const bf16_t*)(ws + WS_O); const float* __restrict__ ST = (const float*)(ws + WS_STAT);
    const int g = lane >> 4, hw = 1 << g;
    for (int tokp = tok0 + gw; tokp < tok0 + ntok; tokp += 2 * NGW) {
        u32x2 vv[2][16], me[2]; int cnt[2]; float mm[2][2][3], ll[2][2][3]; u32x4 ov[2][2][3];
#pragma unroll
        for (int q = 0; q < 2; ++q) {
            const int tok = (tokp + q * NGW < tok0 + ntok) ? tokp + q * NGW : tokp;
            const int bb = tok >> 11, s = tok & (SEQ - 1);
            const bf16_t* base = (const bf16_t*)(ws + off_vp(bb)) + (size_t)(tok - s) * PWD + 4 * lane;
            cnt[q] = 0;
#pragma unroll
            for (int jj = 0; jj < 16; ++jj) { const int j = s - hw + jj; const bool ok = (jj < 2 * hw) && (j >= 0) && (j < SEQ);
                vv[q][jj] = (u32x2){0u, 0u}; if (ok) vv[q][jj] = *(const u32x2*)(base + (size_t)j * PWD); cnt[q] += ok ? 1 : 0; }
            me[q] = *(const u32x2*)(base + (size_t)s * PWD);
#pragma unroll
            for (int it = 0; it < 2; ++it) {
                const int chunk = (it * 64 + lane < 96) ? it * 64 + lane : 95, h = chunk >> 3;
#pragma unroll
                for (int i = 0; i < 3; ++i) { const float* st = ST + (((size_t)i * M + tok) * NH + h) * 2; mm[q][it][i] = st[0]; ll[q][it][i] = st[1]; ov[q][it][i] = *(const u32x4*)(O + ((size_t)i * M + tok) * AW + chunk * 8); }
            }
        }
#pragma unroll
        for (int q = 0; q < 2; ++q) {
            const int tok = (tokp + q * NGW < tok0 + ntok) ? tokp + q * NGW : tokp;
            bf16_t* MIX = (bf16_t*)(ws + off_mix(tok >> 11));
            float s0 = 0.f, s1 = 0.f, s2 = 0.f, s3 = 0.f;
#pragma unroll
            for (int jj = 0; jj < 16; ++jj) { s0 += __uint_as_float(vv[q][jj].x << 16); s1 += __uint_as_float(vv[q][jj].x & 0xffff0000u); s2 += __uint_as_float(vv[q][jj].y << 16); s3 += __uint_as_float(vv[q][jj].y & 0xffff0000u); }
            const float rc = 1.0f / (float)cnt[q];
            u32x2 w2; w2.x = pk2(s0 * rc - __uint_as_float(me[q].x << 16), s1 * rc - __uint_as_float(me[q].x & 0xffff0000u)); w2.y = pk2(s2 * rc - __uint_as_float(me[q].y << 16), s3 * rc - __uint_as_float(me[q].y & 0xffff0000u));
            *(u32x2*)(MIX + (size_t)tok * DM + 4 * lane) = w2;
#pragma unroll
            for (int it = 0; it < 2; ++it) {
                const int chunk = it * 64 + lane;
                float mxx = fmaxf(fmaxf(mm[q][it][0], mm[q][it][1]), mm[q][it][2]);
                float wgt[3], den = 0.f;
#pragma unroll
                for (int i = 0; i < 3; ++i) { wgt[i] = __builtin_amdgcn_exp2f(mm[q][it][i] - mxx) * ll[q][it][i]; den += wgt[i]; }
                const float rd = 1.0f / den;
                float acc[8] = {0.f, 0.f, 0.f, 0.f, 0.f, 0.f, 0.f, 0.f};
#pragma unroll
                for (int i = 0; i < 3; ++i) { const u32x4 v = ov[q][it][i]; const float wi = wgt[i] * rd;
                    acc[0] += wi * __uint_as_float(v.x << 16); acc[1] += wi * __uint_as_float(v.x & 0xffff0000u); acc[2] += wi * __uint_as_float(v.y << 16); acc[3] += wi * __uint_as_float(v.y & 0xffff0000u);
                    acc[4] += wi * __uint_as_float(v.z << 16); acc[5] += wi * __uint_as_float(v.z & 0xffff0000u); acc[6] += wi * __uint_as_float(v.w << 16); acc[7] += wi * __uint_as_float(v.w & 0xffff0000u); }
                u32x4 w; w.x = pk2(acc[0], acc[1]); w.y = pk2(acc[2], acc[3]); w.z = pk2(acc[4], acc[5]); w.w = pk2(acc[6], acc[7]);
                if (chunk < 96) *(u32x4*)(MIX + (size_t)tok * DM + PWD + chunk * 8) = w;
            }
        }
    }
}

__device__ __forceinline__ void final_norm(const Args& a, int wv0, int nwv, int tok0, int ntok) {
    const int tid = threadIdx.x, lane = tid & 63, wave = __builtin_amdgcn_readfirstlane(tid >> 6);
    const int gw = wv0 + wave, NGW = nwv;
    const f32x4* gr = (const f32x4*)a.nf + lane;
    for (int mp = tok0 + gw; mp < tok0 + ntok; mp += 2 * NGW) {
        f32x4 v[2][4];
#pragma unroll
        for (int q = 0; q < 2; ++q) { const int m = (mp + q * NGW < tok0 + ntok) ? mp + q * NGW : mp; const f32x4* xr = (const f32x4*)(a.out + (size_t)m * DM) + lane;
#pragma unroll
            for (int j = 0; j < 4; ++j) v[q][j] = xr[64 * j]; }
        float ri[2];
#pragma unroll
        for (int q = 0; q < 2; ++q) { float s = 0.f;
#pragma unroll
            for (int j = 0; j < 4; ++j) s += (v[q][j][0] * v[q][j][0] + v[q][j][1] * v[q][j][1]) + (v[q][j][2] * v[q][j][2] + v[q][j][3] * v[q][j][3]);
            ri[q] = 1.0f / sqrtf(wave_sum(s) * (1.0f / DM) + NORM_EPS); }
#pragma unroll
        for (int q = 0; q < 2; ++q) { if (q == 1 && mp + NGW >= tok0 + ntok) break; const int m = mp + q * NGW; f32x4* xr = (f32x4*)(a.out + (size_t)m * DM) + lane;
#pragma unroll
            for (int j = 0; j < 4; ++j) xr[64 * j] = v[q][j] * ri[q] * gr[64 * j]; }
    }
}

#define XB_TMO      128
#define XB_XCNT(j)  (256  + 64 * (j))
#define XB_XSUB(j)  (1280 + 64 * (j))
#define XB_XGEN(j)  (2304 + 64 * (j))
#define XB_TOP      3328
#define XB_TOPGEN   3392
#define XCD_BAR_WORDS 3456
#define XB_SPIN_CAP (1u << 18)

__device__ __forceinline__ unsigned xb_ld(unsigned* p)              { return __hip_atomic_load(p, __ATOMIC_RELAXED, __HIP_MEMORY_SCOPE_AGENT); }
__device__ __forceinline__ unsigned xb_add(unsigned* p, unsigned v) { return __hip_atomic_fetch_add(p, v, __ATOMIC_RELAXED, __HIP_MEMORY_SCOPE_AGENT); }
__device__ __forceinline__ unsigned xb_xcc_id() { return (unsigned)__builtin_amdgcn_s_getreg((3 << 11) | 20) & 0xFu; }
#define XB_SPIN(cond, bar) do { unsigned _sp = 0; while (cond) { __builtin_amdgcn_s_sleep(1); \
    if ((++_sp & 255u) == 0u) { if (xb_ld(&(bar)[XB_TMO])) break; if (_sp > XB_SPIN_CAP) { atomicAdd(&(bar)[XB_TMO], 1u); break; } } } } while (0)

struct XcdBarrier {
    unsigned* bar; unsigned x;
    volatile LAS unsigned* st;
};

__device__ __forceinline__ XcdBarrier xcd_barrier_post(unsigned* bar, volatile LAS unsigned* st) {
    XcdBarrier b; b.bar = bar; b.x = xb_xcc_id(); b.st = st;
    if (threadIdx.x == 0) (void)xb_add(&bar[XB_XCNT(b.x)], 1u);
    return b;
}
__device__ __forceinline__ void xcd_barrier_complete(unsigned* bar, unsigned x, unsigned& nloc, unsigned& nx) {
    const unsigned G = gridDim.x * gridDim.y * gridDim.z;
    unsigned sum, cnt, mine, sp = 0u;
    for (;;) {
        sum = 0u; cnt = 0u; mine = 0u;
#pragma unroll
        for (unsigned j = 0; j < 16; ++j) { const unsigned c = xb_ld(&bar[XB_XCNT(j)]); sum += c; cnt += (c > 0u) ? 1u : 0u; mine = (j == x) ? c : mine; }
        if (sum == G) break;
        __builtin_amdgcn_s_sleep(1);
        if ((++sp & 255u) == 0u) { if (xb_ld(&bar[XB_TMO])) break; if (sp > XB_SPIN_CAP) { atomicAdd(&bar[XB_TMO], 1u); break; } }
    }
    nloc = mine > 0u ? mine : 1u; nx = cnt > 0u ? cnt : 1u;
}

__device__ __forceinline__ void xcd_barrier(const XcdBarrier& b) {
    asm volatile("s_waitcnt vmcnt(0)" ::: "memory");
    __syncthreads();
    if (threadIdx.x == 0) {
        unsigned* bar = b.bar;
        __builtin_amdgcn_s_waitcnt(0);
        unsigned nloc = b.st[0], nx = b.st[1];
        if (nloc == 0u) { xcd_barrier_complete(bar, b.x, nloc, nx); b.st[0] = nloc; b.st[1] = nx; }
        const unsigned old = xb_add(&bar[XB_XSUB(b.x)], 1u);
        const unsigned gen = old / nloc;
        if (old + 1u == (gen + 1u) * nloc) {
            __builtin_amdgcn_fence(__ATOMIC_RELEASE, "agent");
            asm volatile("s_waitcnt vmcnt(0)" ::: "memory");
            const unsigned og = xb_add(&bar[XB_TOP], 1u);
            const unsigned tg = og / nx;
            if (og + 1u == (tg + 1u) * nx) xb_add(&bar[XB_TOPGEN], 1u);
            else XB_SPIN(xb_ld(&bar[XB_TOPGEN]) == tg, bar);
            __builtin_amdgcn_fence(__ATOMIC_ACQUIRE, "agent");
            xb_add(&bar[XB_XGEN(b.x)], 1u);
            asm volatile("s_waitcnt vmcnt(0)" ::: "memory");
        } else {
            XB_SPIN(xb_ld(&bar[XB_XGEN(b.x)]) == gen, bar);
            __builtin_amdgcn_fence(__ATOMIC_ACQUIRE, "agent");
            asm volatile("s_waitcnt vmcnt(0)" ::: "memory");
        }
    }
    __syncthreads();
}

#define XL_RANK(j) (3520 + 64 * (j))
#define XL_CNT(j)  (4608 + 64 * (j))
__device__ __forceinline__ void local_barrier(unsigned* ctl, unsigned x) {
    asm volatile("s_waitcnt vmcnt(0)" ::: "memory");
    __syncthreads();
    if (threadIdx.x == 0) {
        __builtin_amdgcn_s_waitcnt(0);
        const unsigned old = xb_add(&ctl[XL_CNT(x)], 1u), target = (old / 32u + 1u) * 32u;
        XB_SPIN(xb_ld(&ctl[XL_CNT(x)]) < target, ctl);
        __builtin_amdgcn_fence(__ATOMIC_ACQUIRE, "agent");
        asm volatile("s_waitcnt vmcnt(0)" ::: "memory");
    }
    __syncthreads();
}

constexpr int LDS_BYTES = 152576;
__global__ void __launch_bounds__(512, 2) fwd(Args a) {
    extern __shared__ __attribute__((aligned(16))) unsigned char lds_raw[];
    LAS unsigned char* lds = (LAS unsigned char*)lds_raw;
    cg::grid_group grid = cg::this_grid();
    const int G = gridDim.x;
    const int vcu0 = (G % 8 == 0) ? ((int)blockIdx.x % 8) * (G / 8) + (int)blockIdx.x / 8 : (int)blockIdx.x;
    unsigned char* ws = a.ws;
    unsigned* ctl = (unsigned*)(ws + WS_CTL);
    bf16_t* XB = (bf16_t*)(ws + WS_XB); bf16_t* ACT = (bf16_t*)(ws + WS_A); float* P = (float*)(ws + WS_SSQ); float* CS = (float*)(ws + WS_ROPE);

    LAS float* RT = (LAS float*)(lds + 149760);
    volatile LAS unsigned* BST = (volatile LAS unsigned*)(lds + 149760 + 2048);
    const unsigned xcc = xb_xcc_id();
    if (threadIdx.x == 0) { BST[0] = 0u; BST[1] = 0u; BST[2] = xb_add(&ctl[XL_RANK(xcc)], 1u); BST[3] = 0u; }
    __syncthreads();
    const XcdBarrier bar = xcd_barrier_post(ctl, BST);
    if (a.never) grid.sync();
    prologue(a, lds, vcu0, G);
    xcd_barrier(bar);
    if (threadIdx.x == 0) {
        bool ok = (G == 256);
        for (unsigned j = 0; j < 16; ++j) { const unsigned cnt = xb_ld(&ctl[XB_XCNT(j)]); ok = ok && (cnt == (j < 8 ? 32u : 0u)); }
        BST[3] = (ok && xb_ld(&ctl[XB_TMO]) == 0u) ? 1u : 0u;
    }
    __syncthreads();
    const bool local = BST[3] != 0u;
    const int rank = (int)BST[2];
    const int bx = local ? rank * 8 + (int)xcc : (int)blockIdx.x;
    const int wv0 = local ? rank * 8 : vcu0 * 8, nwv = local ? 256 : G * 8, tok0 = local ? (int)xcc * SEQ : 0, ntok = local ? SEQ : M;
#define SEAM() do { if (local) local_barrier(ctl, xcc); else xcd_barrier(bar); } while (0)
    for (int st = 0; st < 3 * DEPTH; ++st) {
        const int l = st / 3, kind = st % 3;
        unsigned char* wl = ws + WS_W + (size_t)l * LW_SIZE;
        asm volatile("" : "+s"(wl));
        if (kind != 1) {
            const bf16_t* Wgu = (const bf16_t*)(wl + (kind ? LW_GU2 : LW_GU1)); const bf16_t* Wd = (const bf16_t*)(wl + (kind ? LW_D2 : LW_D1));
            { pg8::Gemm g{XB, Wgu, M, NGU, DM}; epi::RinvOrder<pg8::StaticOrder> S; S.init(M, NGU, G, bx); S.P = P; S.tab = RT;
              { pg8::Unit u0; S.pm0 = S.next(0, u0) ? u0.pm : -1; int t = threadIdx.x; asm volatile("" : "+v"(t)); if (S.pm0 >= 0 && t < 256) { const float r = epi::rinv_of(P, S.pm0 * 256 + t); RT[t] = r; RT[256 + t] = r; } __syncthreads(); }
              const int nfull = S.nwg / G; const bool split = false && (S.nwg - nfull * G) * 2 == G && (G % 16 == 0);
              if (split) S.imax = nfull;
              { epi::EpiSwiGLU<2> E{ACT, RT}; pg8::gemm_phase<epi::EpiSwiGLU<2>, epi::RinvOrder<pg8::StaticOrder>, true, true>(lds, g, S, E); }
              if (split) { epi::RinvOrder<pg8::HalfOrder> H; H.init(M, NGU, G, bx); H.nfull = nfull; H.P = P; H.tab = RT; H.pm0 = -1; epi::EpiSwiGLU<1> E{ACT, RT};
                pg8::gemm_phase<epi::EpiSwiGLU<1>, epi::RinvOrder<pg8::HalfOrder>, true, true, true>(lds, g, H, E); } }
            SEAM();
            { pg8::Gemm g{ACT, Wd, M, DM, DFF}; pg8::StaticOrder S; S.init(M, DM, G, bx); epi::EpiResid E{st == 0 ? a.x : a.out, a.out, XB, P, 0.5f};
              pg8::gemm_phase<epi::EpiResid, pg8::StaticOrder, true, true>(lds, g, S, E); }
            SEAM();
        } else {
            { pg8::Gemm g{XB, (const bf16_t*)(wl + LW_IN), M, NIN, DM}; epi::RinvOrder<pg8::StaticOrder> S; S.init(M, NIN, G, bx); S.P = P; S.tab = RT; const int bb = bx & 7;
              { pg8::Unit u0; S.pm0 = S.next(0, u0) ? u0.pm : -1; int t = threadIdx.x; asm volatile("" : "+v"(t)); if (S.pm0 >= 0 && t < 256) { const float r = epi::rinv_of(P, S.pm0 * 256 + t); RT[t] = r; RT[256 + t] = r; } __syncthreads(); }
              const int nfull = S.nwg / G; const bool split = false && (S.nwg - nfull * G) * 2 == G && (G % 16 == 0);
              if (split) S.imax = nfull;
              bf16_t* vp_ = (bf16_t*)(ws + off_vp(bb)); bf16_t* q_ = (bf16_t*)(ws + off_q(bb)); bf16_t* k_ = (bf16_t*)(ws + off_k(bb)); bf16_t* v_ = (bf16_t*)(ws + off_v(bb));
              { epi::EpiProj<2> E{vp_, q_, k_, v_, RT, CS}; pg8::gemm_phase<epi::EpiProj<2>, epi::RinvOrder<pg8::StaticOrder>, true, true>(lds, g, S, E); }
              if (split) { epi::RinvOrder<pg8::HalfOrder> H; H.init(M, NIN, G, bx); H.nfull = nfull; H.P = P; H.tab = RT; H.pm0 = -1; epi::EpiProj<1> E{vp_, q_, k_, v_, RT, CS};
                pg8::gemm_phase<epi::EpiProj<1>, epi::RinvOrder<pg8::HalfOrder>, true, true, true>(lds, g, H, E); } }
            SEAM();
            if (local) att::phase(lds, ws, (int)xcc * NH * 24 + rank, 32, ((int)xcc + 1) * NH * 24); else att::phase(lds, ws, bx, G, BATCH * NH * 24);
            SEAM();
            combine_phase(a, wv0, nwv, tok0, ntok);
            SEAM();
            { pg8::Gemm g{(const bf16_t*)(ws + off_mix(bx & 7)), (const bf16_t*)(wl + LW_OUT), M, DM, DM}; pg8::StaticOrder S; S.init(M, DM, G, bx); epi::EpiResid E{a.out, a.out, XB, P, 1.0f};
              pg8::gemm_phase<epi::EpiResid, pg8::StaticOrder, true, true>(lds, g, S, E); }
            SEAM();
        }
    }
    final_norm(a, wv0, nwv, tok0, ntok);
}

extern "C" void kernel_launch(void* const* d_in, const int* in_sizes, int n_in, void* d_out, int out_size, void* d_ws, size_t ws_size, hipStream_t stream) {
    static int grid = 0;
    if (grid == 0) {
        if (n_in != 16 || in_sizes[0] != M * DM || out_size != M * DM || ws_size < WS_END) { fprintf(stderr, "kernel_launch: unexpected shapes (n_in %d in0 %d out %d ws %zu)\n", n_in, n_in > 0 ? in_sizes[0] : -1, out_size, ws_size); grid = -1; return; }
        int dev = 0, cus = 0, per_cu = 0;
        if (hipGetDevice(&dev) != hipSuccess || hipDeviceGetAttribute(&cus, hipDeviceAttributeMultiprocessorCount, dev) != hipSuccess) { grid = -1; return; }
        if (hipFuncSetAttribute((const void*)fwd, hipFuncAttributeMaxDynamicSharedMemorySize, LDS_BYTES) != hipSuccess) { fprintf(stderr, "kernel_launch: hipFuncSetAttribute failed\n"); grid = -1; return; }
        if (hipOccupancyMaxActiveBlocksPerMultiprocessor(&per_cu, (const void*)fwd, 512, LDS_BYTES) != hipSuccess || per_cu < 1) fprintf(stderr, "kernel_launch: occupancy query says %d\n", per_cu);
        (void)hipGetLastError();
        grid = cus;
    }
    if (grid < 0) return;
    if (hipMemsetAsync((char*)d_ws + WS_CTL, 0, CTL_BYTES, stream) != hipSuccess) { fprintf(stderr, "kernel_launch: memset failed\n"); return; }
    Args a{};
    a.x = (const float*)d_in[0]; a.pos = (const int*)d_in[1];
    a.n1 = (const float*)d_in[2]; a.g1 = (const float*)d_in[3]; a.u1 = (const float*)d_in[4]; a.d1 = (const float*)d_in[5];
    a.nm = (const float*)d_in[6]; a.win = (const float*)d_in[7]; a.pw = (const float*)d_in[8]; a.ps = (const float*)d_in[9]; a.wout = (const float*)d_in[10];
    a.n2 = (const float*)d_in[11]; a.g2 = (const float*)d_in[12]; a.u2 = (const float*)d_in[13]; a.d2 = (const float*)d_in[14]; a.nf = (const float*)d_in[15];
    a.out = (float*)d_out; a.ws = (unsigned char*)d_ws;
    for (int i = 0; i < 8; ++i) a.inv_freq[i] = (float)pow(500000.0, -(double)i / 8.0);
    void* args[] = {&a};
    hipError_t e = hipLaunchCooperativeKernel((const void*)fwd, dim3(grid), dim3(512), args, LDS_BYTES, stream);
    if (e != hipSuccess) fprintf(stderr, "cooperative launch failed: %s (grid %d)\n", hipGetErrorString(e), grid);
}
```

```cpp
#include <hip/hip_runtime.h>
#include <hip/hip_cooperative_groups.h>
#include <cstdio>
#include <cstdint>
#include <cmath>
namespace cg = cooperative_groups;
namespace pg8 {
#define PG8_LAS __attribute__((address_space(3)))
typedef unsigned short bf16_t;
typedef short bf16x8 __attribute__((ext_vector_type(8)));
typedef float f32x4 __attribute__((ext_vector_type(4)));
typedef unsigned u32x4 __attribute__((ext_vector_type(4)));
constexpr int BM = 256, BK = 64, HALF = 128, HTB = HALF * BK * 2  , STAGE_BYTES = 8 * HTB, NXCD = 8, WGM = 8;

__host__ __device__ __forceinline__ int lds_byte(int r, int c) { const int st = (r >> 4) * 2 + (c >> 5), rr = r & 15, cc = c & 31, ob = rr * 64 + cc * 2; return st * 1024 + (ob ^ (((ob >> 9) & 1) << 5)); }
__host__ __device__ __forceinline__ void stage_rc(int b, int& R, int& C) { const int st = b / 1024, sb = b % 1024, swz = sb ^ (((sb >> 9) & 1) << 5); R = (st >> 1) * 16 + swz / 64; C = (st & 1) * 32 + (swz % 64) / 2; }
__host__ __device__ __forceinline__ int perm32(int rho) { const int n = rho >> 4, i = rho & 15; return 8 * (i >> 2) + 4 * n + (i & 3); }

struct Unit { int pm, pn, par, roff; };
struct Gemm { const bf16_t* A; const bf16_t* Bt; int M, N, K, nkt; };

struct StaticOrder {
    int nM, nN, nwg, G, c, imax;
    __host__ __device__ void init(int M, int N, int G_, int c_) { nM = M / BM; nN = N / BM; nwg = nM * nN; G = G_; c = c_; imax = 1 << 30; }
    __host__ __device__ void decode(long L, Unit& u) const {
        int wgid = (int)L; { const int q = nwg / NXCD, r = nwg % NXCD, xcd = wgid % NXCD, off = wgid / NXCD; wgid = (xcd < r ? xcd * (q + 1) : r * (q + 1) + (xcd - r) * q) + off; }
        const int nig = WGM * nN, gid = wgid / nig, fm = gid * WGM, gsz = (nM - fm) < WGM ? (nM - fm) : WGM;
        u.pm = fm + ((wgid % nig) % gsz); u.pn = (wgid % nig) / gsz;
    }
    __host__ __device__ bool next(int i, Unit& u) const {
        const long L = (long)i * G + c; if (i >= imax || L >= nwg) return false;
        decode(L, u); u.par = i & 1; u.roff = 0; return true;
    }
    __device__ __forceinline__ void a_ready(const Unit&) const {}
    __device__ __forceinline__ void done(const Unit&) const {}
};
struct HalfOrder : StaticOrder {
    int nfull;
    __host__ __device__ bool next(int i, Unit& u) const {
        if (i != 0) return false;
        const int xcd = c % NXCD, rho = c / NXCD; const long L = ((long)nfull * (G / NXCD) + (rho >> 1)) * NXCD + xcd; if (L >= nwg) return false;
        decode(L, u); u.par = 0; u.roff = 0; return true;
    }
};
__device__ __forceinline__ unsigned cvt_pk_bf16(float lo, float hi) { unsigned r; asm volatile("v_cvt_pk_bf16_f32 %0, %1, %2" : "=v"(r) : "v"(lo), "v"(hi)); return r; }
template <class Epi, class Sched, bool ALIGN_EPI = false, bool SP2 = false, bool HALFM = false>
__device__ __forceinline__ void gemm_phase(PG8_LAS unsigned char* lds, const Gemm g, const Sched& S, const Epi& E) {
    int tid_ = threadIdx.x; asm volatile("" : "+v"(tid_));
    const int tid = tid_, wid = __builtin_amdgcn_readfirstlane(tid >> 6), lane = tid & 63, wr = wid >> 2, wc = wid & 3, fr = lane & 15, fq = lane >> 4;
    static_assert(!HALFM || SP2, "HALFM is written for the SP2 loop");
    const int K = g.K, nt = g.nkt ? g.nkt : K / BK;
    unsigned voffA[2], voffB[2];
#pragma unroll
    for (int i = 0; i < 2; ++i) { int R, C; stage_rc(tid * 16 + i * 8192, R, C); const int Rb = Epi::PERM ? ((R & ~31) + perm32(R & 31)) : R;
        voffA[i] = (unsigned)(R * K + C) * 2u; voffB[i] = (unsigned)(Rb * K + C) * 2u; }
    const size_t kstep = (size_t)(BK * 2);
    const size_t hstep = (size_t)HALF * K * 2;
    const size_t tstep = 2 * hstep;
    const unsigned ldsw = (unsigned)wid * 1024u;
    const int aoff = lds_byte(wr * 64 + fr, fq * 8), boff = lds_byte(wc * 32 + fr, fq * 8);
#define PG8_SA(b, h) (((b) * 2 + (h)) * HTB)
#define PG8_SB(b, h) ((4 + (b) * 2 + (h)) * HTB)
#define PG8_STAGE(bufoff, gbase, voff) do { _Pragma("unroll") for (int _i = 0; _i < 2; ++_i) \
        __builtin_amdgcn_global_load_lds((const unsigned*)((const char*)(gbase) + (voff)[_i]), (PG8_LAS unsigned*)(lds + (bufoff) + ldsw + _i * 8192), 16, 0, 0); } while (0)
#define PG8_LDA(dst, b, h) do { _Pragma("unroll") for (int m = 0; m < 4; ++m) _Pragma("unroll") for (int k = 0; k < 2; ++k) dst[m][k] = *(const PG8_LAS bf16x8*)(lds + PG8_SA(b, h) + aoff + m * 2048 + k * 1024); } while (0)
#define PG8_LDB(dst, b, h) do { _Pragma("unroll") for (int n = 0; n < 2; ++n) _Pragma("unroll") for (int k = 0; k < 2; ++k) dst[n][k] = *(const PG8_LAS bf16x8*)(lds + PG8_SB(b, h) + boff + n * 2048 + k * 1024); } while (0)
#define PG8_MMA(ai, bj, At, Bt) do { __builtin_amdgcn_s_setprio(1); _Pragma("unroll") for (int m = 0; m < 4; ++m) _Pragma("unroll") for (int n = 0; n < 2; ++n) _Pragma("unroll") for (int k = 0; k < 2; ++k) \
        acc[ai][bj][m][n] = __builtin_amdgcn_mfma_f32_16x16x32_bf16(Bt[n][k], At[m][k], acc[ai][bj][m][n], 0, 0, 0); __builtin_amdgcn_s_setprio(0); } while (0)
#define PG8_WAIT_V(n) asm volatile("s_waitcnt vmcnt(" #n ")" ::: "memory")
#define PG8_WAIT_L(n) asm volatile("s_waitcnt lgkmcnt(" #n ")" ::: "memory")
#define PG8_BAR __builtin_amdgcn_s_barrier()
#define PG8_SCHED __builtin_amdgcn_sched_barrier(0)
    Unit cur, nxt; int ui = 0;
    if (!S.next(0, cur)) return;
    f32x4 acc[2][2][4][2];
#pragma unroll
    for (int a = 0; a < 2; ++a)
#pragma unroll
        for (int b = 0; b < 2; ++b)
#pragma unroll
            for (int m = 0; m < 4; ++m)
#pragma unroll
                for (int n = 0; n < 2; ++n) acc[a][b][m][n] = (f32x4){0.f, 0.f, 0.f, 0.f};
    bf16x8 At[4][2], B0[2][2], B1[2][2];
    const char* cA = (const char*)g.A + (size_t)cur.pm * tstep + (size_t)cur.roff * K * 2; const char* cB = (const char*)g.Bt + (size_t)cur.pn * tstep;
    S.a_ready(cur);
    if constexpr (SP2) {
        PG8_STAGE(PG8_SB(0, 0), cB, voffB); PG8_STAGE(PG8_SB(0, 1), cB + hstep, voffB); PG8_STAGE(PG8_SA(0, 0), cA, voffA); PG8_STAGE(PG8_SA(0, 1), cA + hstep, voffA);
        if (wr == 1) PG8_BAR;
        PG8_WAIT_V(2); PG8_BAR;
        PG8_STAGE(PG8_SB(1, 0), cB + kstep, voffB); PG8_STAGE(PG8_SA(1, 0), cA + kstep, voffA); PG8_STAGE(PG8_SB(1, 1), cB + hstep + kstep, voffB);
        PG8_WAIT_V(6); PG8_BAR;
    } else {
        PG8_STAGE(PG8_SB(0, 0), cB, voffB); PG8_STAGE(PG8_SA(0, 0), cA, voffA); PG8_STAGE(PG8_SB(0, 1), cB + hstep, voffB); PG8_STAGE(PG8_SA(0, 1), cA + hstep, voffA);
        if (wr == 1) PG8_BAR;
        PG8_WAIT_V(4); PG8_BAR;
        PG8_STAGE(PG8_SB(1, 0), cB + kstep, voffB); PG8_STAGE(PG8_SA(1, 0), cA + kstep, voffA); PG8_STAGE(PG8_SB(1, 1), cB + hstep + kstep, voffB);
        PG8_WAIT_V(6); PG8_BAR;
    }
    for (;;) {
        const bool has_next = S.next(ui + 1, nxt);
        const char* nA = has_next ? (const char*)g.A + (size_t)nxt.pm * tstep + (size_t)nxt.roff * K * 2 : cA; const char* nB = has_next ? (const char*)g.Bt + (size_t)nxt.pn * tstep : cB;
        for (int t = 0; t < nt; t += 2) {
            const bool last = (t == nt - 2);
            const char* a1 = cA + (size_t)(t + 1) * kstep;
            const char* a2 = last ? nA : cA + (size_t)(t + 2) * kstep; const char* b2 = last ? nB : cB + (size_t)(t + 2) * kstep;
            const char* a3 = a2 + kstep; const char* b3 = b2 + kstep;
            if (last && has_next) S.a_ready(nxt);
            if constexpr (SP2) {
            PG8_LDB(B0, 0, 0); PG8_LDB(B1, 0, 1); PG8_SCHED; PG8_LDA(At, 0, 0); PG8_STAGE(PG8_SA(1, 1), a1 + hstep, voffA);
            PG8_WAIT_V(8); PG8_WAIT_L(0); PG8_BAR; PG8_MMA(0, 0, At, B0); PG8_MMA(0, 1, At, B1); PG8_BAR; PG8_SCHED;
            if constexpr (!HALFM) PG8_LDA(At, 0, 1); PG8_STAGE(PG8_SB(0, 0), b2, voffB); PG8_STAGE(PG8_SB(0, 1), b2 + hstep, voffB); PG8_STAGE(PG8_SA(0, 0), a2, voffA);
            PG8_WAIT_V(8); PG8_WAIT_L(0); PG8_BAR; if constexpr (!HALFM) { PG8_MMA(1, 0, At, B0); PG8_MMA(1, 1, At, B1); } PG8_BAR; PG8_SCHED;
            PG8_LDB(B0, 1, 0); PG8_LDB(B1, 1, 1); PG8_SCHED; PG8_LDA(At, 1, 0); PG8_STAGE(PG8_SA(0, 1), a2 + hstep, voffA);
            PG8_WAIT_V(8); PG8_WAIT_L(0); PG8_BAR; PG8_MMA(0, 0, At, B0); PG8_MMA(0, 1, At, B1); PG8_BAR; PG8_SCHED;
            if constexpr (!HALFM) PG8_LDA(At, 1, 1); PG8_STAGE(PG8_SB(1, 0), b3, voffB); PG8_STAGE(PG8_SB(1, 1), b3 + hstep, voffB); PG8_STAGE(PG8_SA(1, 0), a3, voffA);
            PG8_WAIT_V(8); PG8_WAIT_L(0); PG8_BAR; if constexpr (!HALFM) { PG8_MMA(1, 0, At, B0); PG8_MMA(1, 1, At, B1); } PG8_BAR; PG8_SCHED;
            } else {
            PG8_LDB(B0, 0, 0); PG8_SCHED; PG8_LDA(At, 0, 0); PG8_STAGE(PG8_SA(1, 1), a1 + hstep, voffA);
            PG8_WAIT_L(8); PG8_BAR; PG8_WAIT_L(0); PG8_MMA(0, 0, At, B0); PG8_BAR; PG8_SCHED;
            PG8_LDB(B1, 0, 1); PG8_STAGE(PG8_SB(0, 0), b2, voffB);
            PG8_BAR; PG8_WAIT_L(0); PG8_MMA(0, 1, At, B1); PG8_BAR;
            PG8_LDA(At, 0, 1); PG8_STAGE(PG8_SA(0, 0), a2, voffA);
            PG8_BAR; PG8_WAIT_L(0); PG8_MMA(1, 0, At, B0); PG8_BAR; PG8_SCHED;
            PG8_STAGE(PG8_SB(0, 1), b2 + hstep, voffB);
            PG8_WAIT_V(6); PG8_BAR; PG8_MMA(1, 1, At, B1); PG8_BAR;
            PG8_LDB(B0, 1, 0); PG8_SCHED; PG8_LDA(At, 1, 0); PG8_STAGE(PG8_SA(0, 1), a2 + hstep, voffA);
            PG8_WAIT_L(8); PG8_BAR; PG8_WAIT_L(0); PG8_MMA(0, 0, At, B0); PG8_BAR; PG8_SCHED;
            PG8_LDB(B1, 1, 1); PG8_STAGE(PG8_SB(1, 0), b3, voffB);
            PG8_BAR; PG8_WAIT_L(0); PG8_MMA(0, 1, At, B1); PG8_BAR;
            PG8_LDA(At, 1, 1); PG8_STAGE(PG8_SA(1, 0), a3, voffA);
            PG8_BAR; PG8_WAIT_L(0); PG8_MMA(1, 0, At, B0); PG8_BAR; PG8_SCHED;
            PG8_STAGE(PG8_SB(1, 1), b3 + hstep, voffB);
            PG8_WAIT_V(6); PG8_BAR; PG8_MMA(1, 1, At, B1); PG8_BAR;
            }
        }
        if constexpr (ALIGN_EPI) { if (wr == 0) PG8_BAR; }
        if constexpr (!Epi::AFTER_DRAIN) { E(acc, cur, wr, wc, fr, fq); S.done(cur); }
        if (!has_next) break;
#pragma unroll
        for (int a = 0; a < 2; ++a)
#pragma unroll
            for (int b = 0; b < 2; ++b)
#pragma unroll
                for (int m = 0; m < 4; ++m)
#pragma unroll
                    for (int n = 0; n < 2; ++n) acc[a][b][m][n] = (f32x4){0.f, 0.f, 0.f, 0.f};
        cur = nxt; cA = nA; cB = nB; ++ui;
        if constexpr (ALIGN_EPI) { if (wr == 1) PG8_BAR; }
    }
    PG8_WAIT_V(0);
    if constexpr (!ALIGN_EPI) { if (wr == 0) PG8_BAR; }
    PG8_BAR;
    if constexpr (Epi::AFTER_DRAIN) { E.fused(acc, cur, wr, wc, fr, fq, lds, wid, lane); S.done(cur); }
#undef PG8_SA
#undef PG8_SB
#undef PG8_STAGE
#undef PG8_LDA
#undef PG8_LDB
#undef PG8_MMA
#undef PG8_WAIT_V
#undef PG8_WAIT_L
#undef PG8_BAR
#undef PG8_SCHED
}
}

constexpr int DM = 1024, BATCH = 8, SEQ = 2048, DEPTH = 4, M = BATCH * SEQ;
constexpr int DFF = 2816, NGU = 2 * DFF, NIN = 2560, AW = 768, PWD = 256, NH = 12, HD = 64;
constexpr float NORM_EPS = 1e-6f;
constexpr float QSCALE = 0.125f * 1.4426950408889634f;

#define GAS __attribute__((address_space(1)))
#define LAS __attribute__((address_space(3)))
typedef unsigned short bf16_t;
typedef unsigned u32x4 __attribute__((ext_vector_type(4)));
typedef unsigned u32x2 __attribute__((ext_vector_type(2)));
typedef float f32x4 __attribute__((ext_vector_type(4)));
typedef float f32x16 __attribute__((ext_vector_type(16)));
typedef short bf16x8 __attribute__((ext_vector_type(8)));
typedef short s16x4 __attribute__((ext_vector_type(4)));

constexpr size_t MiB = 1u << 20;
constexpr size_t W_GU = (size_t)NGU * DM * 2, W_D = (size_t)DM * DFF * 2, W_IN = (size_t)NIN * DM * 2, W_OUT = (size_t)DM * DM * 2;
constexpr size_t LW_GU1 = 0, LW_D1 = LW_GU1 + W_GU, LW_IN = LW_D1 + W_D, LW_OUT = LW_IN + W_IN, LW_GU2 = LW_OUT + W_OUT, LW_D2 = LW_GU2 + W_GU, LW_SIZE = LW_D2 + W_D;
static_assert(LW_SIZE == 40 * MiB, "per-layer weight block");
constexpr size_t WS_W = 0;
constexpr size_t WS_XB = 160 * MiB;
constexpr size_t WS_A = 192 * MiB;
__host__ __device__ constexpr size_t off_q(int b) { return WS_A + (size_t)b * 8 * MiB; }
__host__ __device__ constexpr size_t off_vp(int b) { return WS_A + 4 * MiB + (size_t)b * 10 * MiB; }
__host__ __device__ constexpr size_t off_k(int b) { return WS_A + 5 * MiB + (size_t)b * 8 * MiB; }
__host__ __device__ constexpr size_t off_v(int b) { return WS_A + 8 * MiB + (size_t)b * 8 * MiB; }
__host__ __device__ constexpr size_t off_mix(int b) { return WS_A + (size_t)b * 7 * MiB; }
constexpr size_t WS_O = 280 * MiB;
constexpr size_t WS_STAT = 352 * MiB;
constexpr size_t WS_SSQ = 357 * MiB;
constexpr size_t WS_ROPE = 358 * MiB;
constexpr size_t WS_CTL = 359 * MiB, CTL_BYTES = 32768;
constexpr size_t WS_END = 360 * MiB;
static_assert((size_t)M * DFF * 2 <= 88 * MiB && (size_t)3 * M * NH * 2 * 4 <= 5 * MiB, "ws map");

struct Args {
    const float* x; const int* pos;
    const float *n1, *g1, *u1, *d1, *nm, *win, *pw, *ps, *wout, *n2, *g2, *u2, *d2, *nf;
    float* out; unsigned char* ws;
    float inv_freq[8];
    int never, pad;
};

namespace epi {
using pg8::Unit; using pg8::BM; using pg8::HALF;
__device__ __forceinline__ float rinv_of(const float* P, int row) {
    const f32x4* p = (const f32x4*)(P + (size_t)row * 16);
    const f32x4 a = p[0], b = p[1], c = p[2], d = p[3];
    const float s = ((a[0] + a[1]) + (a[2] + a[3])) + ((b[0] + b[1]) + (b[2] + b[3])) + ((c[0] + c[1]) + (c[2] + c[3])) + ((d[0] + d[1]) + (d[2] + d[3]));
    return __builtin_amdgcn_rsqf(s * (1.0f / DM) + NORM_EPS);
}
template <class Base> struct RinvOrder : Base {
    const float* P; LAS float* tab;
    __device__ __forceinline__ void a_ready(const Unit& u) const { int t = threadIdx.x; asm volatile("" : "+v"(t)); if (t < 256 - u.roff) tab[u.par * 256 + t] = rinv_of(P, u.pm * BM + u.roff + t); }
};
__device__ __forceinline__ float silu_mul(float g, float u) {
    const float e = __builtin_amdgcn_exp2f(-1.4426950408889634f * g);
    return g * __builtin_amdgcn_rcpf(1.0f + e) * u;
}
template <int NAI> struct EpiSwiGLU {
    static constexpr bool PERM = true, AFTER_DRAIN = false;
    bf16_t* O; const LAS float* tab;
    __device__ __forceinline__ void operator()(const f32x4 (&acc)[2][2][4][2], const Unit& u, int wr, int wc, int fr, int fq) const {
        const int row0 = u.pm * BM + u.roff + wr * 64 + fr, col0 = u.pn * HALF + wc * 32 + 8 * fq;
#pragma unroll
        for (int ai = 0; ai < NAI; ++ai)
#pragma unroll
            for (int m = 0; m < 4; ++m) {
                const int row = row0 + ai * HALF + m * 16; const float ri = tab[u.par * 256 + ai * HALF + wr * 64 + m * 16 + fr];
                const f32x4 g0 = acc[ai][0][m][0] * ri, g1 = acc[ai][0][m][1] * ri, u0 = acc[ai][1][m][0] * ri, u1 = acc[ai][1][m][1] * ri;
                u32x4 w;
                w.x = pg8::cvt_pk_bf16(silu_mul(g0[0], u0[0]), silu_mul(g0[1], u0[1])); w.y = pg8::cvt_pk_bf16(silu_mul(g0[2], u0[2]), silu_mul(g0[3], u0[3]));
                w.z = pg8::cvt_pk_bf16(silu_mul(g1[0], u1[0]), silu_mul(g1[1], u1[1])); w.w = pg8::cvt_pk_bf16(silu_mul(g1[2], u1[2]), silu_mul(g1[3], u1[3]));
                *(u32x4*)(O + (size_t)row * DFF + col0) = w;
                if (m & 1) asm volatile("" ::: "memory");
            }
    }
};
struct EpiResid {
    static constexpr bool PERM = true, AFTER_DRAIN = false;
    const float* Xin; float* X; bf16_t* XB; float* P; float scale;
    __device__ __forceinline__ void operator()(const f32x4 (&acc)[2][2][4][2], const Unit& u, int wr, int wc, int fr, int fq) const {
        const int row0 = u.pm * BM + wr * 64 + fr, col0 = u.pn * BM + wc * 32 + 8 * fq;
#pragma unroll
        for (int g2 = 0; g2 < 4; ++g2) {
            const int ai = g2 >> 1;
            f32x4 xa[2][2][2];
#pragma unroll
            for (int mm = 0; mm < 2; ++mm)
#pragma unroll
                for (int bj = 0; bj < 2; ++bj) { const float* xp = Xin + (size_t)(row0 + ai * HALF + ((g2 & 1) * 2 + mm) * 16) * DM + col0 + bj * HALF; xa[mm][bj][0] = *(const f32x4*)xp; xa[mm][bj][1] = *(const f32x4*)(xp + 4); }
#pragma unroll
            for (int mm = 0; mm < 2; ++mm) {
                const int m = (g2 & 1) * 2 + mm;
                const int row = row0 + ai * HALF + m * 16; float ss = 0.f;
#pragma unroll
                for (int bj = 0; bj < 2; ++bj) {
                    const f32x4 a = xa[mm][bj][0] + acc[ai][bj][m][0] * scale, b = xa[mm][bj][1] + acc[ai][bj][m][1] * scale;
                    float* xp = X + (size_t)row * DM + col0 + bj * HALF;
                    *(f32x4*)xp = a; *(f32x4*)(xp + 4) = b;
                    u32x4 w; w.x = pg8::cvt_pk_bf16(a[0], a[1]); w.y = pg8::cvt_pk_bf16(a[2], a[3]); w.z = pg8::cvt_pk_bf16(b[0], b[1]); w.w = pg8::cvt_pk_bf16(b[2], b[3]);
                    *(u32x4*)(XB + (size_t)row * DM + col0 + bj * HALF) = w;
                    ss += (a[0] * a[0] + a[1] * a[1]) + (a[2] * a[2] + a[3] * a[3]) + (b[0] * b[0] + b[1] * b[1]) + (b[2] * b[2] + b[3] * b[3]);
                }
                ss += __shfl_xor(ss, 16); ss += __shfl_xor(ss, 32);
                if (fq == 0) P[(size_t)row * 16 + u.pn * 4 + wc] = ss;
            }
            asm volatile("" ::: "memory");
        }
    }
};
template <int NAI> struct EpiProj {
    static constexpr bool PERM = true, AFTER_DRAIN = false;
    bf16_t *VP, *Q, *K, *V; const LAS float* tab; const float* CS;
    __device__ __forceinline__ void operator()(const f32x4 (&acc)[2][2][4][2], const Unit& u, int wr, int wc, int fr, int fq) const {
        const int pn = u.pn;
        bf16_t* dst; int ld, cb;
        if (pn == 0) { dst = VP; ld = PWD; cb = 0; } else if (pn < 4) { dst = Q; ld = AW; cb = (pn - 1) * 256; } else if (pn < 7) { dst = K; ld = AW; cb = (pn - 4) * 256; } else { dst = V; ld = AW; cb = (pn - 7) * 256; }
        const bool ropetile = (pn >= 1 && pn <= 6);
        const bool ropelane = ropetile && !(wc & 1) && (fq < 2);
        const float sgn = (fq == 0) ? -1.f : 1.f;
        const float qs = (pn >= 1 && pn < 4) ? QSCALE : 1.f;
        const int row0 = u.pm * BM + u.roff + wr * 64 + fr, col0 = cb + wc * 32 + 8 * fq;
#pragma unroll
        for (int ai = 0; ai < NAI; ++ai)
#pragma unroll
            for (int m = 0; m < 4; ++m) {
                const int row = row0 + ai * HALF + m * 16; const float ri = tab[u.par * 256 + ai * HALF + wr * 64 + m * 16 + fr];
                f32x4 c0 = {1.f, 1.f, 1.f, 1.f}, c1 = c0, s0 = {0.f, 0.f, 0.f, 0.f}, s1 = s0;
                if (ropelane) { const f32x4* cs = (const f32x4*)(CS + (size_t)row * 16); c0 = cs[0]; c1 = cs[1]; s0 = cs[2]; s1 = cs[3]; }
#pragma unroll
                for (int bj = 0; bj < 2; ++bj) {
                    f32x4 v0 = acc[ai][bj][m][0] * ri, v1 = acc[ai][bj][m][1] * ri;
                    if (ropetile) {
                        f32x4 p0, p1;
#pragma unroll
                        for (int j = 0; j < 4; ++j) { p0[j] = __shfl_xor(v0[j], 16); p1[j] = __shfl_xor(v1[j], 16); }
                        if (ropelane) { v0 = v0 * c0 + p0 * s0 * sgn; v1 = v1 * c1 + p1 * s1 * sgn; }
                    }
                    v0 = v0 * qs; v1 = v1 * qs;
                    u32x4 w; w.x = pg8::cvt_pk_bf16(v0[0], v0[1]); w.y = pg8::cvt_pk_bf16(v0[2], v0[3]); w.z = pg8::cvt_pk_bf16(v1[0], v1[1]); w.w = pg8::cvt_pk_bf16(v1[2], v1[3]);
                    *(u32x4*)(dst + (size_t)row * ld + col0 + bj * HALF) = w;
                }
                if (m & 1) asm volatile("" ::: "memory");
            }
    }
};
}

namespace att {
constexpr int NSLOT = 448, KCS = NSLOT * 16 + 16, VDS = NSLOT * 64 + 64;
constexpr int L_K = 0, L_V = 8 * KCS, L_WS = L_V + 2 * VDS, L_OST = L_WS + 8 * 256, L_END = L_OST + 8 * 4096;
static_assert(L_END <= 149760, "attention LDS");
__device__ __forceinline__ int crow(int r, int hi) { return (r & 3) + 8 * (r >> 2) + 4 * hi; }
__device__ __forceinline__ s16x4 vtr(const LAS unsigned char* p) { return __builtin_bit_cast(s16x4, __builtin_amdgcn_ds_read_tr16_b64_v4i16((LAS s16x4*)p)); }
struct UD { int b, h, br, u; };
__device__ __forceinline__ UD decode(int uidg) { UD x; x.u = uidg & 7; x.br = (uidg >> 3) % 3; const int bh = uidg / 24; x.b = bh / NH; x.h = bh % NH; return x; }

__device__ __forceinline__ void load_kv(u32x4 (&val)[14], const UD& x, const unsigned char* ws, int tid) {
    const int br = x.br, u = x.u, sub = tid & 15, s0 = tid >> 4;
    const bf16_t* base = (const bf16_t*)(ws + ((sub < 8) ? off_k(x.b) : off_v(x.b))) + (size_t)x.b * SEQ * AW + x.h * HD + (sub & 7) * 8;
    if (br < 2) {
        const int d = (br == 0) ? 1 : 4, L = SEQ / d, T0 = (br == 0) ? 256 * u : 256 * (u & 1), cls = (br == 0) ? 0 : (u >> 1);
        const int k0 = T0 - 64 + s0;
        const bf16_t* p0 = base + ((long)k0 * d + cls) * AW; const long stride = (long)32 * d * AW;
#pragma unroll
        for (int i = 0; i < 14; ++i) { const int key = k0 + 32 * i; val[i] = (u32x4){0u, 0u, 0u, 0u};
            if ((i < 12) && (key >= 0) && (key < L)) val[i] = *(const u32x4*)(p0 + i * stride); }
    } else {
        const bf16_t* pa = base + ((long)(s0 - 64) * 16 + 2 * u) * AW; const bf16_t* pb = base + ((long)s0 * 16 + 2 * u + 1) * AW; const long stride = (long)32 * 16 * AW;
#pragma unroll
        for (int i = 0; i < 14; ++i) { val[i] = (u32x4){0u, 0u, 0u, 0u};
            if (i < 8) { const int key = s0 + 32 * i - 64; if ((key >= 0) && (key < 128)) val[i] = *(const u32x4*)(pa + i * stride); }
            else if (i < 12) val[i] = *(const u32x4*)(pb + (i - 8) * stride); }
    }
}
__device__ __forceinline__ void store_kv(LAS unsigned char* lds, const u32x4 (&val)[14], int tid) {
#pragma unroll
    for (int i = 0; i < 14; ++i) {
        const int piece = tid + 512 * i, slot = piece >> 4, sub = piece & 15;
        const int off = (sub < 8) ? (L_K + sub * KCS + slot * 16) : (L_V + ((sub - 8) >> 2) * VDS + slot * 64 + ((sub - 8) & 3) * 16);
        *(LAS u32x4*)(lds + off) = val[i];
    }
}
__device__ __forceinline__ void wave_geo(const UD& x, int wid, int& d, int& L, int& cls, int& t0, int& sbase) {
    const int br = x.br, u = x.u; d = (br == 0) ? 1 : (br == 1) ? 4 : 16; L = SEQ / d;
    if (br < 2) { const int T0 = (br == 0) ? 256 * u : 256 * (u & 1); cls = (br == 0) ? 0 : (u >> 1); t0 = T0 + 32 * wid; sbase = 32 * wid; }
    else { const int hw = wid >> 2; cls = 2 * u + hw; t0 = 32 * (wid & 3); sbase = 192 * hw + 32 * (wid & 3); }
}
__device__ __forceinline__ void load_q(bf16x8 (&qr)[4], const UD& x, const unsigned char* ws, int wid, int r32, int hi) {
    int d, L, cls, t0, sbase; wave_geo(x, wid, d, L, cls, t0, sbase);
    const bf16_t* Qb = (const bf16_t*)(ws + off_q(x.b));
    const size_t qtok = (size_t)x.b * SEQ + (size_t)(t0 + r32) * d + cls;
#pragma unroll
    for (int d0 = 0; d0 < 4; ++d0) qr[d0] = *(const bf16x8*)(Qb + qtok * AW + x.h * HD + d0 * 16 + hi * 8);
}
__device__ __forceinline__ void compute_a(LAS unsigned char* lds, const UD& x, const bf16x8 (&qr)[4], int wid, int lane, u32x4 (&pw)[10], float& mx_o, float& l_o) {
    const int r32 = lane & 31, hi = lane >> 5;
    int d, L, cls, t0, sbase; wave_geo(x, wid, d, L, cls, t0, sbase);
    f32x16 s[5];
#pragma unroll
    for (int ht = 0; ht < 5; ++ht) {
        const LAS unsigned char* kb = lds + L_K + hi * KCS + (sbase + 32 * ht + r32) * 16;
        f32x16 a = {};
#pragma unroll
        for (int d0 = 0; d0 < 4; ++d0) { const bf16x8 kf = *(const LAS bf16x8*)(kb + d0 * 2 * KCS); a = __builtin_amdgcn_mfma_f32_32x32x16_bf16(kf, qr[d0], a, 0, 0, 0); }
        s[ht] = a;
    }
    {
        const int dq = r32 - 4 * hi;
#pragma unroll
        for (int r = 0; r < 16; ++r) { const int cr = (r & 3) + 8 * (r >> 2); s[0][r] = (cr >= dq) ? s[0][r] : -INFINITY; s[4][r] = (cr <= dq) ? s[4][r] : -INFINITY; }
        if (t0 < 64) {
#pragma unroll
            for (int r = 0; r < 16; ++r) s[0][r] = -INFINITY;
            if (t0 < 32) {
#pragma unroll
                for (int r = 0; r < 16; ++r) s[1][r] = -INFINITY;
            }
        }
        if (t0 + 96 > L) {
#pragma unroll
            for (int r = 0; r < 16; ++r) s[4][r] = -INFINITY;
            if (t0 + 64 > L) {
#pragma unroll
                for (int r = 0; r < 16; ++r) s[3][r] = -INFINITY;
            }
        }
    }
    float mx = s[2][0];
#pragma unroll
    for (int ht = 0; ht < 5; ++ht)
#pragma unroll
        for (int r = 0; r < 16; ++r) mx = fmaxf(mx, s[ht][r]);
    mx = fmaxf(mx, __shfl_xor(mx, 32));
    float lsum = 0.f;
#pragma unroll
    for (int ht = 0; ht < 5; ++ht)
#pragma unroll
        for (int r = 0; r < 16; ++r) { const float p = __builtin_amdgcn_exp2f(s[ht][r] - mx); s[ht][r] = p; lsum += p; }
    lsum += __shfl_xor(lsum, 32);
#pragma unroll
    for (int g = 0; g < 10; ++g) {
        const int ht = g >> 1, rb = (g & 1) * 8;
        pw[g].x = pg8::cvt_pk_bf16(s[ht][rb + 0], s[ht][rb + 1]); pw[g].y = pg8::cvt_pk_bf16(s[ht][rb + 2], s[ht][rb + 3]); pw[g].z = pg8::cvt_pk_bf16(s[ht][rb + 4], s[ht][rb + 5]); pw[g].w = pg8::cvt_pk_bf16(s[ht][rb + 6], s[ht][rb + 7]);
    }
    mx_o = mx; l_o = lsum;
}
__device__ __forceinline__ void compute_b(LAS unsigned char* lds, const UD& x, unsigned char* ws, int wid, int lane, const u32x4 (&pw)[10], float mx, float lsum) {
    const int r32 = lane & 31, hi = lane >> 5;
    int d, L, cls, t0, sbase; wave_geo(x, wid, d, L, cls, t0, sbase);
    const size_t tokb = (size_t)x.b * SEQ;
    const size_t qtok = tokb + (size_t)(t0 + r32) * d + cls;
    f32x16 o[2]; o[0] = f32x16{}; o[1] = f32x16{};
    const int vlane = ((lane >> 4) & 1) * 32 + (lane & 3) * 8 + (4 * hi + ((lane & 15) >> 2)) * 64;
#pragma unroll
    for (int g = 0; g < 10; ++g) {
        const bf16x8 pa = __builtin_bit_cast(bf16x8, pw[g]);
#pragma unroll
        for (int d0 = 0; d0 < 2; ++d0) {
            const LAS unsigned char* vp = lds + L_V + d0 * VDS + (sbase + 16 * g) * 64 + vlane;
            const s16x4 lo = vtr(vp), hh = vtr(vp + 512);
            const bf16x8 vf = (bf16x8){lo[0], lo[1], lo[2], lo[3], hh[0], hh[1], hh[2], hh[3]};
            o[d0] = __builtin_amdgcn_mfma_f32_32x32x16_bf16(pa, vf, o[d0], 0, 0, 0);
        }
    }
    LAS float* wsf = (LAS float*)(lds + L_WS + wid * 256);
    LAS bf16_t* stg = (LAS bf16_t*)(lds + L_OST + wid * 4096);
    if (hi == 0) {
        wsf[r32] = lsum;
        float* st = (float*)(ws + WS_STAT) + (((size_t)x.br * M + qtok) * NH + x.h) * 2; st[0] = mx; st[1] = lsum;
    }
    asm volatile("s_waitcnt lgkmcnt(0)" ::: "memory");
#pragma unroll
    for (int r = 0; r < 16; ++r) {
        const int qrow = crow(r, hi); const float rl = __builtin_amdgcn_rcpf(wsf[qrow]);
        const unsigned a = pg8::cvt_pk_bf16(o[0][r] * rl, o[1][r] * rl);
        stg[qrow * 64 + r32] = (bf16_t)(a & 0xffffu); stg[qrow * 64 + 32 + r32] = (bf16_t)(a >> 16);
    }
    asm volatile("s_waitcnt lgkmcnt(0)" ::: "memory");
    bf16_t* Ob = (bf16_t*)(ws + WS_O) + (size_t)x.br * M * AW;
#pragma unroll
    for (int i = 0; i < 4; ++i) {
        const int row = i * 8 + (lane >> 3), ch = lane & 7;
        const u32x4 v = *(const LAS u32x4*)(stg + row * 64 + ch * 8);
        *(u32x4*)(Ob + (tokb + (size_t)(t0 + row) * d + cls) * AW + x.h * HD + ch * 8) = v;
    }
}
__device__ __forceinline__ void phase(LAS unsigned char* lds, unsigned char* ws, int first, int step, int limit) {
    int tid_ = threadIdx.x; asm volatile("" : "+v"(tid_));
    const int tid = tid_, lane = tid & 63; const int wid = __builtin_amdgcn_readfirstlane(tid >> 6);
    if (first >= limit) return;
    u32x4 val[14];
    load_kv(val, decode(first), ws, tid);
    for (int uid = first; uid < limit; uid += step) {
        const UD x = decode(uid);
        bf16x8 qr[4]; load_q(qr, x, ws, wid, lane & 31, lane >> 5);
        store_kv(lds, val, tid);
        __syncthreads();
        u32x4 pw[10]; float mx, lsum;
        compute_a(lds, x, qr, wid, lane, pw, mx, lsum);
        if (uid + step < limit) load_kv(val, decode(uid + step), ws, tid);
        compute_b(lds, x, ws, wid, lane, pw, mx, lsum);
        __syncthreads();
    }
}
}

__device__ __forceinline__ float bf2f(unsigned short h) { return __uint_as_float((unsigned)h << 16); }
__device__ __forceinline__ float wave_sum(float v) {
#pragma unroll
    for (int o = 1; o < 64; o <<= 1) v += __shfl_xor(v, o);
    return v;
}
__device__ __forceinline__ unsigned f2bf(float f) { unsigned u = __float_as_uint(f); return (u + 0x7fffu + ((u >> 16) & 1u)) >> 16; }
__device__ __forceinline__ unsigned pk2(float lo, float hi) { return f2bf(lo) | (f2bf(hi) << 16); }

struct TrItem { const float* W; const float* gain; bf16_t* WT; int N, k0, n0, ldw, drow0; };
__device__ __forceinline__ void tr_load(f32x4 (&v)[16], const TrItem& t, int lane) {
    const int kr = lane >> 4, nc = 4 * (lane & 15);
#pragma unroll
    for (int i = 0; i < 16; ++i) v[i] = *(const f32x4*)(t.W + (size_t)(t.k0 + 4 * i + kr) * t.N + t.n0 + nc);
}
__device__ __forceinline__ void tr_finish(const f32x4 (&v)[16], const TrItem& t, LAS float* scr, int lane) {
    const int kr = lane >> 4, nc = 4 * (lane & 15);
#pragma unroll
    for (int i = 0; i < 16; ++i) { const int kk = 4 * i + kr; const float gg = t.gain ? t.gain[t.k0 + kk] : 1.f; LAS float* s = scr + kk * 65 + nc;
        s[0] = v[i][0] * gg; s[1] = v[i][1] * gg; s[2] = v[i][2] * gg; s[3] = v[i][3] * gg; }
    asm volatile("s_waitcnt lgkmcnt(0)" ::: "memory");
    const int c = lane & 7;
#pragma unroll
    for (int j = 0; j < 8; ++j) { const int n = (lane >> 3) + 8 * j; const LAS float* s = scr + (8 * c) * 65 + n;
        u32x4 o; o.x = pk2(s[0 * 65], s[1 * 65]); o.y = pk2(s[2 * 65], s[3 * 65]); o.z = pk2(s[4 * 65], s[5 * 65]); o.w = pk2(s[6 * 65], s[7 * 65]);
        *(u32x4*)(t.WT + (size_t)(t.drow0 + n) * t.ldw + t.k0 + 8 * c) = o; }
    asm volatile("s_waitcnt lgkmcnt(0)" ::: "memory");
}
constexpr int I_G = 16 * 44, I_D = 44 * 16, I_IN = 16 * 40, I_O = 12 * 16, I_LAYER = 6 * I_G + I_IN + I_O;
static_assert(I_G == I_D, "item counts");
__device__ __forceinline__ TrItem tr_decode(const Args& a, int it) {
    TrItem t; const int l = it / I_LAYER; int r = it % I_LAYER;
    unsigned char* wl = a.ws + WS_W + (size_t)l * LW_SIZE;
    if (r < 6 * I_G) {
        const int seg = r / I_G; r = r % I_G;
        const int ffn = seg / 3, kind = seg % 3;
        if (kind < 2) {
            t.W = (kind == 0 ? (ffn ? a.g2 : a.g1) : (ffn ? a.u2 : a.u1)) + (size_t)l * DM * DFF; t.gain = (ffn ? a.n2 : a.n1) + (size_t)l * DM;
            t.WT = (bf16_t*)(wl + (ffn ? LW_GU2 : LW_GU1)); t.N = DFF; t.ldw = DM;
            const int kb = r / 44, nb = r % 44; t.k0 = 64 * kb; t.n0 = 64 * nb; t.drow0 = 256 * (t.n0 / 128) + 128 * kind + (t.n0 % 128);
        } else {
            t.W = (ffn ? a.d2 : a.d1) + (size_t)l * DFF * DM; t.gain = nullptr; t.WT = (bf16_t*)(wl + (ffn ? LW_D2 : LW_D1)); t.N = DM; t.ldw = DFF;
            const int kb = r / 16, nb = r % 16; t.k0 = 64 * kb; t.n0 = 64 * nb; t.drow0 = 64 * nb;
        }
    } else if (r < 6 * I_G + I_IN) {
        r -= 6 * I_G; const int kb = r / 40, nb = r % 40;
        t.W = a.win + (size_t)l * DM * NIN; t.gain = a.nm + (size_t)l * DM; t.WT = (bf16_t*)(wl + LW_IN); t.N = NIN; t.ldw = DM; t.k0 = 64 * kb; t.n0 = 64 * nb; t.drow0 = 64 * nb;
    } else {
        r -= 6 * I_G + I_IN; const int kb = 4 + r / 16, nb = r % 16;
        t.W = a.wout + (size_t)l * DM * DM; t.gain = nullptr; t.WT = (bf16_t*)(wl + LW_OUT); t.N = DM; t.ldw = DM; t.k0 = 64 * kb; t.n0 = 64 * nb; t.drow0 = 64 * nb;
    }
    return t;
}

__device__ __forceinline__ void prologue(const Args& a, LAS unsigned char* lds, int vcu, int G) {
    const int tid = threadIdx.x, lane = tid & 63, wave = __builtin_amdgcn_readfirstlane(tid >> 6);
    LAS float* scr = (LAS float*)(lds + wave * 16640);
    const int gw = vcu * 8 + wave, NGW = G * 8;
    unsigned char* ws = a.ws;
    if (gw < DEPTH * I_LAYER) {
        TrItem cur = tr_decode(a, gw); f32x4 va[16]; tr_load(va, cur, lane);
        for (int it = gw; it < DEPTH * I_LAYER; it += NGW) {
            const bool more = it + NGW < DEPTH * I_LAYER;
            TrItem nxt = cur; f32x4 vb[16];
            if (more) { nxt = tr_decode(a, it + NGW); tr_load(vb, nxt, lane); }
            tr_finish(va, cur, scr, lane);
            if (more) {
#pragma unroll
                for (int i = 0; i < 16; ++i) va[i] = vb[i];
                cur = nxt; }
        }
    }
    for (int it = gw; it < DEPTH * 4 * 8 * 16; it += NGW) {
        const int l = it >> 9, g = (it >> 7) & 3, c8 = (it >> 4) & 7, n = (it & 15) * 64 + lane;
        const float* wo = a.wout + (size_t)l * DM * DM + (size_t)(g * 64) * DM + n;
        const float* sc = a.ps + (size_t)l * PWD + g * 64;
        const float* pr = a.pw + (((size_t)l * 4 + g) * 64 + c8 * 8) * 64;
        float acc[8] = {0.f, 0.f, 0.f, 0.f, 0.f, 0.f, 0.f, 0.f};
#pragma unroll 4
        for (int dd = 0; dd < 64; ++dd) { const float wv = wo[(size_t)dd * DM] * sc[dd];
#pragma unroll
            for (int e = 0; e < 8; ++e) acc[e] += pr[e * 64 + dd] * wv; }
        u32x4 o; o.x = pk2(acc[0], acc[1]); o.y = pk2(acc[2], acc[3]); o.z = pk2(acc[4], acc[5]); o.w = pk2(acc[6], acc[7]);
        *(u32x4*)((bf16_t*)(ws + WS_W + (size_t)l * LW_SIZE + LW_OUT) + (size_t)n * DM + g * 64 + c8 * 8) = o;
    }
    bf16_t* XB = (bf16_t*)(ws + WS_XB); float* P = (float*)(ws + WS_SSQ); float* CS = (float*)(ws + WS_ROPE);
    for (int mp = gw; mp < M; mp += 2 * NGW) {
        f32x4 v[2][4];
#pragma unroll
        for (int q = 0; q < 2; ++q) { const int m = (mp + q * NGW < M) ? mp + q * NGW : mp; const f32x4* xr = (const f32x4*)(a.x + (size_t)m * DM) + lane;
#pragma unroll
            for (int j = 0; j < 4; ++j) v[q][j] = xr[64 * j]; }
#pragma unroll
        for (int q = 0; q < 2; ++q) {
            const int m = (mp + q * NGW < M) ? mp + q * NGW : mp;
            u32x2* xb = (u32x2*)(XB + (size_t)m * DM) + lane;
            float s = 0.f;
#pragma unroll
            for (int j = 0; j < 4; ++j) { const f32x4 x4 = v[q][j]; s += (x4[0] * x4[0] + x4[1] * x4[1]) + (x4[2] * x4[2] + x4[3] * x4[3]);
                u32x2 w; w.x = pk2(x4[0], x4[1]); w.y = pk2(x4[2], x4[3]); xb[64 * j] = w; }
            s = wave_sum(s);
            if (lane < 16) P[(size_t)m * 16 + lane] = (lane == 0) ? s : 0.f;
            if (lane < 8) {
                const float ang = (float)a.pos[m] * a.inv_freq[lane];
                double rev = (double)ang * 0.15915494309189535; rev -= floor(rev);
                const float fr = (float)rev;
                CS[(size_t)m * 16 + lane] = __builtin_amdgcn_cosf(fr); CS[(size_t)m * 16 + 8 + lane] = __builtin_amdgcn_sinf(fr);
            }
        }
    }
}

__device__ __forceinline__ void combine_phase(const Args& a, int wv0, int nwv, int tok0, int ntok) {
    int tid_ = threadIdx.x; asm volatile("" : "+v"(tid_));
    const int tid = tid_, lane = tid & 63, wave = __builtin_amdgcn_readfirstlane(tid >> 6);
    const int gw = wv0 + wave, NGW = nwv;
    unsigned char* ws = a.ws;
    const bf16_t* __restrict__ O = (const bf16_t*)(ws + WS_O); const float* __restrict__ ST = (const float*)(ws + WS_STAT);
    const int g = lane >> 4, hw = 1 << g;
    for (int tokp = tok0 + gw; tokp < tok0 + ntok; tokp += 2 * NGW) {
        u32x2 vv[2][16], me[2]; int cnt[2]; float mm[2][2][3], ll[2][2][3]; u32x4 ov[2][2][3];
#pragma unroll
        for (int q = 0; q < 2; ++q) {
            const int tok = (tokp + q * NGW < tok0 + ntok) ? tokp + q * NGW : tokp;
            const int bb = tok >> 11, s = tok & (SEQ - 1);
            const bf16_t* base = (const bf16_t*)(ws + off_vp(bb)) + (size_t)(tok - s) * PWD + 4 * lane;
            cnt[q] = 0;
#pragma unroll
            for (int jj = 0; jj < 16; ++jj) { const int j = s - hw + jj; const bool ok = (jj < 2 * hw) && (j >= 0) && (j < SEQ);
                vv[q][jj] = (u32x2){0u, 0u}; if (ok) vv[q][jj] = *(const u32x2*)(base + (size_t)j * PWD); cnt[q] += ok ? 1 : 0; }
            me[q] = *(const u32x2*)(base + (size_t)s * PWD);
#pragma unroll
            for (int it = 0; it < 2; ++it) {
                const int chunk = (it * 64 + lane < 96) ? it * 64 + lane : 95, h = chunk >> 3;
#pragma unroll
                for (int i = 0; i < 3; ++i) { const float* st = ST + (((size_t)i * M + tok) * NH + h) * 2; mm[q][it][i] = st[0]; ll[q][it][i] = st[1]; ov[q][it][i] = *(const u32x4*)(O + ((size_t)i * M + tok) * AW + chunk * 8); }
            }
        }
#pragma unroll
        for (int q = 0; q < 2; ++q) {
            const int tok = (tokp + q * NGW < tok0 + ntok) ? tokp + q * NGW : tokp;
            bf16_t* MIX = (bf16_t*)(ws + off_mix(tok >> 11));
            float s0 = 0.f, s1 = 0.f, s2 = 0.f, s3 = 0.f;
#pragma unroll
            for (int jj = 0; jj < 16; ++jj) { s0 += __uint_as_float(vv[q][jj].x << 16); s1 += __uint_as_float(vv[q][jj].x & 0xffff0000u); s2 += __uint_as_float(vv[q][jj].y << 16); s3 += __uint_as_float(vv[q][jj].y & 0xffff0000u); }
            const float rc = 1.0f / (float)cnt[q];
            u32x2 w2; w2.x = pk2(s0 * rc - __uint_as_float(me[q].x << 16), s1 * rc - __uint_as_float(me[q].x & 0xffff0000u)); w2.y = pk2(s2 * rc - __uint_as_float(me[q].y << 16), s3 * rc - __uint_as_float(me[q].y & 0xffff0000u));
            *(u32x2*)(MIX + (size_t)tok * DM + 4 * lane) = w2;
#pragma unroll
            for (int it = 0; it < 2; ++it) {
                const int chunk = it * 64 + lane;
                float mxx = fmaxf(fmaxf(mm[q][it][0], mm[q][it][1]), mm[q][it][2]);
                float wgt[3], den = 0.f;
#pragma unroll
                for (int i = 0; i < 3; ++i) { wgt[i] = __builtin_amdgcn_exp2f(mm[q][it][i] - mxx) * ll[q][it][i]; den += wgt[i]; }
                const float rd = 1.0f / den;
                float acc[8] = {0.f, 0.f, 0.f, 0.f, 0.f, 0.f, 0.f, 0.f};
#pragma unroll
                for (int i = 0; i < 3; ++i) { const u32x4 v = ov[q][it][i]; const float wi = wgt[i] * rd;
                    acc[0] += wi * __uint_as_float(v.x << 16); acc[1] += wi * __uint_as_float(v.x & 0xffff0000u); acc[2] += wi * __uint_as_float(v.y << 16); acc[3] += wi * __uint_as_float(v.y & 0xffff0000u);
                    acc[4] += wi * __uint_as_float(v.z << 16); acc[5] += wi * __uint_as_float(v.z & 0xffff0000u); acc[6] += wi * __uint_as_float(v.w << 16); acc[7] += wi * __uint_as_float(v.w & 0xffff0000u); }
                u32x4 w; w.x = pk2(acc[0], acc[1]); w.y = pk2(acc[2], acc[3]); w.z = pk2(acc[4], acc[5]); w.w = pk2(acc[6], acc[7]);
                if (chunk < 96) *(u32x4*)(MIX + (size_t)tok * DM + PWD + chunk * 8) = w;
            }
        }
    }
}

__device__ __forceinline__ void final_norm(const Args& a, int wv0, int nwv, int tok0, int ntok) {
    const int tid = threadIdx.x, lane = tid & 63, wave = __builtin_amdgcn_readfirstlane(tid >> 6);
    const int gw = wv0 + wave, NGW = nwv;
    const f32x4* gr = (const f32x4*)a.nf + lane;
    for (int mp = tok0 + gw; mp < tok0 + ntok; mp += 2 * NGW) {
        f32x4 v[2][4];
#pragma unroll
        for (int q = 0; q < 2; ++q) { const int m = (mp + q * NGW < tok0 + ntok) ? mp + q * NGW : mp; const f32x4* xr = (const f32x4*)(a.out + (size_t)m * DM) + lane;
#pragma unroll
            for (int j = 0; j < 4; ++j) v[q][j] = xr[64 * j]; }
        float ri[2];
#pragma unroll
        for (int q = 0; q < 2; ++q) { float s = 0.f;
#pragma unroll
            for (int j = 0; j < 4; ++j) s += (v[q][j][0] * v[q][j][0] + v[q][j][1] * v[q][j][1]) + (v[q][j][2] * v[q][j][2] + v[q][j][3] * v[q][j][3]);
            ri[q] = 1.0f / sqrtf(wave_sum(s) * (1.0f / DM) + NORM_EPS); }
#pragma unroll
        for (int q = 0; q < 2; ++q) { if (q == 1 && mp + NGW >= tok0 + ntok) break; const int m = mp + q * NGW; f32x4* xr = (f32x4*)(a.out + (size_t)m * DM) + lane;
#pragma unroll
            for (int j = 0; j < 4; ++j) xr[64 * j] = v[q][j] * ri[q] * gr[64 * j]; }
    }
}

#define XB_TMO      128
#define XB_XCNT(j)  (256  + 64 * (j))
#define XB_XSUB(j)  (1280 + 64 * (j))
#define XB_XGEN(j)  (2304 + 64 * (j))
#define XB_TOP      3328
#define XB_TOPGEN   3392
#define XCD_BAR_WORDS 3456
#define XB_SPIN_CAP (1u << 18)

__device__ __forceinline__ unsigned xb_ld(unsigned* p)              { return __hip_atomic_load(p, __ATOMIC_RELAXED, __HIP_MEMORY_SCOPE_AGENT); }
__device__ __forceinline__ unsigned xb_add(unsigned* p, unsigned v) { return __hip_atomic_fetch_add(p, v, __ATOMIC_RELAXED, __HIP_MEMORY_SCOPE_AGENT); }
__device__ __forceinline__ unsigned xb_xcc_id() { return (unsigned)__builtin_amdgcn_s_getreg((3 << 11) | 20) & 0xFu; }
#define XB_SPIN(cond, bar) do { unsigned _sp = 0; while (cond) { __builtin_amdgcn_s_sleep(1); \
    if ((++_sp & 255u) == 0u) { if (xb_ld(&(bar)[XB_TMO])) break; if (_sp > XB_SPIN_CAP) { atomicAdd(&(bar)[XB_TMO], 1u); break; } } } } while (0)

struct XcdBarrier {
    unsigned* bar; unsigned x;
    volatile LAS unsigned* st;
};

__device__ __forceinline__ XcdBarrier xcd_barrier_post(unsigned* bar, volatile LAS unsigned* st) {
    XcdBarrier b; b.bar = bar; b.x = xb_xcc_id(); b.st = st;
    if (threadIdx.x == 0) (void)xb_add(&bar[XB_XCNT(b.x)], 1u);
    return b;
}
__device__ __forceinline__ void xcd_barrier_complete(unsigned* bar, unsigned x, unsigned& nloc, unsigned& nx) {
    const unsigned G = gridDim.x * gridDim.y * gridDim.z;
    unsigned sum, cnt, mine, sp = 0u;
    for (;;) {
        sum = 0u; cnt = 0u; mine = 0u;
#pragma unroll
        for (unsigned j = 0; j < 16; ++j) { const unsigned c = xb_ld(&bar[XB_XCNT(j)]); sum += c; cnt += (c > 0u) ? 1u : 0u; mine = (j == x) ? c : mine; }
        if (sum == G) break;
        __builtin_amdgcn_s_sleep(1);
        if ((++sp & 255u) == 0u) { if (xb_ld(&bar[XB_TMO])) break; if (sp > XB_SPIN_CAP) { atomicAdd(&bar[XB_TMO], 1u); break; } }
    }
    nloc = mine > 0u ? mine : 1u; nx = cnt > 0u ? cnt : 1u;
}

__device__ __forceinline__ void xcd_barrier(const XcdBarrier& b) {
    asm volatile("s_waitcnt vmcnt(0)" ::: "memory");
    __syncthreads();
    if (threadIdx.x == 0) {
        unsigned* bar = b.bar;
        __builtin_amdgcn_s_waitcnt(0);
        unsigned nloc = b.st[0], nx = b.st[1];
        if (nloc == 0u) { xcd_barrier_complete(bar, b.x, nloc, nx); b.st[0] = nloc; b.st[1] = nx; }
        const unsigned old = xb_add(&bar[XB_XSUB(b.x)], 1u);
        const unsigned gen = old / nloc;
        if (old + 1u == (gen + 1u) * nloc) {
            __builtin_amdgcn_fence(__ATOMIC_RELEASE, "agent");
            asm volatile("s_waitcnt vmcnt(0)" ::: "memory");
            const unsigned og = xb_add(&bar[XB_TOP], 1u);
            const unsigned tg = og / nx;
            if (og + 1u == (tg + 1u) * nx) xb_add(&bar[XB_TOPGEN], 1u);
            else XB_SPIN(xb_ld(&bar[XB_TOPGEN]) == tg, bar);
            __builtin_amdgcn_fence(__ATOMIC_ACQUIRE, "agent");
            xb_add(&bar[XB_XGEN(b.x)], 1u);
            asm volatile("s_waitcnt vmcnt(0)" ::: "memory");
        } else {
            XB_SPIN(xb_ld(&bar[XB_XGEN(b.x)]) == gen, bar);
            __builtin_amdgcn_fence(__ATOMIC_ACQUIRE, "agent");
            asm volatile("s_waitcnt vmcnt(0)" ::: "memory");
        }
    }
    __syncthreads();
}

#define XL_RANK(j) (3520 + 64 * (j))
#define XL_CNT(j)  (4608 + 64 * (j))
__device__ __forceinline__ void local_barrier(unsigned* ctl, unsigned x) {
    asm volatile("s_waitcnt vmcnt(0)" ::: "memory");
    __syncthreads();
    if (threadIdx.x == 0) {
        __builtin_amdgcn_s_waitcnt(0);
        const unsigned old = xb_add(&ctl[XL_CNT(x)], 1u), target = (old / 32u + 1u) * 32u;
        XB_SPIN(xb_ld(&ctl[XL_CNT(x)]) < target, ctl);
        __builtin_amdgcn_fence(__ATOMIC_ACQUIRE, "agent");
        asm volatile("s_waitcnt vmcnt(0)" ::: "memory");
    }
    __syncthreads();
}

constexpr int LDS_BYTES = 152576;
__global__ void __launch_bounds__(512, 2) fwd(Args a) {
    extern __shared__ __attribute__((aligned(16))) unsigned char lds_raw[];
    LAS unsigned char* lds = (LAS unsigned char*)lds_raw;
    cg::grid_group grid = cg::this_grid();
    const int G = gridDim.x;
    const int vcu0 = (G % 8 == 0) ? ((int)blockIdx.x % 8) * (G / 8) + (int)blockIdx.x / 8 : (int)blockIdx.x;
    unsigned char* ws = a.ws;
    unsigned* ctl = (unsigned*)(ws + WS_CTL);
    bf16_t* XB = (bf16_t*)(ws + WS_XB); bf16_t* ACT = (bf16_t*)(ws + WS_A); float* P = (float*)(ws + WS_SSQ); float* CS = (float*)(ws + WS_ROPE);

    LAS float* RT = (LAS float*)(lds + 149760);
    volatile LAS unsigned* BST = (volatile LAS unsigned*)(lds + 149760 + 2048);
    const unsigned xcc = xb_xcc_id();
    if (threadIdx.x == 0) { BST[0] = 0u; BST[1] = 0u; BST[2] = xb_add(&ctl[XL_RANK(xcc)], 1u); BST[3] = 0u; }
    __syncthreads();
    const XcdBarrier bar = xcd_barrier_post(ctl, BST);
    if (a.never) grid.sync();
    prologue(a, lds, vcu0, G);
    xcd_barrier(bar);
    if (threadIdx.x == 0) {
        bool ok = (G == 256);
        for (unsigned j = 0; j < 16; ++j) { const unsigned cnt = xb_ld(&ctl[XB_XCNT(j)]); ok = ok && (cnt == (j < 8 ? 32u : 0u)); }
        BST[3] = (ok && xb_ld(&ctl[XB_TMO]) == 0u) ? 1u : 0u;
    }
    __syncthreads();
    const bool local = BST[3] != 0u;
    const int rank = (int)BST[2];
    const int bx = local ? rank * 8 + (int)xcc : (int)blockIdx.x;
    const int wv0 = local ? rank * 8 : vcu0 * 8, nwv = local ? 256 : G * 8, tok0 = local ? (int)xcc * SEQ : 0, ntok = local ? SEQ : M;
#define SEAM() do { if (local) local_barrier(ctl, xcc); else xcd_barrier(bar); } while (0)
    for (int st = 0; st < 3 * DEPTH; ++st) {
        const int l = st / 3, kind = st % 3;
        unsigned char* wl = ws + WS_W + (size_t)l * LW_SIZE;
        asm volatile("" : "+s"(wl));
        if (kind != 1) {
            const bf16_t* Wgu = (const bf16_t*)(wl + (kind ? LW_GU2 : LW_GU1)); const bf16_t* Wd = (const bf16_t*)(wl + (kind ? LW_D2 : LW_D1));
            { pg8::Gemm g{XB, Wgu, M, NGU, DM}; epi::RinvOrder<pg8::StaticOrder> S; S.init(M, NGU, G, bx); S.P = P; S.tab = RT;
              const int nfull = S.nwg / G; const bool split = false && (S.nwg - nfull * G) * 2 == G && (G % 16 == 0);
              if (split) S.imax = nfull;
              { epi::EpiSwiGLU<2> E{ACT, RT}; pg8::gemm_phase<epi::EpiSwiGLU<2>, epi::RinvOrder<pg8::StaticOrder>, true, true>(lds, g, S, E); }
              if (split) { epi::RinvOrder<pg8::HalfOrder> H; H.init(M, NGU, G, bx); H.nfull = nfull; H.P = P; H.tab = RT; epi::EpiSwiGLU<1> E{ACT, RT};
                pg8::gemm_phase<epi::EpiSwiGLU<1>, epi::RinvOrder<pg8::HalfOrder>, true, true, true>(lds, g, H, E); } }
            SEAM();
            { pg8::Gemm g{ACT, Wd, M, DM, DFF}; pg8::StaticOrder S; S.init(M, DM, G, bx); epi::EpiResid E{st == 0 ? a.x : a.out, a.out, XB, P, 0.5f};
              pg8::gemm_phase<epi::EpiResid, pg8::StaticOrder, true, true>(lds, g, S, E); }
            SEAM();
        } else {
            { pg8::Gemm g{XB, (const bf16_t*)(wl + LW_IN), M, NIN, DM}; epi::RinvOrder<pg8::StaticOrder> S; S.init(M, NIN, G, bx); S.P = P; S.tab = RT; const int bb = bx & 7;
              const int nfull = S.nwg / G; const bool split = false && (S.nwg - nfull * G) * 2 == G && (G % 16 == 0);
              if (split) S.imax = nfull;
              bf16_t* vp_ = (bf16_t*)(ws + off_vp(bb)); bf16_t* q_ = (bf16_t*)(ws + off_q(bb)); bf16_t* k_ = (bf16_t*)(ws + off_k(bb)); bf16_t* v_ = (bf16_t*)(ws + off_v(bb));
              { epi::EpiProj<2> E{vp_, q_, k_, v_, RT, CS}; pg8::gemm_phase<epi::EpiProj<2>, epi::RinvOrder<pg8::StaticOrder>, true, true>(lds, g, S, E); }
              if (split) { epi::RinvOrder<pg8::HalfOrder> H; H.init(M, NIN, G, bx); H.nfull = nfull; H.P = P; H.tab = RT; epi::EpiProj<1> E{vp_, q_, k_, v_, RT, CS};
                pg8::gemm_phase<epi::EpiProj<1>, epi::RinvOrder<pg8::HalfOrder>, true, true, true>(lds, g, H, E); } }
            SEAM();
            if (local) att::phase(lds, ws, (int)xcc * NH * 24 + rank, 32, ((int)xcc + 1) * NH * 24); else att::phase(lds, ws, bx, G, BATCH * NH * 24);
            SEAM();
            combine_phase(a, wv0, nwv, tok0, ntok);
            SEAM();
            { pg8::Gemm g{(const bf16_t*)(ws + off_mix(bx & 7)), (const bf16_t*)(wl + LW_OUT), M, DM, DM}; pg8::StaticOrder S; S.init(M, DM, G, bx); epi::EpiResid E{a.out, a.out, XB, P, 1.0f};
              pg8::gemm_phase<epi::EpiResid, pg8::StaticOrder, true, true>(lds, g, S, E); }
            SEAM();
        }
    }
    final_norm(a, wv0, nwv, tok0, ntok);
}

extern "C" void kernel_launch(void* const* d_in, const int* in_sizes, int n_in, void* d_out, int out_size, void* d_ws, size_t ws_size, hipStream_t stream) {
    static int grid = 0;
    if (grid == 0) {
        if (n_in != 16 || in_sizes[0] != M * DM || out_size != M * DM || ws_size < WS_END) { fprintf(stderr, "kernel_launch: unexpected shapes (n_in %d in0 %d out %d ws %zu)\n", n_in, n_in > 0 ? in_sizes[0] : -1, out_size, ws_size); grid = -1; return; }
        int dev = 0, cus = 0, per_cu = 0;
        if (hipGetDevice(&dev) != hipSuccess || hipDeviceGetAttribute(&cus, hipDeviceAttributeMultiprocessorCount, dev) != hipSuccess) { grid = -1; return; }
        if (hipFuncSetAttribute((const void*)fwd, hipFuncAttributeMaxDynamicSharedMemorySize, LDS_BYTES) != hipSuccess) { fprintf(stderr, "kernel_launch: hipFuncSetAttribute failed\n"); grid = -1; return; }
        if (hipOccupancyMaxActiveBlocksPerMultiprocessor(&per_cu, (const void*)fwd, 512, LDS_BYTES) != hipSuccess || per_cu < 1) fprintf(stderr, "kernel_launch: occupancy query says %d\n", per_cu);
        (void)hipGetLastError();
        grid = cus;
    }
    if (grid < 0) return;
    if (hipMemsetAsync((char*)d_ws + WS_CTL, 0, CTL_BYTES, stream) != hipSuccess) { fprintf(stderr, "kernel_launch: memset failed\n"); return; }
    Args a{};
    a.x = (const float*)d_in[0]; a.pos = (const int*)d_in[1];
    a.n1 = (const float*)d_in[2]; a.g1 = (const float*)d_in[3]; a.u1 = (const float*)d_in[4]; a.d1 = (const float*)d_in[5];
    a.nm = (const float*)d_in[6]; a.win = (const float*)d_in[7]; a.pw = (const float*)d_in[8]; a.ps = (const float*)d_in[9]; a.wout = (const float*)d_in[10];
    a.n2 = (const float*)d_in[11]; a.g2 = (const float*)d_in[12]; a.u2 = (const float*)d_in[13]; a.d2 = (const float*)d_in[14]; a.nf = (const float*)d_in[15];
    a.out = (float*)d_out; a.ws = (unsigned char*)d_ws;
    for (int i = 0; i < 8; ++i) a.inv_freq[i] = (float)pow(500000.0, -(double)i / 8.0);
    void* args[] = {&a};
    hipError_t e = hipLaunchCooperativeKernel((const void*)fwd, dim3(grid), dim3(512), args, LDS_BYTES, stream);
    if (e != hipSuccess) fprintf(stderr, "cooperative launch failed: %s (grid %d)\n", hipGetErrorString(e), grid);
}
```

```cpp
#include <hip/hip_runtime.h>
#include <hip/hip_cooperative_groups.h>
#include <cstdio>
#include <cstdint>
#include <cmath>
namespace cg = cooperative_groups;
namespace pg8 {
#define PG8_LAS __attribute__((address_space(3)))
typedef unsigned short bf16_t;
typedef short bf16x8 __attribute__((ext_vector_type(8)));
typedef float f32x4 __attribute__((ext_vector_type(4)));
typedef unsigned u32x4 __attribute__((ext_vector_type(4)));
constexpr int BM = 256, BK = 64, HALF = 128, HTB = HALF * BK * 2  , STAGE_BYTES = 8 * HTB, NXCD = 8, WGM = 8;

__host__ __device__ __forceinline__ int lds_byte(int r, int c) { const int st = (r >> 4) * 2 + (c >> 5), rr = r & 15, cc = c & 31, ob = rr * 64 + cc * 2; return st * 1024 + (ob ^ (((ob >> 9) & 1) << 5)); }
__host__ __device__ __forceinline__ void stage_rc(int b, int& R, int& C) { const int st = b / 1024, sb = b % 1024, swz = sb ^ (((sb >> 9) & 1) << 5); R = (st >> 1) * 16 + swz / 64; C = (st & 1) * 32 + (swz % 64) / 2; }
__host__ __device__ __forceinline__ int perm32(int rho) { const int n = rho >> 4, i = rho & 15; return 8 * (i >> 2) + 4 * n + (i & 3); }

struct Unit { int pm, pn, par, roff; };
struct Gemm { const bf16_t* A; const bf16_t* Bt; int M, N, K, nkt; };

struct StaticOrder {
    int nM, nN, nwg, G, c, imax;
    __host__ __device__ void init(int M, int N, int G_, int c_) { nM = M / BM; nN = N / BM; nwg = nM * nN; G = G_; c = c_; imax = 1 << 30; }
    __host__ __device__ void decode(long L, Unit& u) const {
        int wgid = (int)L; { const int q = nwg / NXCD, r = nwg % NXCD, xcd = wgid % NXCD, off = wgid / NXCD; wgid = (xcd < r ? xcd * (q + 1) : r * (q + 1) + (xcd - r) * q) + off; }
        const int nig = WGM * nN, gid = wgid / nig, fm = gid * WGM, gsz = (nM - fm) < WGM ? (nM - fm) : WGM;
        u.pm = fm + ((wgid % nig) % gsz); u.pn = (wgid % nig) / gsz;
    }
    __host__ __device__ bool next(int i, Unit& u) const {
        const long L = (long)i * G + c; if (i >= imax || L >= nwg) return false;
        decode(L, u); u.par = i & 1; u.roff = 0; return true;
    }
    __device__ __forceinline__ void a_ready(const Unit&) const {}
    __device__ __forceinline__ void done(const Unit&) const {}
};
struct HalfOrder : StaticOrder {
    int nfull;
    __host__ __device__ bool next(int i, Unit& u) const {
        if (i != 0) return false;
        const int xcd = c % NXCD, rho = c / NXCD; const long L = ((long)nfull * (G / NXCD) + (rho >> 1)) * NXCD + xcd; if (L >= nwg) return false;
        decode(L, u); u.par = 0; u.roff = 0; return true;
    }
};
__device__ __forceinline__ unsigned cvt_pk_bf16(float lo, float hi) { unsigned r; asm volatile("v_cvt_pk_bf16_f32 %0, %1, %2" : "=v"(r) : "v"(lo), "v"(hi)); return r; }
template <class Epi, class Sched, bool ALIGN_EPI = false, bool SP2 = false, bool HALFM = false>
__device__ __forceinline__ void gemm_phase(PG8_LAS unsigned char* lds, const Gemm g, const Sched& S, const Epi& E) {
    int tid_ = threadIdx.x; asm volatile("" : "+v"(tid_));
    const int tid = tid_, wid = __builtin_amdgcn_readfirstlane(tid >> 6), lane = tid & 63, wr = wid >> 2, wc = wid & 3, fr = lane & 15, fq = lane >> 4;
    static_assert(!HALFM || SP2, "HALFM is written for the SP2 loop");
    const int K = g.K, nt = g.nkt ? g.nkt : K / BK;
    unsigned voffA[2], voffB[2];
#pragma unroll
    for (int i = 0; i < 2; ++i) { int R, C; stage_rc(tid * 16 + i * 8192, R, C); const int Rb = Epi::PERM ? ((R & ~31) + perm32(R & 31)) : R;
        voffA[i] = (unsigned)(R * K + C) * 2u; voffB[i] = (unsigned)(Rb * K + C) * 2u; }
    const size_t kstep = (size_t)(BK * 2);
    const size_t hstep = (size_t)HALF * K * 2;
    const size_t tstep = 2 * hstep;
    const unsigned ldsw = (unsigned)wid * 1024u;
    const int aoff = lds_byte(wr * 64 + fr, fq * 8), boff = lds_byte(wc * 32 + fr, fq * 8);
#define PG8_SA(b, h) (((b) * 2 + (h)) * HTB)
#define PG8_SB(b, h) ((4 + (b) * 2 + (h)) * HTB)
#define PG8_STAGE(bufoff, gbase, voff) do { _Pragma("unroll") for (int _i = 0; _i < 2; ++_i) \
        __builtin_amdgcn_global_load_lds((const unsigned*)((const char*)(gbase) + (voff)[_i]), (PG8_LAS unsigned*)(lds + (bufoff) + ldsw + _i * 8192), 16, 0, 0); } while (0)
#define PG8_LDA(dst, b, h) do { _Pragma("unroll") for (int m = 0; m < 4; ++m) _Pragma("unroll") for (int k = 0; k < 2; ++k) dst[m][k] = *(const PG8_LAS bf16x8*)(lds + PG8_SA(b, h) + aoff + m * 2048 + k * 1024); } while (0)
#define PG8_LDB(dst, b, h) do { _Pragma("unroll") for (int n = 0; n < 2; ++n) _Pragma("unroll") for (int k = 0; k < 2; ++k) dst[n][k] = *(const PG8_LAS bf16x8*)(lds + PG8_SB(b, h) + boff + n * 2048 + k * 1024); } while (0)
#define PG8_MMA(ai, bj, At, Bt) do { __builtin_amdgcn_s_setprio(1); _Pragma("unroll") for (int m = 0; m < 4; ++m) _Pragma("unroll") for (int n = 0; n < 2; ++n) _Pragma("unroll") for (int k = 0; k < 2; ++k) \
        acc[ai][bj][m][n] = __builtin_amdgcn_mfma_f32_16x16x32_bf16(Bt[n][k], At[m][k], acc[ai][bj][m][n], 0, 0, 0); __builtin_amdgcn_s_setprio(0); } while (0)
#define PG8_WAIT_V(n) asm volatile("s_waitcnt vmcnt(" #n ")" ::: "memory")
#define PG8_WAIT_L(n) asm volatile("s_waitcnt lgkmcnt(" #n ")" ::: "memory")
#define PG8_BAR __builtin_amdgcn_s_barrier()
#define PG8_SCHED __builtin_amdgcn_sched_barrier(0)
    Unit cur, nxt; int ui = 0;
    if (!S.next(0, cur)) return;
    f32x4 acc[2][2][4][2];
#pragma unroll
    for (int a = 0; a < 2; ++a)
#pragma unroll
        for (int b = 0; b < 2; ++b)
#pragma unroll
            for (int m = 0; m < 4; ++m)
#pragma unroll
                for (int n = 0; n < 2; ++n) acc[a][b][m][n] = (f32x4){0.f, 0.f, 0.f, 0.f};
    bf16x8 At[4][2], B0[2][2], B1[2][2];
    const char* cA = (const char*)g.A + (size_t)cur.pm * tstep + (size_t)cur.roff * K * 2; const char* cB = (const char*)g.Bt + (size_t)cur.pn * tstep;
    S.a_ready(cur);
    if constexpr (SP2) {
        PG8_STAGE(PG8_SB(0, 0), cB, voffB); PG8_STAGE(PG8_SB(0, 1), cB + hstep, voffB); PG8_STAGE(PG8_SA(0, 0), cA, voffA); PG8_STAGE(PG8_SA(0, 1), cA + hstep, voffA);
        if (wr == 1) PG8_BAR;
        PG8_WAIT_V(2); PG8_BAR;
        PG8_STAGE(PG8_SB(1, 0), cB + kstep, voffB); PG8_STAGE(PG8_SA(1, 0), cA + kstep, voffA); PG8_STAGE(PG8_SB(1, 1), cB + hstep + kstep, voffB);
        PG8_WAIT_V(6); PG8_BAR;
    } else {
        PG8_STAGE(PG8_SB(0, 0), cB, voffB); PG8_STAGE(PG8_SA(0, 0), cA, voffA); PG8_STAGE(PG8_SB(0, 1), cB + hstep, voffB); PG8_STAGE(PG8_SA(0, 1), cA + hstep, voffA);
        if (wr == 1) PG8_BAR;
        PG8_WAIT_V(4); PG8_BAR;
        PG8_STAGE(PG8_SB(1, 0), cB + kstep, voffB); PG8_STAGE(PG8_SA(1, 0), cA + kstep, voffA); PG8_STAGE(PG8_SB(1, 1), cB + hstep + kstep, voffB);
        PG8_WAIT_V(6); PG8_BAR;
    }
    for (;;) {
        const bool has_next = S.next(ui + 1, nxt);
        const char* nA = has_next ? (const char*)g.A + (size_t)nxt.pm * tstep + (size_t)nxt.roff * K * 2 : cA; const char* nB = has_next ? (const char*)g.Bt + (size_t)nxt.pn * tstep : cB;
        for (int t = 0; t < nt; t += 2) {
            const bool last = (t == nt - 2);
            const char* a1 = cA + (size_t)(t + 1) * kstep;
            const char* a2 = last ? nA : cA + (size_t)(t + 2) * kstep; const char* b2 = last ? nB : cB + (size_t)(t + 2) * kstep;
            const char* a3 = a2 + kstep; const char* b3 = b2 + kstep;
            if (last && has_next) S.a_ready(nxt);
            if constexpr (SP2) {
            PG8_LDB(B0, 0, 0); PG8_LDB(B1, 0, 1); PG8_SCHED; PG8_LDA(At, 0, 0); PG8_STAGE(PG8_SA(1, 1), a1 + hstep, voffA);
            PG8_WAIT_V(8); PG8_WAIT_L(0); PG8_BAR; PG8_MMA(0, 0, At, B0); PG8_MMA(0, 1, At, B1); PG8_BAR; PG8_SCHED;
            if constexpr (!HALFM) PG8_LDA(At, 0, 1); PG8_STAGE(PG8_SB(0, 0), b2, voffB); PG8_STAGE(PG8_SB(0, 1), b2 + hstep, voffB); PG8_STAGE(PG8_SA(0, 0), a2, voffA);
            PG8_WAIT_V(8); PG8_WAIT_L(0); PG8_BAR; if constexpr (!HALFM) { PG8_MMA(1, 0, At, B0); PG8_MMA(1, 1, At, B1); } PG8_BAR; PG8_SCHED;
            PG8_LDB(B0, 1, 0); PG8_LDB(B1, 1, 1); PG8_SCHED; PG8_LDA(At, 1, 0); PG8_STAGE(PG8_SA(0, 1), a2 + hstep, voffA);
            PG8_WAIT_V(8); PG8_WAIT_L(0); PG8_BAR; PG8_MMA(0, 0, At, B0); PG8_MMA(0, 1, At, B1); PG8_BAR; PG8_SCHED;
            if constexpr (!HALFM) PG8_LDA(At, 1, 1); PG8_STAGE(PG8_SB(1, 0), b3, voffB); PG8_STAGE(PG8_SB(1, 1), b3 + hstep, voffB); PG8_STAGE(PG8_SA(1, 0), a3, voffA);
            PG8_WAIT_V(8); PG8_WAIT_L(0); PG8_BAR; if constexpr (!HALFM) { PG8_MMA(1, 0, At, B0); PG8_MMA(1, 1, At, B1); } PG8_BAR; PG8_SCHED;
            } else {
            PG8_LDB(B0, 0, 0); PG8_SCHED; PG8_LDA(At, 0, 0); PG8_STAGE(PG8_SA(1, 1), a1 + hstep, voffA);
            PG8_WAIT_L(8); PG8_BAR; PG8_WAIT_L(0); PG8_MMA(0, 0, At, B0); PG8_BAR; PG8_SCHED;
            PG8_LDB(B1, 0, 1); PG8_STAGE(PG8_SB(0, 0), b2, voffB);
            PG8_BAR; PG8_WAIT_L(0); PG8_MMA(0, 1, At, B1); PG8_BAR;
            PG8_LDA(At, 0, 1); PG8_STAGE(PG8_SA(0, 0), a2, voffA);
            PG8_BAR; PG8_WAIT_L(0); PG8_MMA(1, 0, At, B0); PG8_BAR; PG8_SCHED;
            PG8_STAGE(PG8_SB(0, 1), b2 + hstep, voffB);
            PG8_WAIT_V(6); PG8_BAR; PG8_MMA(1, 1, At, B1); PG8_BAR;
            PG8_LDB(B0, 1, 0); PG8_SCHED; PG8_LDA(At, 1, 0); PG8_STAGE(PG8_SA(0, 1), a2 + hstep, voffA);
            PG8_WAIT_L(8); PG8_BAR; PG8_WAIT_L(0); PG8_MMA(0, 0, At, B0); PG8_BAR; PG8_SCHED;
            PG8_LDB(B1, 1, 1); PG8_STAGE(PG8_SB(1, 0), b3, voffB);
            PG8_BAR; PG8_WAIT_L(0); PG8_MMA(0, 1, At, B1); PG8_BAR;
            PG8_LDA(At, 1, 1); PG8_STAGE(PG8_SA(1, 0), a3, voffA);
            PG8_BAR; PG8_WAIT_L(0); PG8_MMA(1, 0, At, B0); PG8_BAR; PG8_SCHED;
            PG8_STAGE(PG8_SB(1, 1), b3 + hstep, voffB);
            PG8_WAIT_V(6); PG8_BAR; PG8_MMA(1, 1, At, B1); PG8_BAR;
            }
        }
        if constexpr (ALIGN_EPI) { if (wr == 0) PG8_BAR; }
        if constexpr (!Epi::AFTER_DRAIN) { E(acc, cur, wr, wc, fr, fq); S.done(cur); }
        if (!has_next) break;
#pragma unroll
        for (int a = 0; a < 2; ++a)
#pragma unroll
            for (int b = 0; b < 2; ++b)
#pragma unroll
                for (int m = 0; m < 4; ++m)
#pragma unroll
                    for (int n = 0; n < 2; ++n) acc[a][b][m][n] = (f32x4){0.f, 0.f, 0.f, 0.f};
        cur = nxt; cA = nA; cB = nB; ++ui;
        if constexpr (ALIGN_EPI) { if (wr == 1) PG8_BAR; }
    }
    PG8_WAIT_V(0);
    if constexpr (!ALIGN_EPI) { if (wr == 0) PG8_BAR; }
    PG8_BAR;
    if constexpr (Epi::AFTER_DRAIN) { E.fused(acc, cur, wr, wc, fr, fq, lds, wid, lane); S.done(cur); }
#undef PG8_SA
#undef PG8_SB
#undef PG8_STAGE
#undef PG8_LDA
#undef PG8_LDB
#undef PG8_MMA
#undef PG8_WAIT_V
#undef PG8_WAIT_L
#undef PG8_BAR
#undef PG8_SCHED
}
}

constexpr int DM = 1024, BATCH = 8, SEQ = 2048, DEPTH = 4, M = BATCH * SEQ;
constexpr int DFF = 2816, NGU = 2 * DFF, NIN = 2560, AW = 768, PWD = 256, NH = 12, HD = 64;
constexpr float NORM_EPS = 1e-6f;
constexpr float QSCALE = 0.125f * 1.4426950408889634f;

#define GAS __attribute__((address_space(1)))
#define LAS __attribute__((address_space(3)))
typedef unsigned short bf16_t;
typedef unsigned u32x4 __attribute__((ext_vector_type(4)));
typedef unsigned u32x2 __attribute__((ext_vector_type(2)));
typedef float f32x4 __attribute__((ext_vector_type(4)));
typedef float f32x16 __attribute__((ext_vector_type(16)));
typedef short bf16x8 __attribute__((ext_vector_type(8)));
typedef short s16x4 __attribute__((ext_vector_type(4)));

constexpr size_t MiB = 1u << 20;
constexpr size_t W_GU = (size_t)NGU * DM * 2, W_D = (size_t)DM * DFF * 2, W_IN = (size_t)NIN * DM * 2, W_OUT = (size_t)DM * DM * 2;
constexpr size_t LW_GU1 = 0, LW_D1 = LW_GU1 + W_GU, LW_IN = LW_D1 + W_D, LW_OUT = LW_IN + W_IN, LW_GU2 = LW_OUT + W_OUT, LW_D2 = LW_GU2 + W_GU, LW_SIZE = LW_D2 + W_D;
static_assert(LW_SIZE == 40 * MiB, "per-layer weight block");
constexpr size_t WS_W = 0;
constexpr size_t WS_XB = 160 * MiB;
constexpr size_t WS_A = 192 * MiB;
__host__ __device__ constexpr size_t off_q(int b) { return WS_A + (size_t)b * 8 * MiB; }
__host__ __device__ constexpr size_t off_vp(int b) { return WS_A + 4 * MiB + (size_t)b * 10 * MiB; }
__host__ __device__ constexpr size_t off_k(int b) { return WS_A + 5 * MiB + (size_t)b * 8 * MiB; }
__host__ __device__ constexpr size_t off_v(int b) { return WS_A + 8 * MiB + (size_t)b * 8 * MiB; }
__host__ __device__ constexpr size_t off_mix(int b) { return WS_A + (size_t)b * 7 * MiB; }
constexpr size_t WS_O = 280 * MiB;
constexpr size_t WS_XL = 328 * MiB;
constexpr size_t WS_STAT = 360 * MiB;
constexpr size_t WS_SSQ = 365 * MiB;
constexpr size_t WS_ROPE = 366 * MiB;
constexpr size_t WS_CTL = 367 * MiB, CTL_BYTES = 32768;
constexpr size_t WS_END = 368 * MiB;
__device__ __forceinline__ bf16_t* o_base(unsigned char* ws, unsigned char* dout, int br, int b) { return br < 2 ? (bf16_t*)(ws + WS_O) + (size_t)br * M * AW : (bf16_t*)(dout + (size_t)b * 5 * MiB); }
static_assert((size_t)M * DFF * 2 <= 88 * MiB && (size_t)3 * M * NH * 2 * 4 <= 5 * MiB, "ws map");

struct Args {
    const float* x; const int* pos;
    const float *n1, *g1, *u1, *d1, *nm, *win, *pw, *ps, *wout, *n2, *g2, *u2, *d2, *nf;
    float* out; unsigned char* ws;
    float inv_freq[8];
    int never, pad;
};

namespace epi {
using pg8::Unit; using pg8::BM; using pg8::HALF;
__device__ __forceinline__ float rinv_of(const float* P, int row) {
    const f32x4* p = (const f32x4*)(P + (size_t)row * 16);
    const f32x4 a = p[0], b = p[1], c = p[2], d = p[3];
    const float s = ((a[0] + a[1]) + (a[2] + a[3])) + ((b[0] + b[1]) + (b[2] + b[3])) + ((c[0] + c[1]) + (c[2] + c[3])) + ((d[0] + d[1]) + (d[2] + d[3]));
    return __builtin_amdgcn_rsqf(s * (1.0f / DM) + NORM_EPS);
}
template <class Base> struct RinvOrder : Base {
    const float* P; LAS float* tab;
    __device__ __forceinline__ void a_ready(const Unit& u) const { int t = threadIdx.x; asm volatile("" : "+v"(t)); if (t < 256 - u.roff) tab[u.par * 256 + t] = rinv_of(P, u.pm * BM + u.roff + t); }
};
__device__ __forceinline__ float silu_mul(float g, float u) {
    const float e = __builtin_amdgcn_exp2f(-1.4426950408889634f * g);
    return g * __builtin_amdgcn_rcpf(1.0f + e) * u;
}
template <int NAI> struct EpiSwiGLU {
    static constexpr bool PERM = true, AFTER_DRAIN = false;
    bf16_t* O; const LAS float* tab;
    __device__ __forceinline__ void operator()(const f32x4 (&acc)[2][2][4][2], const Unit& u, int wr, int wc, int fr, int fq) const {
        const int row0 = u.pm * BM + u.roff + wr * 64 + fr, col0 = u.pn * HALF + wc * 32 + 8 * fq;
#pragma unroll
        for (int ai = 0; ai < NAI; ++ai)
#pragma unroll
            for (int m = 0; m < 4; ++m) {
                const int row = row0 + ai * HALF + m * 16; const float ri = tab[u.par * 256 + ai * HALF + wr * 64 + m * 16 + fr];
                const f32x4 g0 = acc[ai][0][m][0] * ri, g1 = acc[ai][0][m][1] * ri, u0 = acc[ai][1][m][0] * ri, u1 = acc[ai][1][m][1] * ri;
                u32x4 w;
                w.x = pg8::cvt_pk_bf16(silu_mul(g0[0], u0[0]), silu_mul(g0[1], u0[1])); w.y = pg8::cvt_pk_bf16(silu_mul(g0[2], u0[2]), silu_mul(g0[3], u0[3]));
                w.z = pg8::cvt_pk_bf16(silu_mul(g1[0], u1[0]), silu_mul(g1[1], u1[1])); w.w = pg8::cvt_pk_bf16(silu_mul(g1[2], u1[2]), silu_mul(g1[3], u1[3]));
                *(u32x4*)(O + (size_t)row * DFF + col0) = w;
                if (m & 1) asm volatile("" ::: "memory");
            }
    }
};
struct EpiResid {
    static constexpr bool PERM = true, AFTER_DRAIN = false;
    const float* X0; bf16_t* XH; bf16_t* XL; float* P; float scale;
    __device__ __forceinline__ void operator()(const f32x4 (&acc)[2][2][4][2], const Unit& u, int wr, int wc, int fr, int fq) const {
        const int row0 = u.pm * BM + wr * 64 + fr, col0 = u.pn * BM + wc * 32 + 8 * fq;
#pragma unroll
        for (int g2 = 0; g2 < 4; ++g2) {
            const int ai = g2 >> 1;
            f32x4 xa[2][2][2];
            if (X0) {
#pragma unroll
                for (int mm = 0; mm < 2; ++mm)
#pragma unroll
                    for (int bj = 0; bj < 2; ++bj) { const float* xp = X0 + (size_t)(row0 + ai * HALF + ((g2 & 1) * 2 + mm) * 16) * DM + col0 + bj * HALF; xa[mm][bj][0] = *(const f32x4*)xp; xa[mm][bj][1] = *(const f32x4*)(xp + 4); }
            } else {
                u32x4 hh[2][2], ll[2][2];
#pragma unroll
                for (int mm = 0; mm < 2; ++mm)
#pragma unroll
                    for (int bj = 0; bj < 2; ++bj) { const size_t off = (size_t)(row0 + ai * HALF + ((g2 & 1) * 2 + mm) * 16) * DM + col0 + bj * HALF; hh[mm][bj] = *(const u32x4*)(XH + off); ll[mm][bj] = *(const u32x4*)(XL + off); }
#pragma unroll
                for (int mm = 0; mm < 2; ++mm)
#pragma unroll
                    for (int bj = 0; bj < 2; ++bj) { const u32x4 h = hh[mm][bj], l = ll[mm][bj];
                        xa[mm][bj][0] = (f32x4){__uint_as_float(h.x << 16) + __uint_as_float(l.x << 16), __uint_as_float(h.x & 0xffff0000u) + __uint_as_float(l.x & 0xffff0000u), __uint_as_float(h.y << 16) + __uint_as_float(l.y << 16), __uint_as_float(h.y & 0xffff0000u) + __uint_as_float(l.y & 0xffff0000u)};
                        xa[mm][bj][1] = (f32x4){__uint_as_float(h.z << 16) + __uint_as_float(l.z << 16), __uint_as_float(h.z & 0xffff0000u) + __uint_as_float(l.z & 0xffff0000u), __uint_as_float(h.w << 16) + __uint_as_float(l.w << 16), __uint_as_float(h.w & 0xffff0000u) + __uint_as_float(l.w & 0xffff0000u)}; }
            }
#pragma unroll
            for (int mm = 0; mm < 2; ++mm) {
                const int m = (g2 & 1) * 2 + mm;
                const int row = row0 + ai * HALF + m * 16; float ss = 0.f;
#pragma unroll
                for (int bj = 0; bj < 2; ++bj) {
                    const f32x4 a = xa[mm][bj][0] + acc[ai][bj][m][0] * scale, b = xa[mm][bj][1] + acc[ai][bj][m][1] * scale;
                    u32x4 w; w.x = pg8::cvt_pk_bf16(a[0], a[1]); w.y = pg8::cvt_pk_bf16(a[2], a[3]); w.z = pg8::cvt_pk_bf16(b[0], b[1]); w.w = pg8::cvt_pk_bf16(b[2], b[3]);
                    u32x4 wl;
                    wl.x = pg8::cvt_pk_bf16(a[0] - __uint_as_float(w.x << 16), a[1] - __uint_as_float(w.x & 0xffff0000u)); wl.y = pg8::cvt_pk_bf16(a[2] - __uint_as_float(w.y << 16), a[3] - __uint_as_float(w.y & 0xffff0000u));
                    wl.z = pg8::cvt_pk_bf16(b[0] - __uint_as_float(w.z << 16), b[1] - __uint_as_float(w.z & 0xffff0000u)); wl.w = pg8::cvt_pk_bf16(b[2] - __uint_as_float(w.w << 16), b[3] - __uint_as_float(w.w & 0xffff0000u));
                    const size_t off = (size_t)row * DM + col0 + bj * HALF;
                    *(u32x4*)(XH + off) = w; *(u32x4*)(XL + off) = wl;
                    ss += (a[0] * a[0] + a[1] * a[1]) + (a[2] * a[2] + a[3] * a[3]) + (b[0] * b[0] + b[1] * b[1]) + (b[2] * b[2] + b[3] * b[3]);
                }
                ss += __shfl_xor(ss, 16); ss += __shfl_xor(ss, 32);
                if (fq == 0) P[(size_t)row * 16 + u.pn * 4 + wc] = ss;
            }
            asm volatile("" ::: "memory");
        }
    }
};
template <int NAI> struct EpiProj {
    static constexpr bool PERM = true, AFTER_DRAIN = false;
    bf16_t *VP, *Q, *K, *V; const LAS float* tab; const float* CS;
    __device__ __forceinline__ void operator()(const f32x4 (&acc)[2][2][4][2], const Unit& u, int wr, int wc, int fr, int fq) const {
        const int pn = u.pn;
        bf16_t* dst; int ld, cb;
        if (pn == 0) { dst = VP; ld = PWD; cb = 0; } else if (pn < 4) { dst = Q; ld = AW; cb = (pn - 1) * 256; } else if (pn < 7) { dst = K; ld = AW; cb = (pn - 4) * 256; } else { dst = V; ld = AW; cb = (pn - 7) * 256; }
        const bool ropetile = (pn >= 1 && pn <= 6);
        const bool ropelane = ropetile && !(wc & 1) && (fq < 2);
        const float sgn = (fq == 0) ? -1.f : 1.f;
        const float qs = (pn >= 1 && pn < 4) ? QSCALE : 1.f;
        const int row0 = u.pm * BM + u.roff + wr * 64 + fr, col0 = cb + wc * 32 + 8 * fq;
#pragma unroll
        for (int ai = 0; ai < NAI; ++ai)
#pragma unroll
            for (int m = 0; m < 4; ++m) {
                const int row = row0 + ai * HALF + m * 16; const float ri = tab[u.par * 256 + ai * HALF + wr * 64 + m * 16 + fr];
                f32x4 c0 = {1.f, 1.f, 1.f, 1.f}, c1 = c0, s0 = {0.f, 0.f, 0.f, 0.f}, s1 = s0;
                if (ropelane) { const f32x4* cs = (const f32x4*)(CS + (size_t)row * 16); c0 = cs[0]; c1 = cs[1]; s0 = cs[2]; s1 = cs[3]; }
#pragma unroll
                for (int bj = 0; bj < 2; ++bj) {
                    f32x4 v0 = acc[ai][bj][m][0] * ri, v1 = acc[ai][bj][m][1] * ri;
                    if (ropetile) {
                        f32x4 p0, p1;
#pragma unroll
                        for (int j = 0; j < 4; ++j) { p0[j] = __shfl_xor(v0[j], 16); p1[j] = __shfl_xor(v1[j], 16); }
                        if (ropelane) { v0 = v0 * c0 + p0 * s0 * sgn; v1 = v1 * c1 + p1 * s1 * sgn; }
                    }
                    v0 = v0 * qs; v1 = v1 * qs;
                    u32x4 w; w.x = pg8::cvt_pk_bf16(v0[0], v0[1]); w.y = pg8::cvt_pk_bf16(v0[2], v0[3]); w.z = pg8::cvt_pk_bf16(v1[0], v1[1]); w.w = pg8::cvt_pk_bf16(v1[2], v1[3]);
                    *(u32x4*)(dst + (size_t)row * ld + col0 + bj * HALF) = w;
                }
                if (m & 1) asm volatile("" ::: "memory");
            }
    }
};
}

namespace att {
constexpr int NSLOT = 448, KCS = NSLOT * 16 + 16, VDS = NSLOT * 64 + 64;
constexpr int L_K = 0, L_V = 8 * KCS, L_WS = L_V + 2 * VDS, L_OST = L_WS + 8 * 256, L_END = L_OST + 8 * 4096;
static_assert(L_END <= 149760, "attention LDS");
__device__ __forceinline__ int crow(int r, int hi) { return (r & 3) + 8 * (r >> 2) + 4 * hi; }
__device__ __forceinline__ s16x4 vtr(const LAS unsigned char* p) { return __builtin_bit_cast(s16x4, __builtin_amdgcn_ds_read_tr16_b64_v4i16((LAS s16x4*)p)); }
struct UD { int b, h, br, u; };
__device__ __forceinline__ UD decode(int uidg) { UD x; x.u = uidg & 7; x.br = (uidg >> 3) % 3; const int bh = uidg / 24; x.b = bh / NH; x.h = bh % NH; return x; }

__device__ __forceinline__ void load_kv(u32x4 (&val)[14], const UD& x, const unsigned char* ws, int tid) {
    const int br = x.br, u = x.u, sub = tid & 15, s0 = tid >> 4;
    const bf16_t* base = (const bf16_t*)(ws + ((sub < 8) ? off_k(x.b) : off_v(x.b))) + (size_t)x.b * SEQ * AW + x.h * HD + (sub & 7) * 8;
    if (br < 2) {
        const int d = (br == 0) ? 1 : 4, L = SEQ / d, T0 = (br == 0) ? 256 * u : 256 * (u & 1), cls = (br == 0) ? 0 : (u >> 1);
        const int k0 = T0 - 64 + s0;
        const bf16_t* p0 = base + ((long)k0 * d + cls) * AW; const long stride = (long)32 * d * AW;
#pragma unroll
        for (int i = 0; i < 14; ++i) { const int key = k0 + 32 * i; val[i] = (u32x4){0u, 0u, 0u, 0u};
            if ((i < 12) && (key >= 0) && (key < L)) val[i] = *(const u32x4*)(p0 + i * stride); }
    } else {
        const bf16_t* pa = base + ((long)(s0 - 64) * 16 + 2 * u) * AW; const bf16_t* pb = base + ((long)s0 * 16 + 2 * u + 1) * AW; const long stride = (long)32 * 16 * AW;
#pragma unroll
        for (int i = 0; i < 14; ++i) { val[i] = (u32x4){0u, 0u, 0u, 0u};
            if (i < 8) { const int key = s0 + 32 * i - 64; if ((key >= 0) && (key < 128)) val[i] = *(const u32x4*)(pa + i * stride); }
            else if (i < 12) val[i] = *(const u32x4*)(pb + (i - 8) * stride); }
    }
}
__device__ __forceinline__ void store_kv(LAS unsigned char* lds, const u32x4 (&val)[14], int tid) {
#pragma unroll
    for (int i = 0; i < 14; ++i) {
        const int piece = tid + 512 * i, slot = piece >> 4, sub = piece & 15;
        const int off = (sub < 8) ? (L_K + sub * KCS + slot * 16) : (L_V + ((sub - 8) >> 2) * VDS + slot * 64 + ((sub - 8) & 3) * 16);
        *(LAS u32x4*)(lds + off) = val[i];
    }
}
__device__ __forceinline__ void wave_geo(const UD& x, int wid, int& d, int& L, int& cls, int& t0, int& sbase) {
    const int br = x.br, u = x.u; d = (br == 0) ? 1 : (br == 1) ? 4 : 16; L = SEQ / d;
    if (br < 2) { const int T0 = (br == 0) ? 256 * u : 256 * (u & 1); cls = (br == 0) ? 0 : (u >> 1); t0 = T0 + 32 * wid; sbase = 32 * wid; }
    else { const int hw = wid >> 2; cls = 2 * u + hw; t0 = 32 * (wid & 3); sbase = 192 * hw + 32 * (wid & 3); }
}
__device__ __forceinline__ void load_q(bf16x8 (&qr)[4], const UD& x, const unsigned char* ws, int wid, int r32, int hi) {
    int d, L, cls, t0, sbase; wave_geo(x, wid, d, L, cls, t0, sbase);
    const bf16_t* Qb = (const bf16_t*)(ws + off_q(x.b));
    const size_t qtok = (size_t)x.b * SEQ + (size_t)(t0 + r32) * d + cls;
#pragma unroll
    for (int d0 = 0; d0 < 4; ++d0) qr[d0] = *(const bf16x8*)(Qb + qtok * AW + x.h * HD + d0 * 16 + hi * 8);
}
__device__ __forceinline__ void compute_a(LAS unsigned char* lds, const UD& x, const bf16x8 (&qr)[4], int wid, int lane, u32x4 (&pw)[10], float& mx_o, float& l_o) {
    const int r32 = lane & 31, hi = lane >> 5;
    int d, L, cls, t0, sbase; wave_geo(x, wid, d, L, cls, t0, sbase);
    f32x16 s[5];
#pragma unroll
    for (int ht = 0; ht < 5; ++ht) {
        const LAS unsigned char* kb = lds + L_K + hi * KCS + (sbase + 32 * ht + r32) * 16;
        f32x16 a = {};
#pragma unroll
        for (int d0 = 0; d0 < 4; ++d0) { const bf16x8 kf = *(const LAS bf16x8*)(kb + d0 * 2 * KCS); a = __builtin_amdgcn_mfma_f32_32x32x16_bf16(kf, qr[d0], a, 0, 0, 0); }
        s[ht] = a;
    }
    {
        const int dq = r32 - 4 * hi;
#pragma unroll
        for (int r = 0; r < 16; ++r) { const int cr = (r & 3) + 8 * (r >> 2); s[0][r] = (cr >= dq) ? s[0][r] : -INFINITY; s[4][r] = (cr <= dq) ? s[4][r] : -INFINITY; }
        if (t0 < 64) {
#pragma unroll
            for (int r = 0; r < 16; ++r) s[0][r] = -INFINITY;
            if (t0 < 32) {
#pragma unroll
                for (int r = 0; r < 16; ++r) s[1][r] = -INFINITY;
            }
        }
        if (t0 + 96 > L) {
#pragma unroll
            for (int r = 0; r < 16; ++r) s[4][r] = -INFINITY;
            if (t0 + 64 > L) {
#pragma unroll
                for (int r = 0; r < 16; ++r) s[3][r] = -INFINITY;
            }
        }
    }
    float mx = s[2][0];
#pragma unroll
    for (int ht = 0; ht < 5; ++ht)
#pragma unroll
        for (int r = 0; r < 16; ++r) mx = fmaxf(mx, s[ht][r]);
    mx = fmaxf(mx, __shfl_xor(mx, 32));
    float lsum = 0.f;
#pragma unroll
    for (int ht = 0; ht < 5; ++ht)
#pragma unroll
        for (int r = 0; r < 16; ++r) { const float p = __builtin_amdgcn_exp2f(s[ht][r] - mx); s[ht][r] = p; lsum += p; }
    lsum += __shfl_xor(lsum, 32);
#pragma unroll
    for (int g = 0; g < 10; ++g) {
        const int ht = g >> 1, rb = (g & 1) * 8;
        pw[g].x = pg8::cvt_pk_bf16(s[ht][rb + 0], s[ht][rb + 1]); pw[g].y = pg8::cvt_pk_bf16(s[ht][rb + 2], s[ht][rb + 3]); pw[g].z = pg8::cvt_pk_bf16(s[ht][rb + 4], s[ht][rb + 5]); pw[g].w = pg8::cvt_pk_bf16(s[ht][rb + 6], s[ht][rb + 7]);
    }
    mx_o = mx; l_o = lsum;
}
__device__ __forceinline__ void compute_b(LAS unsigned char* lds, const UD& x, unsigned char* ws, unsigned char* dout, int wid, int lane, const u32x4 (&pw)[10], float mx, float lsum) {
    const int r32 = lane & 31, hi = lane >> 5;
    int d, L, cls, t0, sbase; wave_geo(x, wid, d, L, cls, t0, sbase);
    const size_t tokb = (size_t)x.b * SEQ;
    const size_t qtok = tokb + (size_t)(t0 + r32) * d + cls;
    f32x16 o[2]; o[0] = f32x16{}; o[1] = f32x16{};
    const int vlane = ((lane >> 4) & 1) * 32 + (lane & 3) * 8 + (4 * hi + ((lane & 15) >> 2)) * 64;
#pragma unroll
    for (int g = 0; g < 10; ++g) {
        const bf16x8 pa = __builtin_bit_cast(bf16x8, pw[g]);
#pragma unroll
        for (int d0 = 0; d0 < 2; ++d0) {
            const LAS unsigned char* vp = lds + L_V + d0 * VDS + (sbase + 16 * g) * 64 + vlane;
            const s16x4 lo = vtr(vp), hh = vtr(vp + 512);
            const bf16x8 vf = (bf16x8){lo[0], lo[1], lo[2], lo[3], hh[0], hh[1], hh[2], hh[3]};
            o[d0] = __builtin_amdgcn_mfma_f32_32x32x16_bf16(pa, vf, o[d0], 0, 0, 0);
        }
    }
    LAS float* wsf = (LAS float*)(lds + L_WS + wid * 256);
    LAS bf16_t* stg = (LAS bf16_t*)(lds + L_OST + wid * 4096);
    if (hi == 0) {
        wsf[r32] = lsum;
        float* st = (float*)(ws + WS_STAT) + (((size_t)x.br * M + qtok) * NH + x.h) * 2; st[0] = mx; st[1] = lsum;
    }
    asm volatile("s_waitcnt lgkmcnt(0)" ::: "memory");
#pragma unroll
    for (int r = 0; r < 16; ++r) {
        const int qrow = crow(r, hi); const float rl = __builtin_amdgcn_rcpf(wsf[qrow]);
        const unsigned a = pg8::cvt_pk_bf16(o[0][r] * rl, o[1][r] * rl);
        stg[qrow * 64 + r32] = (bf16_t)(a & 0xffffu); stg[qrow * 64 + 32 + r32] = (bf16_t)(a >> 16);
    }
    asm volatile("s_waitcnt lgkmcnt(0)" ::: "memory");
    bf16_t* Ob = o_base(ws, dout, x.br, x.b);
#pragma unroll
    for (int i = 0; i < 4; ++i) {
        const int row = i * 8 + (lane >> 3), ch = lane & 7;
        const u32x4 v = *(const LAS u32x4*)(stg + row * 64 + ch * 8);
        *(u32x4*)(Ob + (tokb + (size_t)(t0 + row) * d + cls) * AW + x.h * HD + ch * 8) = v;
    }
}
__device__ __forceinline__ void phase(LAS unsigned char* lds, unsigned char* ws, unsigned char* dout, int first, int step, int limit) {
    int tid_ = threadIdx.x; asm volatile("" : "+v"(tid_));
    const int tid = tid_, lane = tid & 63; const int wid = __builtin_amdgcn_readfirstlane(tid >> 6);
    if (first >= limit) return;
    u32x4 val[14];
    load_kv(val, decode(first), ws, tid);
    for (int uid = first; uid < limit; uid += step) {
        const UD x = decode(uid);
        bf16x8 qr[4]; load_q(qr, x, ws, wid, lane & 31, lane >> 5);
        store_kv(lds, val, tid);
        __syncthreads();
        u32x4 pw[10]; float mx, lsum;
        compute_a(lds, x, qr, wid, lane, pw, mx, lsum);
        if (uid + step < limit) load_kv(val, decode(uid + step), ws, tid);
        compute_b(lds, x, ws, dout, wid, lane, pw, mx, lsum);
        __syncthreads();
    }
}
}

__device__ __forceinline__ float bf2f(unsigned short h) { return __uint_as_float((unsigned)h << 16); }
__device__ __forceinline__ float wave_sum(float v) {
#pragma unroll
    for (int o = 1; o < 64; o <<= 1) v += __shfl_xor(v, o);
    return v;
}
__device__ __forceinline__ unsigned f2bf(float f) { unsigned u = __float_as_uint(f); return (u + 0x7fffu + ((u >> 16) & 1u)) >> 16; }
__device__ __forceinline__ unsigned pk2(float lo, float hi) { return f2bf(lo) | (f2bf(hi) << 16); }

struct TrItem { const float* W; const float* gain; bf16_t* WT; int N, k0, n0, ldw, drow0; };
__device__ __forceinline__ void tr_load(f32x4 (&v)[16], const TrItem& t, int lane) {
    const int kr = lane >> 4, nc = 4 * (lane & 15);
#pragma unroll
    for (int i = 0; i < 16; ++i) v[i] = *(const f32x4*)(t.W + (size_t)(t.k0 + 4 * i + kr) * t.N + t.n0 + nc);
}
__device__ __forceinline__ void tr_finish(const f32x4 (&v)[16], const TrItem& t, LAS float* scr, int lane) {
    const int kr = lane >> 4, nc = 4 * (lane & 15);
#pragma unroll
    for (int i = 0; i < 16; ++i) { const int kk = 4 * i + kr; const float gg = t.gain ? t.gain[t.k0 + kk] : 1.f; LAS float* s = scr + kk * 65 + nc;
        s[0] = v[i][0] * gg; s[1] = v[i][1] * gg; s[2] = v[i][2] * gg; s[3] = v[i][3] * gg; }
    asm volatile("s_waitcnt lgkmcnt(0)" ::: "memory");
    const int c = lane & 7;
#pragma unroll
    for (int j = 0; j < 8; ++j) { const int n = (lane >> 3) + 8 * j; const LAS float* s = scr + (8 * c) * 65 + n;
        u32x4 o; o.x = pk2(s[0 * 65], s[1 * 65]); o.y = pk2(s[2 * 65], s[3 * 65]); o.z = pk2(s[4 * 65], s[5 * 65]); o.w = pk2(s[6 * 65], s[7 * 65]);
        *(u32x4*)(t.WT + (size_t)(t.drow0 + n) * t.ldw + t.k0 + 8 * c) = o; }
    asm volatile("s_waitcnt lgkmcnt(0)" ::: "memory");
}
constexpr int I_G = 16 * 44, I_D = 44 * 16, I_IN = 16 * 40, I_O = 12 * 16, I_LAYER = 6 * I_G + I_IN + I_O;
static_assert(I_G == I_D, "item counts");
__device__ __forceinline__ TrItem tr_decode(const Args& a, int it) {
    TrItem t; const int l = it / I_LAYER; int r = it % I_LAYER;
    unsigned char* wl = a.ws + WS_W + (size_t)l * LW_SIZE;
    if (r < 6 * I_G) {
        const int seg = r / I_G; r = r % I_G;
        const int ffn = seg / 3, kind = seg % 3;
        if (kind < 2) {
            t.W = (kind == 0 ? (ffn ? a.g2 : a.g1) : (ffn ? a.u2 : a.u1)) + (size_t)l * DM * DFF; t.gain = (ffn ? a.n2 : a.n1) + (size_t)l * DM;
            t.WT = (bf16_t*)(wl + (ffn ? LW_GU2 : LW_GU1)); t.N = DFF; t.ldw = DM;
            const int kb = r / 44, nb = r % 44; t.k0 = 64 * kb; t.n0 = 64 * nb; t.drow0 = 256 * (t.n0 / 128) + 128 * kind + (t.n0 % 128);
        } else {
            t.W = (ffn ? a.d2 : a.d1) + (size_t)l * DFF * DM; t.gain = nullptr; t.WT = (bf16_t*)(wl + (ffn ? LW_D2 : LW_D1)); t.N = DM; t.ldw = DFF;
            const int kb = r / 16, nb = r % 16; t.k0 = 64 * kb; t.n0 = 64 * nb; t.drow0 = 64 * nb;
        }
    } else if (r < 6 * I_G + I_IN) {
        r -= 6 * I_G; const int kb = r / 40, nb = r % 40;
        t.W = a.win + (size_t)l * DM * NIN; t.gain = a.nm + (size_t)l * DM; t.WT = (bf16_t*)(wl + LW_IN); t.N = NIN; t.ldw = DM; t.k0 = 64 * kb; t.n0 = 64 * nb; t.drow0 = 64 * nb;
    } else {
        r -= 6 * I_G + I_IN; const int kb = 4 + r / 16, nb = r % 16;
        t.W = a.wout + (size_t)l * DM * DM; t.gain = nullptr; t.WT = (bf16_t*)(wl + LW_OUT); t.N = DM; t.ldw = DM; t.k0 = 64 * kb; t.n0 = 64 * nb; t.drow0 = 64 * nb;
    }
    return t;
}

__device__ __forceinline__ void prologue(const Args& a, LAS unsigned char* lds, int vcu, int G) {
    const int tid = threadIdx.x, lane = tid & 63, wave = __builtin_amdgcn_readfirstlane(tid >> 6);
    LAS float* scr = (LAS float*)(lds + wave * 16640);
    const int gw = vcu * 8 + wave, NGW = G * 8;
    unsigned char* ws = a.ws;
    if (gw < DEPTH * I_LAYER) {
        TrItem cur = tr_decode(a, gw); f32x4 va[16]; tr_load(va, cur, lane);
        for (int it = gw; it < DEPTH * I_LAYER; it += NGW) {
            const bool more = it + NGW < DEPTH * I_LAYER;
            TrItem nxt = cur; f32x4 vb[16];
            if (more) { nxt = tr_decode(a, it + NGW); tr_load(vb, nxt, lane); }
            tr_finish(va, cur, scr, lane);
            if (more) {
#pragma unroll
                for (int i = 0; i < 16; ++i) va[i] = vb[i];
                cur = nxt; }
        }
    }
    for (int it = gw; it < DEPTH * 4 * 8 * 16; it += NGW) {
        const int l = it >> 9, g = (it >> 7) & 3, c8 = (it >> 4) & 7, n = (it & 15) * 64 + lane;
        const float* wo = a.wout + (size_t)l * DM * DM + (size_t)(g * 64) * DM + n;
        const float* sc = a.ps + (size_t)l * PWD + g * 64;
        const float* pr = a.pw + (((size_t)l * 4 + g) * 64 + c8 * 8) * 64;
        float acc[8] = {0.f, 0.f, 0.f, 0.f, 0.f, 0.f, 0.f, 0.f};
#pragma unroll 4
        for (int dd = 0; dd < 64; ++dd) { const float wv = wo[(size_t)dd * DM] * sc[dd];
#pragma unroll
            for (int e = 0; e < 8; ++e) acc[e] += pr[e * 64 + dd] * wv; }
        u32x4 o; o.x = pk2(acc[0], acc[1]); o.y = pk2(acc[2], acc[3]); o.z = pk2(acc[4], acc[5]); o.w = pk2(acc[6], acc[7]);
        *(u32x4*)((bf16_t*)(ws + WS_W + (size_t)l * LW_SIZE + LW_OUT) + (size_t)n * DM + g * 64 + c8 * 8) = o;
    }
    bf16_t* XB = (bf16_t*)(ws + WS_XB); float* P = (float*)(ws + WS_SSQ); float* CS = (float*)(ws + WS_ROPE);
    for (int mp = gw; mp < M; mp += 2 * NGW) {
        f32x4 v[2][4];
#pragma unroll
        for (int q = 0; q < 2; ++q) { const int m = (mp + q * NGW < M) ? mp + q * NGW : mp; const f32x4* xr = (const f32x4*)(a.x + (size_t)m * DM) + lane;
#pragma unroll
            for (int j = 0; j < 4; ++j) v[q][j] = xr[64 * j]; }
#pragma unroll
        for (int q = 0; q < 2; ++q) {
            const int m = (mp + q * NGW < M) ? mp + q * NGW : mp;
            u32x2* xb = (u32x2*)(XB + (size_t)m * DM) + lane;
            float s = 0.f;
#pragma unroll
            for (int j = 0; j < 4; ++j) { const f32x4 x4 = v[q][j]; s += (x4[0] * x4[0] + x4[1] * x4[1]) + (x4[2] * x4[2] + x4[3] * x4[3]);
                u32x2 w; w.x = pk2(x4[0], x4[1]); w.y = pk2(x4[2], x4[3]); xb[64 * j] = w; }
            s = wave_sum(s);
            if (lane < 16) P[(size_t)m * 16 + lane] = (lane == 0) ? s : 0.f;
            if (lane < 8) {
                const float ang = (float)a.pos[m] * a.inv_freq[lane];
                double rev = (double)ang * 0.15915494309189535; rev -= floor(rev);
                const float fr = (float)rev;
                CS[(size_t)m * 16 + lane] = __builtin_amdgcn_cosf(fr); CS[(size_t)m * 16 + 8 + lane] = __builtin_amdgcn_sinf(fr);
            }
        }
    }
}

__device__ __forceinline__ void combine_phase(const Args& a, int wv0, int nwv, int tok0, int ntok) {
    int tid_ = threadIdx.x; asm volatile("" : "+v"(tid_));
    const int tid = tid_, lane = tid & 63, wave = __builtin_amdgcn_readfirstlane(tid >> 6);
    const int gw = wv0 + wave, NGW = nwv;
    unsigned char* ws = a.ws;
    const float* __restrict__ ST = (const float*)(ws + WS_STAT);
    const int g = lane >> 4, hw = 1 << g;
    for (int tokp = tok0 + gw; tokp < tok0 + ntok; tokp += 2 * NGW) {
        u32x2 vv[2][16], me[2]; int cnt[2]; float mm[2][2][3], ll[2][2][3]; u32x4 ov[2][2][3];
#pragma unroll
        for (int q = 0; q < 2; ++q) {
            const int tok = (tokp + q * NGW < tok0 + ntok) ? tokp + q * NGW : tokp;
            const int bb = tok >> 11, s = tok & (SEQ - 1);
            const bf16_t* base = (const bf16_t*)(ws + off_vp(bb)) + (size_t)(tok - s) * PWD + 4 * lane;
            cnt[q] = 0;
#pragma unroll
            for (int jj = 0; jj < 16; ++jj) { const int j = s - hw + jj; const bool ok = (jj < 2 * hw) && (j >= 0) && (j < SEQ);
                vv[q][jj] = (u32x2){0u, 0u}; if (ok) vv[q][jj] = *(const u32x2*)(base + (size_t)j * PWD); cnt[q] += ok ? 1 : 0; }
            me[q] = *(const u32x2*)(base + (size_t)s * PWD);
#pragma unroll
            for (int it = 0; it < 2; ++it) {
                const int chunk = (it * 64 + lane < 96) ? it * 64 + lane : 95, h = chunk >> 3;
#pragma unroll
                for (int i = 0; i < 3; ++i) { const float* st = ST + (((size_t)i * M + tok) * NH + h) * 2; mm[q][it][i] = st[0]; ll[q][it][i] = st[1]; ov[q][it][i] = *(const u32x4*)(o_base(ws, (unsigned char*)a.out, i, bb) + (size_t)tok * AW + chunk * 8); }
            }
        }
#pragma unroll
        for (int q = 0; q < 2; ++q) {
            const int tok = (tokp + q * NGW < tok0 + ntok) ? tokp + q * NGW : tokp;
            bf16_t* MIX = (bf16_t*)(ws + off_mix(tok >> 11));
            float s0 = 0.f, s1 = 0.f, s2 = 0.f, s3 = 0.f;
#pragma unroll
            for (int jj = 0; jj < 16; ++jj) { s0 += __uint_as_float(vv[q][jj].x << 16); s1 += __uint_as_float(vv[q][jj].x & 0xffff0000u); s2 += __uint_as_float(vv[q][jj].y << 16); s3 += __uint_as_float(vv[q][jj].y & 0xffff0000u); }
            const float rc = 1.0f / (float)cnt[q];
            u32x2 w2; w2.x = pk2(s0 * rc - __uint_as_float(me[q].x << 16), s1 * rc - __uint_as_float(me[q].x & 0xffff0000u)); w2.y = pk2(s2 * rc - __uint_as_float(me[q].y << 16), s3 * rc - __uint_as_float(me[q].y & 0xffff0000u));
            *(u32x2*)(MIX + (size_t)tok * DM + 4 * lane) = w2;
#pragma unroll
            for (int it = 0; it < 2; ++it) {
                const int chunk = it * 64 + lane;
                float mxx = fmaxf(fmaxf(mm[q][it][0], mm[q][it][1]), mm[q][it][2]);
                float wgt[3], den = 0.f;
#pragma unroll
                for (int i = 0; i < 3; ++i) { wgt[i] = __builtin_amdgcn_exp2f(mm[q][it][i] - mxx) * ll[q][it][i]; den += wgt[i]; }
                const float rd = 1.0f / den;
                float acc[8] = {0.f, 0.f, 0.f, 0.f, 0.f, 0.f, 0.f, 0.f};
#pragma unroll
                for (int i = 0; i < 3; ++i) { const u32x4 v = ov[q][it][i]; const float wi = wgt[i] * rd;
                    acc[0] += wi * __uint_as_float(v.x << 16); acc[1] += wi * __uint_as_float(v.x & 0xffff0000u); acc[2] += wi * __uint_as_float(v.y << 16); acc[3] += wi * __uint_as_float(v.y & 0xffff0000u);
                    acc[4] += wi * __uint_as_float(v.z << 16); acc[5] += wi * __uint_as_float(v.z & 0xffff0000u); acc[6] += wi * __uint_as_float(v.w << 16); acc[7] += wi * __uint_as_float(v.w & 0xffff0000u); }
                u32x4 w; w.x = pk2(acc[0], acc[1]); w.y = pk2(acc[2], acc[3]); w.z = pk2(acc[4], acc[5]); w.w = pk2(acc[6], acc[7]);
                if (chunk < 96) *(u32x4*)(MIX + (size_t)tok * DM + PWD + chunk * 8) = w;
            }
        }
    }
}

__device__ __forceinline__ void final_norm(const Args& a, int wv0, int nwv, int tok0, int ntok) {
    const int tid = threadIdx.x, lane = tid & 63, wave = __builtin_amdgcn_readfirstlane(tid >> 6);
    const int gw = wv0 + wave, NGW = nwv;
    const f32x4* gr = (const f32x4*)a.nf + lane;
    const bf16_t* XH = (const bf16_t*)(a.ws + WS_XB); const bf16_t* XL = (const bf16_t*)(a.ws + WS_XL);
    for (int mp = tok0 + gw; mp < tok0 + ntok; mp += 2 * NGW) {
        u32x2 hh[2][4], ll[2][4];
#pragma unroll
        for (int q = 0; q < 2; ++q) { const int m = (mp + q * NGW < tok0 + ntok) ? mp + q * NGW : mp; const u32x2* ph = (const u32x2*)(XH + (size_t)m * DM) + lane; const u32x2* pl = (const u32x2*)(XL + (size_t)m * DM) + lane;
#pragma unroll
            for (int j = 0; j < 4; ++j) { hh[q][j] = ph[64 * j]; ll[q][j] = pl[64 * j]; } }
        f32x4 v[2][4]; float ri[2];
#pragma unroll
        for (int q = 0; q < 2; ++q) { float s = 0.f;
#pragma unroll
            for (int j = 0; j < 4; ++j) { const u32x2 h = hh[q][j], l = ll[q][j];
                v[q][j] = (f32x4){__uint_as_float(h.x << 16) + __uint_as_float(l.x << 16), __uint_as_float(h.x & 0xffff0000u) + __uint_as_float(l.x & 0xffff0000u), __uint_as_float(h.y << 16) + __uint_as_float(l.y << 16), __uint_as_float(h.y & 0xffff0000u) + __uint_as_float(l.y & 0xffff0000u)};
                s += (v[q][j][0] * v[q][j][0] + v[q][j][1] * v[q][j][1]) + (v[q][j][2] * v[q][j][2] + v[q][j][3] * v[q][j][3]); }
            ri[q] = 1.0f / sqrtf(wave_sum(s) * (1.0f / DM) + NORM_EPS); }
#pragma unroll
        for (int q = 0; q < 2; ++q) { if (q == 1 && mp + NGW >= tok0 + ntok) break; const int m = mp + q * NGW; f32x4* xr = (f32x4*)(a.out + (size_t)m * DM) + lane;
#pragma unroll
            for (int j = 0; j < 4; ++j) xr[64 * j] = v[q][j] * ri[q] * gr[64 * j]; }
    }
}

#define XB_TMO      128
#define XB_XCNT(j)  (256  + 64 * (j))
#define XB_XSUB(j)  (1280 + 64 * (j))
#define XB_XGEN(j)  (2304 + 64 * (j))
#define XB_TOP      3328
#define XB_TOPGEN   3392
#define XCD_BAR_WORDS 3456
#define XB_SPIN_CAP (1u << 18)

__device__ __forceinline__ unsigned xb_ld(unsigned* p)              { return __hip_atomic_load(p, __ATOMIC_RELAXED, __HIP_MEMORY_SCOPE_AGENT); }
__device__ __forceinline__ unsigned xb_add(unsigned* p, unsigned v) { return __hip_atomic_fetch_add(p, v, __ATOMIC_RELAXED, __HIP_MEMORY_SCOPE_AGENT); }
__device__ __forceinline__ unsigned xb_xcc_id() { return (unsigned)__builtin_amdgcn_s_getreg((3 << 11) | 20) & 0xFu; }
#define XB_SPIN(cond, bar) do { unsigned _sp = 0; while (cond) { __builtin_amdgcn_s_sleep(1); \
    if ((++_sp & 255u) == 0u) { if (xb_ld(&(bar)[XB_TMO])) break; if (_sp > XB_SPIN_CAP) { atomicAdd(&(bar)[XB_TMO], 1u); break; } } } } while (0)

struct XcdBarrier {
    unsigned* bar; unsigned x;
    volatile LAS unsigned* st;
};

__device__ __forceinline__ XcdBarrier xcd_barrier_post(unsigned* bar, volatile LAS unsigned* st) {
    XcdBarrier b; b.bar = bar; b.x = xb_xcc_id(); b.st = st;
    if (threadIdx.x == 0) (void)xb_add(&bar[XB_XCNT(b.x)], 1u);
    return b;
}
__device__ __forceinline__ void xcd_barrier_complete(unsigned* bar, unsigned x, unsigned& nloc, unsigned& nx) {
    const unsigned G = gridDim.x * gridDim.y * gridDim.z;
    unsigned sum, cnt, mine, sp = 0u;
    for (;;) {
        sum = 0u; cnt = 0u; mine = 0u;
#pragma unroll
        for (unsigned j = 0; j < 16; ++j) { const unsigned c = xb_ld(&bar[XB_XCNT(j)]); sum += c; cnt += (c > 0u) ? 1u : 0u; mine = (j == x) ? c : mine; }
        if (sum == G) break;
        __builtin_amdgcn_s_sleep(1);
        if ((++sp & 255u) == 0u) { if (xb_ld(&bar[XB_TMO])) break; if (sp > XB_SPIN_CAP) { atomicAdd(&bar[XB_TMO], 1u); break; } }
    }
    nloc = mine > 0u ? mine : 1u; nx = cnt > 0u ? cnt : 1u;
}

__device__ __forceinline__ void xcd_barrier(const XcdBarrier& b) {
    asm volatile("s_waitcnt vmcnt(0)" ::: "memory");
    __syncthreads();
    if (threadIdx.x == 0) {
        unsigned* bar = b.bar;
        __builtin_amdgcn_s_waitcnt(0);
        unsigned nloc = b.st[0], nx = b.st[1];
        if (nloc == 0u) { xcd_barrier_complete(bar, b.x, nloc, nx); b.st[0] = nloc; b.st[1] = nx; }
        const unsigned old = xb_add(&bar[XB_XSUB(b.x)], 1u);
        const unsigned gen = old / nloc;
        if (old + 1u == (gen + 1u) * nloc) {
            __builtin_amdgcn_fence(__ATOMIC_RELEASE, "agent");
            asm volatile("s_waitcnt vmcnt(0)" ::: "memory");
            const unsigned og = xb_add(&bar[XB_TOP], 1u);
            const unsigned tg = og / nx;
            if (og + 1u == (tg + 1u) * nx) xb_add(&bar[XB_TOPGEN], 1u);
            else XB_SPIN(xb_ld(&bar[XB_TOPGEN]) == tg, bar);
            __builtin_amdgcn_fence(__ATOMIC_ACQUIRE, "agent");
            xb_add(&bar[XB_XGEN(b.x)], 1u);
            asm volatile("s_waitcnt vmcnt(0)" ::: "memory");
        } else {
            XB_SPIN(xb_ld(&bar[XB_XGEN(b.x)]) == gen, bar);
            __builtin_amdgcn_fence(__ATOMIC_ACQUIRE, "agent");
            asm volatile("s_waitcnt vmcnt(0)" ::: "memory");
        }
    }
    __syncthreads();
}

#define XL_RANK(j) (3520 + 64 * (j))
#define XL_CNT(j)  (4608 + 64 * (j))
__device__ __forceinline__ void local_barrier(unsigned* ctl, unsigned x) {
    asm volatile("s_waitcnt vmcnt(0)" ::: "memory");
    __syncthreads();
    if (threadIdx.x == 0) {
        __builtin_amdgcn_s_waitcnt(0);
        const unsigned old = xb_add(&ctl[XL_CNT(x)], 1u), target = (old / 32u + 1u) * 32u;
        XB_SPIN(xb_ld(&ctl[XL_CNT(x)]) < target, ctl);
        __builtin_amdgcn_fence(__ATOMIC_ACQUIRE, "agent");
        asm volatile("s_waitcnt vmcnt(0)" ::: "memory");
    }
    __syncthreads();
}

constexpr int LDS_BYTES = 152576;
__global__ void __launch_bounds__(512, 2) fwd(Args a) {
    extern __shared__ __attribute__((aligned(16))) unsigned char lds_raw[];
    LAS unsigned char* lds = (LAS unsigned char*)lds_raw;
    cg::grid_group grid = cg::this_grid();
    const int G = gridDim.x;
    const int vcu0 = (G % 8 == 0) ? ((int)blockIdx.x % 8) * (G / 8) + (int)blockIdx.x / 8 : (int)blockIdx.x;
    unsigned char* ws = a.ws;
    unsigned* ctl = (unsigned*)(ws + WS_CTL);
    bf16_t* XB = (bf16_t*)(ws + WS_XB); bf16_t* ACT = (bf16_t*)(ws + WS_A); float* P = (float*)(ws + WS_SSQ); float* CS = (float*)(ws + WS_ROPE);

    LAS float* RT = (LAS float*)(lds + 149760);
    volatile LAS unsigned* BST = (volatile LAS unsigned*)(lds + 149760 + 2048);
    const unsigned xcc = xb_xcc_id();
    if (threadIdx.x == 0) { BST[0] = 0u; BST[1] = 0u; BST[2] = xb_add(&ctl[XL_RANK(xcc)], 1u); BST[3] = 0u; }
    __syncthreads();
    const XcdBarrier bar = xcd_barrier_post(ctl, BST);
    if (a.never) grid.sync();
    prologue(a, lds, vcu0, G);
    xcd_barrier(bar);
    if (threadIdx.x == 0) {
        bool ok = (G == 256);
        for (unsigned j = 0; j < 16; ++j) { const unsigned cnt = xb_ld(&ctl[XB_XCNT(j)]); ok = ok && (cnt == (j < 8 ? 32u : 0u)); }
        BST[3] = (ok && xb_ld(&ctl[XB_TMO]) == 0u) ? 1u : 0u;
    }
    __syncthreads();
    const bool local = BST[3] != 0u;
    const int rank = (int)BST[2];
    const int bx = local ? rank * 8 + (int)xcc : (int)blockIdx.x;
    const int wv0 = local ? rank * 8 : vcu0 * 8, nwv = local ? 256 : G * 8, tok0 = local ? (int)xcc * SEQ : 0, ntok = local ? SEQ : M;
#define SEAM() do { if (local) local_barrier(ctl, xcc); else xcd_barrier(bar); } while (0)
    for (int st = 0; st < 3 * DEPTH; ++st) {
        const int l = st / 3, kind = st % 3;
        unsigned char* wl = ws + WS_W + (size_t)l * LW_SIZE;
        asm volatile("" : "+s"(wl));
        if (kind != 1) {
            const bf16_t* Wgu = (const bf16_t*)(wl + (kind ? LW_GU2 : LW_GU1)); const bf16_t* Wd = (const bf16_t*)(wl + (kind ? LW_D2 : LW_D1));
            { pg8::Gemm g{XB, Wgu, M, NGU, DM}; epi::RinvOrder<pg8::StaticOrder> S; S.init(M, NGU, G, bx); S.P = P; S.tab = RT;
              const int nfull = S.nwg / G; const bool split = false && (S.nwg - nfull * G) * 2 == G && (G % 16 == 0);
              if (split) S.imax = nfull;
              { epi::EpiSwiGLU<2> E{ACT, RT}; pg8::gemm_phase<epi::EpiSwiGLU<2>, epi::RinvOrder<pg8::StaticOrder>, true, true>(lds, g, S, E); }
              if (split) { epi::RinvOrder<pg8::HalfOrder> H; H.init(M, NGU, G, bx); H.nfull = nfull; H.P = P; H.tab = RT; epi::EpiSwiGLU<1> E{ACT, RT};
                pg8::gemm_phase<epi::EpiSwiGLU<1>, epi::RinvOrder<pg8::HalfOrder>, true, true, true>(lds, g, H, E); } }
            SEAM();
            { pg8::Gemm g{ACT, Wd, M, DM, DFF}; pg8::StaticOrder S; S.init(M, DM, G, bx); epi::EpiResid E{st == 0 ? a.x : nullptr, XB, (bf16_t*)(ws + WS_XL), P, 0.5f};
              pg8::gemm_phase<epi::EpiResid, pg8::StaticOrder, true, true>(lds, g, S, E); }
            SEAM();
        } else {
            { pg8::Gemm g{XB, (const bf16_t*)(wl + LW_IN), M, NIN, DM}; epi::RinvOrder<pg8::StaticOrder> S; S.init(M, NIN, G, bx); S.P = P; S.tab = RT; const int bb = bx & 7;
              const int nfull = S.nwg / G; const bool split = false && (S.nwg - nfull * G) * 2 == G && (G % 16 == 0);
              if (split) S.imax = nfull;
              bf16_t* vp_ = (bf16_t*)(ws + off_vp(bb)); bf16_t* q_ = (bf16_t*)(ws + off_q(bb)); bf16_t* k_ = (bf16_t*)(ws + off_k(bb)); bf16_t* v_ = (bf16_t*)(ws + off_v(bb));
              { epi::EpiProj<2> E{vp_, q_, k_, v_, RT, CS}; pg8::gemm_phase<epi::EpiProj<2>, epi::RinvOrder<pg8::StaticOrder>, true, true>(lds, g, S, E); }
              if (split) { epi::RinvOrder<pg8::HalfOrder> H; H.init(M, NIN, G, bx); H.nfull = nfull; H.P = P; H.tab = RT; epi::EpiProj<1> E{vp_, q_, k_, v_, RT, CS};
                pg8::gemm_phase<epi::EpiProj<1>, epi::RinvOrder<pg8::HalfOrder>, true, true, true>(lds, g, H, E); } }
            SEAM();
            if (local) att::phase(lds, ws, (unsigned char*)a.out, (int)xcc * NH * 24 + rank, 32, ((int)xcc + 1) * NH * 24); else att::phase(lds, ws, (unsigned char*)a.out, bx, G, BATCH * NH * 24);
            SEAM();
            combine_phase(a, wv0, nwv, tok0, ntok);
            SEAM();
            { pg8::Gemm g{(const bf16_t*)(ws + off_mix(bx & 7)), (const bf16_t*)(wl + LW_OUT), M, DM, DM}; pg8::StaticOrder S; S.init(M, DM, G, bx); epi::EpiResid E{nullptr, XB, (bf16_t*)(ws + WS_XL), P, 1.0f};
              pg8::gemm_phase<epi::EpiResid, pg8::StaticOrder, true, true>(lds, g, S, E); }
            SEAM();
        }
    }
    final_norm(a, wv0, nwv, tok0, ntok);
}

extern "C" void kernel_launch(void* const* d_in, const int* in_sizes, int n_in, void* d_out, int out_size, void* d_ws, size_t ws_size, hipStream_t stream) {
    static int grid = 0;
    if (grid == 0) {
        if (n_in != 16 || in_sizes[0] != M * DM || out_size != M * DM || ws_size < WS_END) { fprintf(stderr, "kernel_launch: unexpected shapes (n_in %d in0 %d out %d ws %zu)\n", n_in, n_in > 0 ? in_sizes[0] : -1, out_size, ws_size); grid = -1; return; }
        int dev = 0, cus = 0, per_cu = 0;
        if (hipGetDevice(&dev) != hipSuccess || hipDeviceGetAttribute(&cus, hipDeviceAttributeMultiprocessorCount, dev) != hipSuccess) { grid = -1; return; }
        if (hipFuncSetAttribute((const void*)fwd, hipFuncAttributeMaxDynamicSharedMemorySize, LDS_BYTES) != hipSuccess) { fprintf(stderr, "kernel_launch: hipFuncSetAttribute failed\n"); grid = -1; return; }
        if (hipOccupancyMaxActiveBlocksPerMultiprocessor(&per_cu, (const void*)fwd, 512, LDS_BYTES) != hipSuccess || per_cu < 1) fprintf(stderr, "kernel_launch: occupancy query says %d\n", per_cu);
        (void)hipGetLastError();
        grid = cus;
    }
    if (grid < 0) return;
    if (hipMemsetAsync((char*)d_ws + WS_CTL, 0, CTL_BYTES, stream) != hipSuccess) { fprintf(stderr, "kernel_launch: memset failed\n"); return; }
    Args a{};
    a.x = (const float*)d_in[0]; a.pos = (const int*)d_in[1];
    a.n1 = (const float*)d_in[2]; a.g1 = (const float*)d_in[3]; a.u1 = (const float*)d_in[4]; a.d1 = (const float*)d_in[5];
    a.nm = (const float*)d_in[6]; a.win = (const float*)d_in[7]; a.pw = (const float*)d_in[8]; a.ps = (const float*)d_in[9]; a.wout = (const float*)d_in[10];
    a.n2 = (const float*)d_in[11]; a.g2 = (const float*)d_in[12]; a.u2 = (const float*)d_in[13]; a.d2 = (const float*)d_in[14]; a.nf = (const float*)d_in[15];
    a.out = (float*)d_out; a.ws = (unsigned char*)d_ws;
    for (int i = 0; i < 8; ++i) a.inv_freq[i] = (float)pow(500000.0, -(double)i / 8.0);
    void* args[] = {&a};
    hipError_t e = hipLaunchCooperativeKernel((const void*)fwd, dim3(grid), dim3(512), args, LDS_BYTES, stream);
    if (e != hipSuccess) fprintf(stderr, "cooperative launch failed: %s (grid %d)\n", hipGetErrorString(e), grid);
}
```

```cpp
#include <hip/hip_runtime.h>
#include <hip/hip_cooperative_groups.h>
#include <cstdio>
#include <cstdint>
#include <cmath>
namespace cg = cooperative_groups;
namespace pg8 {
#define PG8_LAS __attribute__((address_space(3)))
typedef unsigned short bf16_t;
typedef short bf16x8 __attribute__((ext_vector_type(8)));
typedef float f32x4 __attribute__((ext_vector_type(4)));
typedef unsigned u32x4 __attribute__((ext_vector_type(4)));
constexpr int BM = 256, BK = 64, HALF = 128, HTB = HALF * BK * 2  , STAGE_BYTES = 8 * HTB, NXCD = 8, WGM = 8;

__host__ __device__ __forceinline__ int lds_byte(int r, int c) { const int st = (r >> 4) * 2 + (c >> 5), rr = r & 15, cc = c & 31, ob = rr * 64 + cc * 2; return st * 1024 + (ob ^ (((ob >> 9) & 1) << 5)); }
__host__ __device__ __forceinline__ void stage_rc(int b, int& R, int& C) { const int st = b / 1024, sb = b % 1024, swz = sb ^ (((sb >> 9) & 1) << 5); R = (st >> 1) * 16 + swz / 64; C = (st & 1) * 32 + (swz % 64) / 2; }
__host__ __device__ __forceinline__ int perm32(int rho) { const int n = rho >> 4, i = rho & 15; return 8 * (i >> 2) + 4 * n + (i & 3); }

struct Unit { int pm, pn, par, roff; };
struct Gemm { const bf16_t* A; const bf16_t* Bt; int M, N, K, nkt; };

struct StaticOrder {
    int nM, nN, nwg, G, c, imax;
    __host__ __device__ void init(int M, int N, int G_, int c_) { nM = M / BM; nN = N / BM; nwg = nM * nN; G = G_; c = c_; imax = 1 << 30; }
    __host__ __device__ void decode(long L, Unit& u) const {
        int wgid = (int)L; { const int q = nwg / NXCD, r = nwg % NXCD, xcd = wgid % NXCD, off = wgid / NXCD; wgid = (xcd < r ? xcd * (q + 1) : r * (q + 1) + (xcd - r) * q) + off; }
        const int nig = WGM * nN, gid = wgid / nig, fm = gid * WGM, gsz = (nM - fm) < WGM ? (nM - fm) : WGM;
        u.pm = fm + ((wgid % nig) % gsz); u.pn = (wgid % nig) / gsz;
    }
    __host__ __device__ bool next(int i, Unit& u) const {
        const long L = (long)i * G + c; if (i >= imax || L >= nwg) return false;
        decode(L, u); u.par = i & 1; u.roff = 0; return true;
    }
    __device__ __forceinline__ void a_ready(const Unit&) const {}
    __device__ __forceinline__ void done(const Unit&) const {}
};
struct HalfOrder : StaticOrder {
    int nfull;
    __host__ __device__ bool next(int i, Unit& u) const {
        if (i != 0) return false;
        const int xcd = c % NXCD, rho = c / NXCD; const long L = ((long)nfull * (G / NXCD) + (rho >> 1)) * NXCD + xcd; if (L >= nwg) return false;
        decode(L, u); u.par = 0; u.roff = 0; return true;
    }
};
__device__ __forceinline__ unsigned cvt_pk_bf16(float lo, float hi) { unsigned r; asm volatile("v_cvt_pk_bf16_f32 %0, %1, %2" : "=v"(r) : "v"(lo), "v"(hi)); return r; }
template <class Epi, class Sched, bool ALIGN_EPI = false, bool SP2 = false, bool HALFM = false>
__device__ __forceinline__ void gemm_phase(PG8_LAS unsigned char* lds, const Gemm g, const Sched& S, const Epi& E) {
    int tid_ = threadIdx.x; asm volatile("" : "+v"(tid_));
    const int tid = tid_, wid = __builtin_amdgcn_readfirstlane(tid >> 6), lane = tid & 63, wr = wid >> 2, wc = wid & 3, fr = lane & 15, fq = lane >> 4;
    static_assert(!HALFM || SP2, "HALFM is written for the SP2 loop");
    const int K = g.K, nt = g.nkt ? g.nkt : K / BK;
    unsigned voffA[2], voffB[2];
#pragma unroll
    for (int i = 0; i < 2; ++i) { int R, C; stage_rc(tid * 16 + i * 8192, R, C); const int Rb = Epi::PERM ? ((R & ~31) + perm32(R & 31)) : R;
        voffA[i] = (unsigned)(R * K + C) * 2u; voffB[i] = (unsigned)(Rb * K + C) * 2u; }
    const size_t kstep = (size_t)(BK * 2);
    const size_t hstep = (size_t)HALF * K * 2;
    const size_t tstep = 2 * hstep;
    const unsigned ldsw = (unsigned)wid * 1024u;
    const int aoff = lds_byte(wr * 64 + fr, fq * 8), boff = lds_byte(wc * 32 + fr, fq * 8);
#define PG8_SA(b, h) (((b) * 2 + (h)) * HTB)
#define PG8_SB(b, h) ((4 + (b) * 2 + (h)) * HTB)
#define PG8_STAGE(bufoff, gbase, voff) do { _Pragma("unroll") for (int _i = 0; _i < 2; ++_i) \
        __builtin_amdgcn_global_load_lds((const unsigned*)((const char*)(gbase) + (voff)[_i]), (PG8_LAS unsigned*)(lds + (bufoff) + ldsw + _i * 8192), 16, 0, 0); } while (0)
#define PG8_LDA(dst, b, h) do { _Pragma("unroll") for (int m = 0; m < 4; ++m) _Pragma("unroll") for (int k = 0; k < 2; ++k) dst[m][k] = *(const PG8_LAS bf16x8*)(lds + PG8_SA(b, h) + aoff + m * 2048 + k * 1024); } while (0)
#define PG8_LDB(dst, b, h) do { _Pragma("unroll") for (int n = 0; n < 2; ++n) _Pragma("unroll") for (int k = 0; k < 2; ++k) dst[n][k] = *(const PG8_LAS bf16x8*)(lds + PG8_SB(b, h) + boff + n * 2048 + k * 1024); } while (0)
#define PG8_MMA(ai, bj, At, Bt) do { __builtin_amdgcn_s_setprio(1); _Pragma("unroll") for (int m = 0; m < 4; ++m) _Pragma("unroll") for (int n = 0; n < 2; ++n) _Pragma("unroll") for (int k = 0; k < 2; ++k) \
        acc[ai][bj][m][n] = __builtin_amdgcn_mfma_f32_16x16x32_bf16(Bt[n][k], At[m][k], acc[ai][bj][m][n], 0, 0, 0); __builtin_amdgcn_s_setprio(0); } while (0)
#define PG8_WAIT_V(n) asm volatile("s_waitcnt vmcnt(" #n ")" ::: "memory")
#define PG8_WAIT_L(n) asm volatile("s_waitcnt lgkmcnt(" #n ")" ::: "memory")
#define PG8_BAR __builtin_amdgcn_s_barrier()
#define PG8_SCHED __builtin_amdgcn_sched_barrier(0)
    Unit cur, nxt; int ui = 0;
    if (!S.next(0, cur)) return;
    f32x4 acc[2][2][4][2];
#pragma unroll
    for (int a = 0; a < 2; ++a)
#pragma unroll
        for (int b = 0; b < 2; ++b)
#pragma unroll
            for (int m = 0; m < 4; ++m)
#pragma unroll
                for (int n = 0; n < 2; ++n) acc[a][b][m][n] = (f32x4){0.f, 0.f, 0.f, 0.f};
    bf16x8 At[4][2], B0[2][2], B1[2][2];
    const char* cA = (const char*)g.A + (size_t)cur.pm * tstep + (size_t)cur.roff * K * 2; const char* cB = (const char*)g.Bt + (size_t)cur.pn * tstep;
    S.a_ready(cur);
    if constexpr (SP2) {
        PG8_STAGE(PG8_SB(0, 0), cB, voffB); PG8_STAGE(PG8_SB(0, 1), cB + hstep, voffB); PG8_STAGE(PG8_SA(0, 0), cA, voffA); PG8_STAGE(PG8_SA(0, 1), cA + hstep, voffA);
        if (wr == 1) PG8_BAR;
        PG8_WAIT_V(2); PG8_BAR;
        PG8_STAGE(PG8_SB(1, 0), cB + kstep, voffB); PG8_STAGE(PG8_SA(1, 0), cA + kstep, voffA); PG8_STAGE(PG8_SB(1, 1), cB + hstep + kstep, voffB);
        PG8_WAIT_V(6); PG8_BAR;
    } else {
        PG8_STAGE(PG8_SB(0, 0), cB, voffB); PG8_STAGE(PG8_SA(0, 0), cA, voffA); PG8_STAGE(PG8_SB(0, 1), cB + hstep, voffB); PG8_STAGE(PG8_SA(0, 1), cA + hstep, voffA);
        if (wr == 1) PG8_BAR;
        PG8_WAIT_V(4); PG8_BAR;
        PG8_STAGE(PG8_SB(1, 0), cB + kstep, voffB); PG8_STAGE(PG8_SA(1, 0), cA + kstep, voffA); PG8_STAGE(PG8_SB(1, 1), cB + hstep + kstep, voffB);
        PG8_WAIT_V(6); PG8_BAR;
    }
    for (;;) {
        const bool has_next = S.next(ui + 1, nxt);
        const char* nA = has_next ? (const char*)g.A + (size_t)nxt.pm * tstep + (size_t)nxt.roff * K * 2 : cA; const char* nB = has_next ? (const char*)g.Bt + (size_t)nxt.pn * tstep : cB;
        for (int t = 0; t < nt; t += 2) {
            const bool last = (t == nt - 2);
            const char* a1 = cA + (size_t)(t + 1) * kstep;
            const char* a2 = last ? nA : cA + (size_t)(t + 2) * kstep; const char* b2 = last ? nB : cB + (size_t)(t + 2) * kstep;
            const char* a3 = a2 + kstep; const char* b3 = b2 + kstep;
            if (last && has_next) S.a_ready(nxt);
            if constexpr (SP2) {
            PG8_LDB(B0, 0, 0); PG8_LDB(B1, 0, 1); PG8_SCHED; PG8_LDA(At, 0, 0); PG8_STAGE(PG8_SA(1, 1), a1 + hstep, voffA);
            PG8_WAIT_V(8); PG8_WAIT_L(0); PG8_BAR; PG8_MMA(0, 0, At, B0); PG8_MMA(0, 1, At, B1); PG8_BAR; PG8_SCHED;
            if constexpr (!HALFM) PG8_LDA(At, 0, 1); PG8_STAGE(PG8_SB(0, 0), b2, voffB); PG8_STAGE(PG8_SB(0, 1), b2 + hstep, voffB); PG8_STAGE(PG8_SA(0, 0), a2, voffA);
            PG8_WAIT_V(8); PG8_WAIT_L(0); PG8_BAR; if constexpr (!HALFM) { PG8_MMA(1, 0, At, B0); PG8_MMA(1, 1, At, B1); } PG8_BAR; PG8_SCHED;
            PG8_LDB(B0, 1, 0); PG8_LDB(B1, 1, 1); PG8_SCHED; PG8_LDA(At, 1, 0); PG8_STAGE(PG8_SA(0, 1), a2 + hstep, voffA);
            PG8_WAIT_V(8); PG8_WAIT_L(0); PG8_BAR; PG8_MMA(0, 0, At, B0); PG8_MMA(0, 1, At, B1); PG8_BAR; PG8_SCHED;
            if constexpr (!HALFM) PG8_LDA(At, 1, 1); PG8_STAGE(PG8_SB(1, 0), b3, voffB); PG8_STAGE(PG8_SB(1, 1), b3 + hstep, voffB); PG8_STAGE(PG8_SA(1, 0), a3, voffA);
            PG8_WAIT_V(8); PG8_WAIT_L(0); PG8_BAR; if constexpr (!HALFM) { PG8_MMA(1, 0, At, B0); PG8_MMA(1, 1, At, B1); } PG8_BAR; PG8_SCHED;
            } else {
            PG8_LDB(B0, 0, 0); PG8_SCHED; PG8_LDA(At, 0, 0); PG8_STAGE(PG8_SA(1, 1), a1 + hstep, voffA);
            PG8_WAIT_L(8); PG8_BAR; PG8_WAIT_L(0); PG8_MMA(0, 0, At, B0); PG8_BAR; PG8_SCHED;
            PG8_LDB(B1, 0, 1); PG8_STAGE(PG8_SB(0, 0), b2, voffB);
            PG8_BAR; PG8_WAIT_L(0); PG8_MMA(0, 1, At, B1); PG8_BAR;
            PG8_LDA(At, 0, 1); PG8_STAGE(PG8_SA(0, 0), a2, voffA);
            PG8_BAR; PG8_WAIT_L(0); PG8_MMA(1, 0, At, B0); PG8_BAR; PG8_SCHED;
            PG8_STAGE(PG8_SB(0, 1), b2 + hstep, voffB);
            PG8_WAIT_V(6); PG8_BAR; PG8_MMA(1, 1, At, B1); PG8_BAR;
            PG8_LDB(B0, 1, 0); PG8_SCHED; PG8_LDA(At, 1, 0); PG8_STAGE(PG8_SA(0, 1), a2 + hstep, voffA);
            PG8_WAIT_L(8); PG8_BAR; PG8_WAIT_L(0); PG8_MMA(0, 0, At, B0); PG8_BAR; PG8_SCHED;
            PG8_LDB(B1, 1, 1); PG8_STAGE(PG8_SB(1, 0), b3, voffB);
            PG8_BAR; PG8_WAIT_L(0); PG8_MMA(0, 1, At, B1); PG8_BAR;
            PG8_LDA(At, 1, 1); PG8_STAGE(PG8_SA(1, 0), a3, voffA);
            PG8_BAR; PG8_WAIT_L(0); PG8_MMA(1, 0, At, B0); PG8_BAR; PG8_SCHED;
            PG8_STAGE(PG8_SB(1, 1), b3 + hstep, voffB);
            PG8_WAIT_V(6); PG8_BAR; PG8_MMA(1, 1, At, B1); PG8_BAR;
            }
        }
        if constexpr (ALIGN_EPI) { if (wr == 0) PG8_BAR; }
        if constexpr (!Epi::AFTER_DRAIN) { E(acc, cur, wr, wc, fr, fq); S.done(cur); }
        if (!has_next) break;
#pragma unroll
        for (int a = 0; a < 2; ++a)
#pragma unroll
            for (int b = 0; b < 2; ++b)
#pragma unroll
                for (int m = 0; m < 4; ++m)
#pragma unroll
                    for (int n = 0; n < 2; ++n) acc[a][b][m][n] = (f32x4){0.f, 0.f, 0.f, 0.f};
        cur = nxt; cA = nA; cB = nB; ++ui;
        if constexpr (ALIGN_EPI) { if (wr == 1) PG8_BAR; }
    }
    PG8_WAIT_V(0);
    if constexpr (!ALIGN_EPI) { if (wr == 0) PG8_BAR; }
    PG8_BAR;
    if constexpr (Epi::AFTER_DRAIN) { E.fused(acc, cur, wr, wc, fr, fq, lds, wid, lane); S.done(cur); }
#undef PG8_SA
#undef PG8_SB
#undef PG8_STAGE
#undef PG8_LDA
#undef PG8_LDB
#undef PG8_MMA
#undef PG8_WAIT_V
#undef PG8_WAIT_L
#undef PG8_BAR
#undef PG8_SCHED
}
}

constexpr int DM = 1024, BATCH = 8, SEQ = 2048, DEPTH = 4, M = BATCH * SEQ;
constexpr int DFF = 2816, NGU = 2 * DFF, NIN = 2560, AW = 768, PWD = 256, NH = 12, HD = 64;
constexpr float NORM_EPS = 1e-6f;
constexpr float QSCALE = 0.125f * 1.4426950408889634f;

#define GAS __attribute__((address_space(1)))
#define LAS __attribute__((address_space(3)))
typedef unsigned short bf16_t;
typedef unsigned u32x4 __attribute__((ext_vector_type(4)));
typedef unsigned u32x2 __attribute__((ext_vector_type(2)));
typedef float f32x4 __attribute__((ext_vector_type(4)));
typedef float f32x16 __attribute__((ext_vector_type(16)));
typedef short bf16x8 __attribute__((ext_vector_type(8)));
typedef short s16x4 __attribute__((ext_vector_type(4)));

constexpr size_t MiB = 1u << 20;
constexpr size_t W_GU = (size_t)NGU * DM * 2, W_D = (size_t)DM * DFF * 2, W_IN = (size_t)NIN * DM * 2, W_OUT = (size_t)DM * DM * 2;
constexpr size_t LW_GU1 = 0, LW_D1 = LW_GU1 + W_GU, LW_IN = LW_D1 + W_D, LW_OUT = LW_IN + W_IN, LW_GU2 = LW_OUT + W_OUT, LW_D2 = LW_GU2 + W_GU, LW_SIZE = LW_D2 + W_D;
static_assert(LW_SIZE == 40 * MiB, "per-layer weight block");
constexpr size_t WS_W = 0;
constexpr size_t WS_XB = 160 * MiB;
constexpr size_t WS_A = 192 * MiB;
__host__ __device__ constexpr size_t off_q(int b) { return WS_A + (size_t)b * 8 * MiB; }
__host__ __device__ constexpr size_t off_vp(int b) { return WS_A + 4 * MiB + (size_t)b * 10 * MiB; }
__host__ __device__ constexpr size_t off_k(int b) { return WS_A + 5 * MiB + (size_t)b * 8 * MiB; }
__host__ __device__ constexpr size_t off_v(int b) { return WS_A + 8 * MiB + (size_t)b * 8 * MiB; }
__host__ __device__ constexpr size_t off_mix(int b) { return WS_A + (size_t)b * 7 * MiB; }
constexpr size_t WS_O = 280 * MiB;
constexpr size_t WS_XL = 328 * MiB;
constexpr size_t WS_STAT = 360 * MiB;
constexpr size_t WS_SSQ = 365 * MiB;
constexpr size_t WS_ROPE = 366 * MiB;
constexpr size_t WS_CTL = 367 * MiB, CTL_BYTES = 32768;
constexpr size_t WS_END = 368 * MiB;
__device__ __forceinline__ bf16_t* o_base(unsigned char* ws, unsigned char* dout, int br, int b) { return br < 2 ? (bf16_t*)(ws + WS_O) + (size_t)br * M * AW : (bf16_t*)(dout + (size_t)b * 5 * MiB); }
static_assert((size_t)M * DFF * 2 <= 88 * MiB && (size_t)3 * M * NH * 2 * 4 <= 5 * MiB, "ws map");

struct Args {
    const float* x; const int* pos;
    const float *n1, *g1, *u1, *d1, *nm, *win, *pw, *ps, *wout, *n2, *g2, *u2, *d2, *nf;
    float* out; unsigned char* ws;
    float inv_freq[8];
    int never, pad;
};

namespace epi {
using pg8::Unit; using pg8::BM; using pg8::HALF;
__device__ __forceinline__ float rinv_of(const float* P, int row) {
    const f32x4* p = (const f32x4*)(P + (size_t)row * 16);
    const f32x4 a = p[0], b = p[1], c = p[2], d = p[3];
    const float s = ((a[0] + a[1]) + (a[2] + a[3])) + ((b[0] + b[1]) + (b[2] + b[3])) + ((c[0] + c[1]) + (c[2] + c[3])) + ((d[0] + d[1]) + (d[2] + d[3]));
    return __builtin_amdgcn_rsqf(s * (1.0f / DM) + NORM_EPS);
}
template <class Base> struct RinvOrder : Base {
    const float* P; LAS float* tab;
    __device__ __forceinline__ void a_ready(const Unit& u) const { int t = threadIdx.x; asm volatile("" : "+v"(t)); if (t < 256 - u.roff) tab[u.par * 256 + t] = rinv_of(P, u.pm * BM + u.roff + t); }
};
__device__ __forceinline__ float silu_mul(float g, float u) {
    const float e = __builtin_amdgcn_exp2f(-1.4426950408889634f * g);
    return g * __builtin_amdgcn_rcpf(1.0f + e) * u;
}
template <int NAI> struct EpiSwiGLU {
    static constexpr bool PERM = true, AFTER_DRAIN = false;
    bf16_t* O; const LAS float* tab;
    __device__ __forceinline__ void operator()(const f32x4 (&acc)[2][2][4][2], const Unit& u, int wr, int wc, int fr, int fq) const {
        const int row0 = u.pm * BM + u.roff + wr * 64 + fr, col0 = u.pn * HALF + wc * 32 + 8 * fq;
#pragma unroll
        for (int ai = 0; ai < NAI; ++ai)
#pragma unroll
            for (int m = 0; m < 4; ++m) {
                const int row = row0 + ai * HALF + m * 16; const float ri = tab[u.par * 256 + ai * HALF + wr * 64 + m * 16 + fr];
                const f32x4 g0 = acc[ai][0][m][0] * ri, g1 = acc[ai][0][m][1] * ri, u0 = acc[ai][1][m][0] * ri, u1 = acc[ai][1][m][1] * ri;
                u32x4 w;
                w.x = pg8::cvt_pk_bf16(silu_mul(g0[0], u0[0]), silu_mul(g0[1], u0[1])); w.y = pg8::cvt_pk_bf16(silu_mul(g0[2], u0[2]), silu_mul(g0[3], u0[3]));
                w.z = pg8::cvt_pk_bf16(silu_mul(g1[0], u1[0]), silu_mul(g1[1], u1[1])); w.w = pg8::cvt_pk_bf16(silu_mul(g1[2], u1[2]), silu_mul(g1[3], u1[3]));
                *(u32x4*)(O + (size_t)row * DFF + col0) = w;
                if (m & 1) asm volatile("" ::: "memory");
            }
    }
};
struct EpiResid {
    static constexpr bool PERM = true, AFTER_DRAIN = false;
    const float* X0; bf16_t* XH; bf16_t* XL; float* P; float scale;
    __device__ __forceinline__ void operator()(const f32x4 (&acc)[2][2][4][2], const Unit& u, int wr, int wc, int fr, int fq) const {
        const int row0 = u.pm * BM + wr * 64 + fr, col0 = u.pn * BM + wc * 32 + 8 * fq;
#pragma unroll
        for (int g2 = 0; g2 < 4; ++g2) {
            const int ai = g2 >> 1;
            f32x4 xa[2][2][2];
            if (X0) {
#pragma unroll
                for (int mm = 0; mm < 2; ++mm)
#pragma unroll
                    for (int bj = 0; bj < 2; ++bj) { const float* xp = X0 + (size_t)(row0 + ai * HALF + ((g2 & 1) * 2 + mm) * 16) * DM + col0 + bj * HALF; xa[mm][bj][0] = *(const f32x4*)xp; xa[mm][bj][1] = *(const f32x4*)(xp + 4); }
            } else {
                u32x4 hh[2][2], ll[2][2];
#pragma unroll
                for (int mm = 0; mm < 2; ++mm)
#pragma unroll
                    for (int bj = 0; bj < 2; ++bj) { const size_t off = (size_t)(row0 + ai * HALF + ((g2 & 1) * 2 + mm) * 16) * DM + col0 + bj * HALF; hh[mm][bj] = *(const u32x4*)(XH + off); ll[mm][bj] = *(const u32x4*)(XL + off); }
#pragma unroll
                for (int mm = 0; mm < 2; ++mm)
#pragma unroll
                    for (int bj = 0; bj < 2; ++bj) { const u32x4 h = hh[mm][bj], l = ll[mm][bj];
                        xa[mm][bj][0] = (f32x4){__uint_as_float(h.x << 16) + __uint_as_float(l.x << 16), __uint_as_float(h.x & 0xffff0000u) + __uint_as_float(l.x & 0xffff0000u), __uint_as_float(h.y << 16) + __uint_as_float(l.y << 16), __uint_as_float(h.y & 0xffff0000u) + __uint_as_float(l.y & 0xffff0000u)};
                        xa[mm][bj][1] = (f32x4){__uint_as_float(h.z << 16) + __uint_as_float(l.z << 16), __uint_as_float(h.z & 0xffff0000u) + __uint_as_float(l.z & 0xffff0000u), __uint_as_float(h.w << 16) + __uint_as_float(l.w << 16), __uint_as_float(h.w & 0xffff0000u) + __uint_as_float(l.w & 0xffff0000u)}; }
            }
#pragma unroll
            for (int mm = 0; mm < 2; ++mm) {
                const int m = (g2 & 1) * 2 + mm;
                const int row = row0 + ai * HALF + m * 16; float ss = 0.f;
#pragma unroll
                for (int bj = 0; bj < 2; ++bj) {
                    const f32x4 a = xa[mm][bj][0] + acc[ai][bj][m][0] * scale, b = xa[mm][bj][1] + acc[ai][bj][m][1] * scale;
                    u32x4 w; w.x = pg8::cvt_pk_bf16(a[0], a[1]); w.y = pg8::cvt_pk_bf16(a[2], a[3]); w.z = pg8::cvt_pk_bf16(b[0], b[1]); w.w = pg8::cvt_pk_bf16(b[2], b[3]);
                    u32x4 wl;
                    wl.x = pg8::cvt_pk_bf16(a[0] - __uint_as_float(w.x << 16), a[1] - __uint_as_float(w.x & 0xffff0000u)); wl.y = pg8::cvt_pk_bf16(a[2] - __uint_as_float(w.y << 16), a[3] - __uint_as_float(w.y & 0xffff0000u));
                    wl.z = pg8::cvt_pk_bf16(b[0] - __uint_as_float(w.z << 16), b[1] - __uint_as_float(w.z & 0xffff0000u)); wl.w = pg8::cvt_pk_bf16(b[2] - __uint_as_float(w.w << 16), b[3] - __uint_as_float(w.w & 0xffff0000u));
                    const size_t off = (size_t)row * DM + col0 + bj * HALF;
                    *(u32x4*)(XH + off) = w; *(u32x4*)(XL + off) = wl;
                    ss += (a[0] * a[0] + a[1] * a[1]) + (a[2] * a[2] + a[3] * a[3]) + (b[0] * b[0] + b[1] * b[1]) + (b[2] * b[2] + b[3] * b[3]);
                }
                ss += __shfl_xor(ss, 16); ss += __shfl_xor(ss, 32);
                if (fq == 0) P[(size_t)row * 16 + u.pn * 4 + wc] = ss;
            }
            asm volatile("" ::: "memory");
        }
    }
};
template <int NAI> struct EpiProj {
    static constexpr bool PERM = true, AFTER_DRAIN = false;
    bf16_t *VP, *Q, *K, *V; const LAS float* tab; const float* CS;
    __device__ __forceinline__ void operator()(const f32x4 (&acc)[2][2][4][2], const Unit& u, int wr, int wc, int fr, int fq) const {
        const int pn = u.pn;
        bf16_t* dst; int ld, cb;
        if (pn == 0) { dst = VP; ld = PWD; cb = 0; } else if (pn < 4) { dst = Q; ld = AW; cb = (pn - 1) * 256; } else if (pn < 7) { dst = K; ld = AW; cb = (pn - 4) * 256; } else { dst = V; ld = AW; cb = (pn - 7) * 256; }
        const bool ropetile = (pn >= 1 && pn <= 6);
        const bool ropelane = ropetile && !(wc & 1) && (fq < 2);
        const float sgn = (fq == 0) ? -1.f : 1.f;
        const float qs = (pn >= 1 && pn < 4) ? QSCALE : 1.f;
        const int row0 = u.pm * BM + u.roff + wr * 64 + fr, col0 = cb + wc * 32 + 8 * fq;
#pragma unroll
        for (int ai = 0; ai < NAI; ++ai)
#pragma unroll
            for (int m = 0; m < 4; ++m) {
                const int row = row0 + ai * HALF + m * 16; const float ri = tab[u.par * 256 + ai * HALF + wr * 64 + m * 16 + fr];
                f32x4 c0 = {1.f, 1.f, 1.f, 1.f}, c1 = c0, s0 = {0.f, 0.f, 0.f, 0.f}, s1 = s0;
                if (ropelane) { const f32x4* cs = (const f32x4*)(CS + (size_t)row * 16); c0 = cs[0]; c1 = cs[1]; s0 = cs[2]; s1 = cs[3]; }
#pragma unroll
                for (int bj = 0; bj < 2; ++bj) {
                    f32x4 v0 = acc[ai][bj][m][0] * ri, v1 = acc[ai][bj][m][1] * ri;
                    if (ropetile) {
                        f32x4 p0, p1;
#pragma unroll
                        for (int j = 0; j < 4; ++j) { p0[j] = __shfl_xor(v0[j], 16); p1[j] = __shfl_xor(v1[j], 16); }
                        if (ropelane) { v0 = v0 * c0 + p0 * s0 * sgn; v1 = v1 * c1 + p1 * s1 * sgn; }
                    }
                    v0 = v0 * qs; v1 = v1 * qs;
                    u32x4 w; w.x = pg8::cvt_pk_bf16(v0[0], v0[1]); w.y = pg8::cvt_pk_bf16(v0[2], v0[3]); w.z = pg8::cvt_pk_bf16(v1[0], v1[1]); w.w = pg8::cvt_pk_bf16(v1[2], v1[3]);
                    *(u32x4*)(dst + (size_t)row * ld + col0 + bj * HALF) = w;
                }
                if (m & 1) asm volatile("" ::: "memory");
            }
    }
};
}

namespace att {
constexpr int NSLOT = 448, KCS = NSLOT * 16 + 16, VDS = NSLOT * 64 + 64;
constexpr int L_K = 0, L_V = 8 * KCS, L_WS = L_V + 2 * VDS, L_OST = L_WS + 8 * 256, L_END = L_OST + 8 * 4096;
static_assert(L_END <= 149760, "attention LDS");
__device__ __forceinline__ int crow(int r, int hi) { return (r & 3) + 8 * (r >> 2) + 4 * hi; }
__device__ __forceinline__ s16x4 vtr(const LAS unsigned char* p) { return __builtin_bit_cast(s16x4, __builtin_amdgcn_ds_read_tr16_b64_v4i16((LAS s16x4*)p)); }
struct UD { int b, h, br, u; };
__device__ __forceinline__ UD decode(int uidg) { UD x; x.u = uidg & 7; x.br = (uidg >> 3) % 3; const int bh = uidg / 24; x.b = bh / NH; x.h = bh % NH; return x; }

__device__ __forceinline__ void load_kv(u32x4 (&val)[14], const UD& x, const unsigned char* ws, int tid) {
    const int br = x.br, u = x.u, sub = tid & 15, s0 = tid >> 4;
    const bf16_t* base = (const bf16_t*)(ws + ((sub < 8) ? off_k(x.b) : off_v(x.b))) + (size_t)x.b * SEQ * AW + x.h * HD + (sub & 7) * 8;
    if (br < 2) {
        const int d = (br == 0) ? 1 : 4, L = SEQ / d, T0 = (br == 0) ? 256 * u : 256 * (u & 1), cls = (br == 0) ? 0 : (u >> 1);
        const int k0 = T0 - 64 + s0;
        const bf16_t* p0 = base + ((long)k0 * d + cls) * AW; const long stride = (long)32 * d * AW;
#pragma unroll
        for (int i = 0; i < 14; ++i) { const int key = k0 + 32 * i; val[i] = (u32x4){0u, 0u, 0u, 0u};
            if ((i < 12) && (key >= 0) && (key < L)) val[i] = *(const u32x4*)(p0 + i * stride); }
    } else {
        const bf16_t* pa = base + ((long)(s0 - 64) * 16 + 2 * u) * AW; const bf16_t* pb = base + ((long)s0 * 16 + 2 * u + 1) * AW; const long stride = (long)32 * 16 * AW;
#pragma unroll
        for (int i = 0; i < 14; ++i) { val[i] = (u32x4){0u, 0u, 0u, 0u};
            if (i < 8) { const int key = s0 + 32 * i - 64; if ((key >= 0) && (key < 128)) val[i] = *(const u32x4*)(pa + i * stride); }
            else if (i < 12) val[i] = *(const u32x4*)(pb + (i - 8) * stride); }
    }
}
__device__ __forceinline__ void store_kv(LAS unsigned char* lds, const u32x4 (&val)[14], int tid) {
#pragma unroll
    for (int i = 0; i < 14; ++i) {
        const int piece = tid + 512 * i, slot = piece >> 4, sub = piece & 15;
        const int off = (sub < 8) ? (L_K + sub * KCS + slot * 16) : (L_V + ((sub - 8) >> 2) * VDS + slot * 64 + ((sub - 8) & 3) * 16);
        *(LAS u32x4*)(lds + off) = val[i];
    }
}
__device__ __forceinline__ void wave_geo(const UD& x, int wid, int& d, int& L, int& cls, int& t0, int& sbase) {
    const int br = x.br, u = x.u; d = (br == 0) ? 1 : (br == 1) ? 4 : 16; L = SEQ / d;
    if (br < 2) { const int T0 = (br == 0) ? 256 * u : 256 * (u & 1); cls = (br == 0) ? 0 : (u >> 1); t0 = T0 + 32 * wid; sbase = 32 * wid; }
    else { const int hw = wid >> 2; cls = 2 * u + hw; t0 = 32 * (wid & 3); sbase = 192 * hw + 32 * (wid & 3); }
}
__device__ __forceinline__ void load_q(bf16x8 (&qr)[4], const UD& x, const unsigned char* ws, int wid, int r32, int hi) {
    int d, L, cls, t0, sbase; wave_geo(x, wid, d, L, cls, t0, sbase);
    const bf16_t* Qb = (const bf16_t*)(ws + off_q(x.b));
    const size_t qtok = (size_t)x.b * SEQ + (size_t)(t0 + r32) * d + cls;
#pragma unroll
    for (int d0 = 0; d0 < 4; ++d0) qr[d0] = *(const bf16x8*)(Qb + qtok * AW + x.h * HD + d0 * 16 + hi * 8);
}
__device__ __forceinline__ void compute_a(LAS unsigned char* lds, const UD& x, const bf16x8 (&qr)[4], int wid, int lane, u32x4 (&pw)[10], float& mx_o, float& l_o) {
    const int r32 = lane & 31, hi = lane >> 5;
    int d, L, cls, t0, sbase; wave_geo(x, wid, d, L, cls, t0, sbase);
    f32x16 s[5];
#pragma unroll
    for (int ht = 0; ht < 5; ++ht) {
        const LAS unsigned char* kb = lds + L_K + hi * KCS + (sbase + 32 * ht + r32) * 16;
        f32x16 a = {};
#pragma unroll
        for (int d0 = 0; d0 < 4; ++d0) { const bf16x8 kf = *(const LAS bf16x8*)(kb + d0 * 2 * KCS); a = __builtin_amdgcn_mfma_f32_32x32x16_bf16(kf, qr[d0], a, 0, 0, 0); }
        s[ht] = a;
    }
    {
        const int dq = r32 - 4 * hi;
#pragma unroll
        for (int r = 0; r < 16; ++r) { const int cr = (r & 3) + 8 * (r >> 2); s[0][r] = (cr >= dq) ? s[0][r] : -INFINITY; s[4][r] = (cr <= dq) ? s[4][r] : -INFINITY; }
        if (t0 < 64) {
#pragma unroll
            for (int r = 0; r < 16; ++r) s[0][r] = -INFINITY;
            if (t0 < 32) {
#pragma unroll
                for (int r = 0; r < 16; ++r) s[1][r] = -INFINITY;
            }
        }
        if (t0 + 96 > L) {
#pragma unroll
            for (int r = 0; r < 16; ++r) s[4][r] = -INFINITY;
            if (t0 + 64 > L) {
#pragma unroll
                for (int r = 0; r < 16; ++r) s[3][r] = -INFINITY;
            }
        }
    }
    float mx = s[2][0];
#pragma unroll
    for (int ht = 0; ht < 5; ++ht)
#pragma unroll
        for (int r = 0; r < 16; ++r) mx = fmaxf(mx, s[ht][r]);
    mx = fmaxf(mx, __shfl_xor(mx, 32));
    float lsum = 0.f;
#pragma unroll
    for (int ht = 0; ht < 5; ++ht)
#pragma unroll
        for (int r = 0; r < 16; ++r) { const float p = __builtin_amdgcn_exp2f(s[ht][r] - mx); s[ht][r] = p; lsum += p; }
    lsum += __shfl_xor(lsum, 32);
#pragma unroll
    for (int g = 0; g < 10; ++g) {
        const int ht = g >> 1, rb = (g & 1) * 8;
        pw[g].x = pg8::cvt_pk_bf16(s[ht][rb + 0], s[ht][rb + 1]); pw[g].y = pg8::cvt_pk_bf16(s[ht][rb + 2], s[ht][rb + 3]); pw[g].z = pg8::cvt_pk_bf16(s[ht][rb + 4], s[ht][rb + 5]); pw[g].w = pg8::cvt_pk_bf16(s[ht][rb + 6], s[ht][rb + 7]);
    }
    mx_o = mx; l_o = lsum;
}
__device__ __forceinline__ void compute_b(LAS unsigned char* lds, const UD& x, unsigned char* ws, unsigned char* dout, int wid, int lane, const u32x4 (&pw)[10], float mx, float lsum) {
    const int r32 = lane & 31, hi = lane >> 5;
    int d, L, cls, t0, sbase; wave_geo(x, wid, d, L, cls, t0, sbase);
    const size_t tokb = (size_t)x.b * SEQ;
    const size_t qtok = tokb + (size_t)(t0 + r32) * d + cls;
    f32x16 o[2]; o[0] = f32x16{}; o[1] = f32x16{};
    const int vlane = ((lane >> 4) & 1) * 32 + (lane & 3) * 8 + (4 * hi + ((lane & 15) >> 2)) * 64;
#pragma unroll
    for (int g = 0; g < 10; ++g) {
        const bf16x8 pa = __builtin_bit_cast(bf16x8, pw[g]);
#pragma unroll
        for (int d0 = 0; d0 < 2; ++d0) {
            const LAS unsigned char* vp = lds + L_V + d0 * VDS + (sbase + 16 * g) * 64 + vlane;
            const s16x4 lo = vtr(vp), hh = vtr(vp + 512);
            const bf16x8 vf = (bf16x8){lo[0], lo[1], lo[2], lo[3], hh[0], hh[1], hh[2], hh[3]};
            o[d0] = __builtin_amdgcn_mfma_f32_32x32x16_bf16(pa, vf, o[d0], 0, 0, 0);
        }
    }
    LAS float* wsf = (LAS float*)(lds + L_WS + wid * 256);
    LAS bf16_t* stg = (LAS bf16_t*)(lds + L_OST + wid * 4096);
    if (hi == 0) {
        wsf[r32] = lsum;
        float* st = (float*)(ws + WS_STAT) + (((size_t)x.br * M + qtok) * NH + x.h) * 2; st[0] = mx; st[1] = lsum;
    }
    asm volatile("s_waitcnt lgkmcnt(0)" ::: "memory");
#pragma unroll
    for (int r = 0; r < 16; ++r) {
        const int qrow = crow(r, hi); const float rl = __builtin_amdgcn_rcpf(wsf[qrow]);
        const unsigned a = pg8::cvt_pk_bf16(o[0][r] * rl, o[1][r] * rl);
        stg[qrow * 64 + r32] = (bf16_t)(a & 0xffffu); stg[qrow * 64 + 32 + r32] = (bf16_t)(a >> 16);
    }
    asm volatile("s_waitcnt lgkmcnt(0)" ::: "memory");
    bf16_t* Ob = o_base(ws, dout, x.br, x.b);
#pragma unroll
    for (int i = 0; i < 4; ++i) {
        const int row = i * 8 + (lane >> 3), ch = lane & 7;
        const u32x4 v = *(const LAS u32x4*)(stg + row * 64 + ch * 8);
        *(u32x4*)(Ob + (tokb + (size_t)(t0 + row) * d + cls) * AW + x.h * HD + ch * 8) = v;
    }
}
__device__ __forceinline__ void phase(LAS unsigned char* lds, unsigned char* ws, unsigned char* dout, int first, int step, int limit) {
    int tid_ = threadIdx.x; asm volatile("" : "+v"(tid_));
    const int tid = tid_, lane = tid & 63; const int wid = __builtin_amdgcn_readfirstlane(tid >> 6);
    if (first >= limit) return;
    u32x4 val[14];
    load_kv(val, decode(first), ws, tid);
    for (int uid = first; uid < limit; uid += step) {
        const UD x = decode(uid);
        bf16x8 qr[4]; load_q(qr, x, ws, wid, lane & 31, lane >> 5);
        store_kv(lds, val, tid);
        __syncthreads();
        u32x4 pw[10]; float mx, lsum;
        compute_a(lds, x, qr, wid, lane, pw, mx, lsum);
        if (uid + step < limit) load_kv(val, decode(uid + step), ws, tid);
        compute_b(lds, x, ws, dout, wid, lane, pw, mx, lsum);
        __syncthreads();
    }
}
}

__device__ __forceinline__ float bf2f(unsigned short h) { return __uint_as_float((unsigned)h << 16); }
__device__ __forceinline__ float wave_sum(float v) {
#pragma unroll
    for (int o = 1; o < 64; o <<= 1) v += __shfl_xor(v, o);
    return v;
}
__device__ __forceinline__ unsigned f2bf(float f) { unsigned u = __float_as_uint(f); return (u + 0x7fffu + ((u >> 16) & 1u)) >> 16; }
__device__ __forceinline__ unsigned pk2(float lo, float hi) { return f2bf(lo) | (f2bf(hi) << 16); }

struct TrItem { const float* W; const float* gain; bf16_t* WT; int N, k0, n0, ldw, drow0; };
__device__ __forceinline__ void tr_load(f32x4 (&v)[16], const TrItem& t, int lane) {
    const int kr = lane >> 4, nc = 4 * (lane & 15);
#pragma unroll
    for (int i = 0; i < 16; ++i) v[i] = *(const f32x4*)(t.W + (size_t)(t.k0 + 4 * i + kr) * t.N + t.n0 + nc);
}
__device__ __forceinline__ void tr_finish(const f32x4 (&v)[16], const TrItem& t, LAS float* scr, int lane) {
    const int kr = lane >> 4, nc = 4 * (lane & 15);
#pragma unroll
    for (int i = 0; i < 16; ++i) { const int kk = 4 * i + kr; const float gg = t.gain ? t.gain[t.k0 + kk] : 1.f; LAS float* s = scr + kk * 65 + nc;
        s[0] = v[i][0] * gg; s[1] = v[i][1] * gg; s[2] = v[i][2] * gg; s[3] = v[i][3] * gg; }
    asm volatile("s_waitcnt lgkmcnt(0)" ::: "memory");
    const int c = lane & 7;
#pragma unroll
    for (int j = 0; j < 8; ++j) { const int n = (lane >> 3) + 8 * j; const LAS float* s = scr + (8 * c) * 65 + n;
        u32x4 o; o.x = pk2(s[0 * 65], s[1 * 65]); o.y = pk2(s[2 * 65], s[3 * 65]); o.z = pk2(s[4 * 65], s[5 * 65]); o.w = pk2(s[6 * 65], s[7 * 65]);
        *(u32x4*)(t.WT + (size_t)(t.drow0 + n) * t.ldw + t.k0 + 8 * c) = o; }
    asm volatile("s_waitcnt lgkmcnt(0)" ::: "memory");
}
constexpr int I_G = 16 * 44, I_D = 44 * 16, I_IN = 16 * 40, I_O = 12 * 16, I_LAYER = 6 * I_G + I_IN + I_O;
static_assert(I_G == I_D, "item counts");
__device__ __forceinline__ TrItem tr_decode(const Args& a, int it) {
    TrItem t; const int l = it / I_LAYER; int r = it % I_LAYER;
    unsigned char* wl = a.ws + WS_W + (size_t)l * LW_SIZE;
    if (r < 6 * I_G) {
        const int seg = r / I_G; r = r % I_G;
        const int ffn = seg / 3, kind = seg % 3;
        if (kind < 2) {
            t.W = (kind == 0 ? (ffn ? a.g2 : a.g1) : (ffn ? a.u2 : a.u1)) + (size_t)l * DM * DFF; t.gain = (ffn ? a.n2 : a.n1) + (size_t)l * DM;
            t.WT = (bf16_t*)(wl + (ffn ? LW_GU2 : LW_GU1)); t.N = DFF; t.ldw = DM;
            const int kb = r / 44, nb = r % 44; t.k0 = 64 * kb; t.n0 = 64 * nb; t.drow0 = 256 * (t.n0 / 128) + 128 * kind + (t.n0 % 128);
        } else {
            t.W = (ffn ? a.d2 : a.d1) + (size_t)l * DFF * DM; t.gain = nullptr; t.WT = (bf16_t*)(wl + (ffn ? LW_D2 : LW_D1)); t.N = DM; t.ldw = DFF;
            const int kb = r / 16, nb = r % 16; t.k0 = 64 * kb; t.n0 = 64 * nb; t.drow0 = 64 * nb;
        }
    } else if (r < 6 * I_G + I_IN) {
        r -= 6 * I_G; const int kb = r / 40, nb = r % 40;
        t.W = a.win + (size_t)l * DM * NIN; t.gain = a.nm + (size_t)l * DM; t.WT = (bf16_t*)(wl + LW_IN); t.N = NIN; t.ldw = DM; t.k0 = 64 * kb; t.n0 = 64 * nb; t.drow0 = 64 * nb;
    } else {
        r -= 6 * I_G + I_IN; const int kb = 4 + r / 16, nb = r % 16;
        t.W = a.wout + (size_t)l * DM * DM; t.gain = nullptr; t.WT = (bf16_t*)(wl + LW_OUT); t.N = DM; t.ldw = DM; t.k0 = 64 * kb; t.n0 = 64 * nb; t.drow0 = 64 * nb;
    }
    return t;
}

__device__ __forceinline__ void prologue(const Args& a, LAS unsigned char* lds, int vcu, int G) {
    const int tid = threadIdx.x, lane = tid & 63, wave = __builtin_amdgcn_readfirstlane(tid >> 6);
    LAS float* scr = (LAS float*)(lds + wave * 16640);
    const int gw = vcu * 8 + wave, NGW = G * 8;
    unsigned char* ws = a.ws;
    if (gw < DEPTH * I_LAYER) {
        TrItem cur = tr_decode(a, gw); f32x4 va[16]; tr_load(va, cur, lane);
        for (int it = gw; it < DEPTH * I_LAYER; it += NGW) {
            const bool more = it + NGW < DEPTH * I_LAYER;
            TrItem nxt = cur; f32x4 vb[16];
            if (more) { nxt = tr_decode(a, it + NGW); tr_load(vb, nxt, lane); }
            tr_finish(va, cur, scr, lane);
            if (more) {
#pragma unroll
                for (int i = 0; i < 16; ++i) va[i] = vb[i];
                cur = nxt; }
        }
    }
    for (int it = gw; it < DEPTH * 4 * 8 * 16; it += NGW) {
        const int l = it >> 9, g = (it >> 7) & 3, c8 = (it >> 4) & 7, n = (it & 15) * 64 + lane;
        const float* wo = a.wout + (size_t)l * DM * DM + (size_t)(g * 64) * DM + n;
        const float* sc = a.ps + (size_t)l * PWD + g * 64;
        const float* pr = a.pw + (((size_t)l * 4 + g) * 64 + c8 * 8) * 64;
        float acc[8] = {0.f, 0.f, 0.f, 0.f, 0.f, 0.f, 0.f, 0.f};
#pragma unroll 4
        for (int dd = 0; dd < 64; ++dd) { const float wv = wo[(size_t)dd * DM] * sc[dd];
#pragma unroll
            for (int e = 0; e < 8; ++e) acc[e] += pr[e * 64 + dd] * wv; }
        u32x4 o; o.x = pk2(acc[0], acc[1]); o.y = pk2(acc[2], acc[3]); o.z = pk2(acc[4], acc[5]); o.w = pk2(acc[6], acc[7]);
        *(u32x4*)((bf16_t*)(ws + WS_W + (size_t)l * LW_SIZE + LW_OUT) + (size_t)n * DM + g * 64 + c8 * 8) = o;
    }
    bf16_t* XB = (bf16_t*)(ws + WS_XB); float* P = (float*)(ws + WS_SSQ); float* CS = (float*)(ws + WS_ROPE);
    for (int mp = gw; mp < M; mp += 2 * NGW) {
        f32x4 v[2][4];
#pragma unroll
        for (int q = 0; q < 2; ++q) { const int m = (mp + q * NGW < M) ? mp + q * NGW : mp; const f32x4* xr = (const f32x4*)(a.x + (size_t)m * DM) + lane;
#pragma unroll
            for (int j = 0; j < 4; ++j) v[q][j] = xr[64 * j]; }
#pragma unroll
        for (int q = 0; q < 2; ++q) {
            const int m = (mp + q * NGW < M) ? mp + q * NGW : mp;
            u32x2* xb = (u32x2*)(XB + (size_t)m * DM) + lane;
            float s = 0.f;
#pragma unroll
            for (int j = 0; j < 4; ++j) { const f32x4 x4 = v[q][j]; s += (x4[0] * x4[0] + x4[1] * x4[1]) + (x4[2] * x4[2] + x4[3] * x4[3]);
                u32x2 w; w.x = pk2(x4[0], x4[1]); w.y = pk2(x4[2], x4[3]); xb[64 * j] = w; }
            s = wave_sum(s);
            if (lane < 16) P[(size_t)m * 16 + lane] = (lane == 0) ? s : 0.f;
            if (lane < 8) {
                const float ang = (float)a.pos[m] * a.inv_freq[lane];
                double rev = (double)ang * 0.15915494309189535; rev -= floor(rev);
                const float fr = (float)rev;
                CS[(size_t)m * 16 + lane] = __builtin_amdgcn_cosf(fr); CS[(size_t)m * 16 + 8 + lane] = __builtin_amdgcn_sinf(fr);
            }
        }
    }
}

__device__ __forceinline__ void combine_phase(const Args& a, int wv0, int nwv, int tok0, int ntok) {
    int tid_ = threadIdx.x; asm volatile("" : "+v"(tid_));
    const int tid = tid_, lane = tid & 63, wave = __builtin_amdgcn_readfirstlane(tid >> 6);
    const int gw = wv0 + wave, NGW = nwv;
    unsigned char* ws = a.ws;
    const float* __restrict__ ST = (const float*)(ws + WS_STAT);
    const int g = lane >> 4, hw = 1 << g;
    for (int tokp = tok0 + gw; tokp < tok0 + ntok; tokp += 2 * NGW) {
        u32x2 vv[2][16], me[2]; int cnt[2]; float mm[2][2][3], ll[2][2][3]; u32x4 ov[2][2][3];
#pragma unroll
        for (int q = 0; q < 2; ++q) {
            const int tok = (tokp + q * NGW < tok0 + ntok) ? tokp + q * NGW : tokp;
            const int bb = tok >> 11, s = tok & (SEQ - 1);
            const bf16_t* base = (const bf16_t*)(ws + off_vp(bb)) + (size_t)(tok - s) * PWD + 4 * lane;
            cnt[q] = 0;
#pragma unroll
            for (int jj = 0; jj < 16; ++jj) { const int j = s - hw + jj; const bool ok = (jj < 2 * hw) && (j >= 0) && (j < SEQ);
                vv[q][jj] = (u32x2){0u, 0u}; if (ok) vv[q][jj] = *(const u32x2*)(base + (size_t)j * PWD); cnt[q] += ok ? 1 : 0; }
            me[q] = *(const u32x2*)(base + (size_t)s * PWD);
#pragma unroll
            for (int it = 0; it < 2; ++it) {
                const int chunk = (it * 64 + lane < 96) ? it * 64 + lane : 95, h = chunk >> 3;
#pragma unroll
                for (int i = 0; i < 3; ++i) { const float* st = ST + (((size_t)i * M + tok) * NH + h) * 2; mm[q][it][i] = st[0]; ll[q][it][i] = st[1]; ov[q][it][i] = *(const u32x4*)(o_base(ws, (unsigned char*)a.out, i, bb) + (size_t)tok * AW + chunk * 8); }
            }
        }
#pragma unroll
        for (int q = 0; q < 2; ++q) {
            const int tok = (tokp + q * NGW < tok0 + ntok) ? tokp + q * NGW : tokp;
            bf16_t* MIX = (bf16_t*)(ws + off_mix(tok >> 11));
            float s0 = 0.f, s1 = 0.f, s2 = 0.f, s3 = 0.f;
#pragma unroll
            for (int jj = 0; jj < 16; ++jj) { s0 += __uint_as_float(vv[q][jj].x << 16); s1 += __uint_as_float(vv[q][jj].x & 0xffff0000u); s2 += __uint_as_float(vv[q][jj].y << 16); s3 += __uint_as_float(vv[q][jj].y & 0xffff0000u); }
            const float rc = 1.0f / (float)cnt[q];
            u32x2 w2; w2.x = pk2(s0 * rc - __uint_as_float(me[q].x << 16), s1 * rc - __uint_as_float(me[q].x & 0xffff0000u)); w2.y = pk2(s2 * rc - __uint_as_float(me[q].y << 16), s3 * rc - __uint_as_float(me[q].y & 0xffff0000u));
            *(u32x2*)(MIX + (size_t)tok * DM + 4 * lane) = w2;
#pragma unroll
            for (int it = 0; it < 2; ++it) {
                const int chunk = it * 64 + lane;
                float mxx = fmaxf(fmaxf(mm[q][it][0], mm[q][it][1]), mm[q][it][2]);
                float wgt[3], den = 0.f;
#pragma unroll
                for (int i = 0; i < 3; ++i) { wgt[i] = __builtin_amdgcn_exp2f(mm[q][it][i] - mxx) * ll[q][it][i]; den += wgt[i]; }
                const float rd = 1.0f / den;
                float acc[8] = {0.f, 0.f, 0.f, 0.f, 0.f, 0.f, 0.f, 0.f};
#pragma unroll
                for (int i = 0; i < 3; ++i) { const u32x4 v = ov[q][it][i]; const float wi = wgt[i] * rd;
                    acc[0] += wi * __uint_as_float(v.x << 16); acc[1] += wi * __uint_as_float(v.x & 0xffff0000u); acc[2] += wi * __uint_as_float(v.y << 16); acc[3] += wi * __uint_as_float(v.y & 0xffff0000u);
                    acc[4] += wi * __uint_as_float(v.z << 16); acc[5] += wi * __uint_as_float(v.z & 0xffff0000u); acc[6] += wi * __uint_as_float(v.w << 16); acc[7] += wi * __uint_as_float(v.w & 0xffff0000u); }
                u32x4 w; w.x = pk2(acc[0], acc[1]); w.y = pk2(acc[2], acc[3]); w.z = pk2(acc[4], acc[5]); w.w = pk2(acc[6], acc[7]);
                if (chunk < 96) *(u32x4*)(MIX + (size_t)tok * DM + PWD + chunk * 8) = w;
            }
        }
    }
}

__device__ __forceinline__ void final_norm(const Args& a, int wv0, int nwv, int tok0, int ntok) {
    const int tid = threadIdx.x, lane = tid & 63, wave = __builtin_amdgcn_readfirstlane(tid >> 6);
    const int gw = wv0 + wave, NGW = nwv;
    const f32x4* gr = (const f32x4*)a.nf + lane;
    const bf16_t* XH = (const bf16_t*)(a.ws + WS_XB); const bf16_t* XL = (const bf16_t*)(a.ws + WS_XL);
    for (int mp = tok0 + gw; mp < tok0 + ntok; mp += 2 * NGW) {
        u32x2 hh[2][4], ll[2][4];
#pragma unroll
        for (int q = 0; q < 2; ++q) { const int m = (mp + q * NGW < tok0 + ntok) ? mp + q * NGW : mp; const u32x2* ph = (const u32x2*)(XH + (size_t)m * DM) + lane; const u32x2* pl = (const u32x2*)(XL + (size_t)m * DM) + lane;
#pragma unroll
            for (int j = 0; j < 4; ++j) { hh[q][j] = ph[64 * j]; ll[q][j] = pl[64 * j]; } }
        f32x4 v[2][4]; float ri[2];
#pragma unroll
        for (int q = 0; q < 2; ++q) { float s = 0.f;
#pragma unroll
            for (int j = 0; j < 4; ++j) { const u32x2 h = hh[q][j], l = ll[q][j];
                v[q][j] = (f32x4){__uint_as_float(h.x << 16) + __uint_as_float(l.x << 16), __uint_as_float(h.x & 0xffff0000u) + __uint_as_float(l.x & 0xffff0000u), __uint_as_float(h.y << 16) + __uint_as_float(l.y << 16), __uint_as_float(h.y & 0xffff0000u) + __uint_as_float(l.y & 0xffff0000u)};
                s += (v[q][j][0] * v[q][j][0] + v[q][j][1] * v[q][j][1]) + (v[q][j][2] * v[q][j][2] + v[q][j][3] * v[q][j][3]); }
            ri[q] = 1.0f / sqrtf(wave_sum(s) * (1.0f / DM) + NORM_EPS); }
#pragma unroll
        for (int q = 0; q < 2; ++q) { if (q == 1 && mp + NGW >= tok0 + ntok) break; const int m = mp + q * NGW; f32x4* xr = (f32x4*)(a.out + (size_t)m * DM) + lane;
#pragma unroll
            for (int j = 0; j < 4; ++j) xr[64 * j] = v[q][j] * ri[q] * gr[64 * j]; }
    }
}

#define XB_TMO      128
#define XB_XCNT(j)  (256  + 64 * (j))
#define XB_XSUB(j)  (1280 + 64 * (j))
#define XB_XGEN(j)  (2304 + 64 * (j))
#define XB_TOP      3328
#define XB_TOPGEN   3392
#define XCD_BAR_WORDS 3456
#define XB_SPIN_CAP (1u << 18)

__device__ __forceinline__ unsigned xb_ld(unsigned* p)              { return __hip_atomic_load(p, __ATOMIC_RELAXED, __HIP_MEMORY_SCOPE_AGENT); }
__device__ __forceinline__ unsigned xb_add(unsigned* p, unsigned v) { return __hip_atomic_fetch_add(p, v, __ATOMIC_RELAXED, __HIP_MEMORY_SCOPE_AGENT); }
__device__ __forceinline__ unsigned xb_xcc_id() { return (unsigned)__builtin_amdgcn_s_getreg((3 << 11) | 20) & 0xFu; }
#define XB_SPIN(cond, bar) do { unsigned _sp = 0; while (cond) { __builtin_amdgcn_s_sleep(1); \
    if ((++_sp & 255u) == 0u) { if (xb_ld(&(bar)[XB_TMO])) break; if (_sp > XB_SPIN_CAP) { atomicAdd(&(bar)[XB_TMO], 1u); break; } } } } while (0)

struct XcdBarrier {
    unsigned* bar; unsigned x;
    volatile LAS unsigned* st;
};

__device__ __forceinline__ XcdBarrier xcd_barrier_post(unsigned* bar, volatile LAS unsigned* st) {
    XcdBarrier b; b.bar = bar; b.x = xb_xcc_id(); b.st = st;
    if (threadIdx.x == 0) (void)xb_add(&bar[XB_XCNT(b.x)], 1u);
    return b;
}
__device__ __forceinline__ void xcd_barrier_complete(unsigned* bar, unsigned x, unsigned& nloc, unsigned& nx) {
    const unsigned G = gridDim.x * gridDim.y * gridDim.z;
    unsigned sum, cnt, mine, sp = 0u;
    for (;;) {
        sum = 0u; cnt = 0u; mine = 0u;
#pragma unroll
        for (unsigned j = 0; j < 16; ++j) { const unsigned c = xb_ld(&bar[XB_XCNT(j)]); sum += c; cnt += (c > 0u) ? 1u : 0u; mine = (j == x) ? c : mine; }
        if (sum == G) break;
        __builtin_amdgcn_s_sleep(1);
        if ((++sp & 255u) == 0u) { if (xb_ld(&bar[XB_TMO])) break; if (sp > XB_SPIN_CAP) { atomicAdd(&bar[XB_TMO], 1u); break; } }
    }
    nloc = mine > 0u ? mine : 1u; nx = cnt > 0u ? cnt : 1u;
}

__device__ __forceinline__ void xcd_barrier(const XcdBarrier& b) {
    asm volatile("s_waitcnt vmcnt(0)" ::: "memory");
    __syncthreads();
    if (threadIdx.x == 0) {
        unsigned* bar = b.bar;
        __builtin_amdgcn_s_waitcnt(0);
        unsigned nloc = b.st[0], nx = b.st[1];
        if (nloc == 0u) { xcd_barrier_complete(bar, b.x, nloc, nx); b.st[0] = nloc; b.st[1] = nx; }
        const unsigned old = xb_add(&bar[XB_XSUB(b.x)], 1u);
        const unsigned gen = old / nloc;
        if (old + 1u == (gen + 1u) * nloc) {
            __builtin_amdgcn_fence(__ATOMIC_RELEASE, "agent");
            asm volatile("s_waitcnt vmcnt(0)" ::: "memory");
            const unsigned og = xb_add(&bar[XB_TOP], 1u);
            const unsigned tg = og / nx;
            if (og + 1u == (tg + 1u) * nx) xb_add(&bar[XB_TOPGEN], 1u);
            else XB_SPIN(xb_ld(&bar[XB_TOPGEN]) == tg, bar);
            __builtin_amdgcn_fence(__ATOMIC_ACQUIRE, "agent");
            xb_add(&bar[XB_XGEN(b.x)], 1u);
            asm volatile("s_waitcnt vmcnt(0)" ::: "memory");
        } else {
            XB_SPIN(xb_ld(&bar[XB_XGEN(b.x)]) == gen, bar);
            __builtin_amdgcn_fence(__ATOMIC_ACQUIRE, "agent");
            asm volatile("s_waitcnt vmcnt(0)" ::: "memory");
        }
    }
    __syncthreads();
}

#define XL_RANK(j) (3520 + 64 * (j))
#define XL_CNT(j)  (4608 + 64 * (j))
__device__ __forceinline__ unsigned l2_fetch_add(unsigned* p, unsigned v) {
    unsigned r; asm volatile("global_atomic_add %0, %1, %2, off sc0\n\ts_waitcnt vmcnt(0)" : "=&v"(r) : "v"(p), "v"(v) : "memory"); return r;
}
__device__ __forceinline__ void local_barrier(unsigned* ctl, unsigned x) {
    asm volatile("s_waitcnt vmcnt(0)" ::: "memory");
    __syncthreads();
    if (threadIdx.x == 0) {
        __builtin_amdgcn_s_waitcnt(0);
        unsigned* cw = &ctl[XL_CNT(x)];
        const unsigned old = l2_fetch_add(cw, 1u), target = (old / 32u + 1u) * 32u;
        unsigned sp = 0;
        while (l2_fetch_add(cw, 0u) < target) {
            __builtin_amdgcn_s_sleep(1);
            if ((++sp & 255u) == 0u) { if (xb_ld(&ctl[XB_TMO])) break; if (sp > XB_SPIN_CAP) { atomicAdd(&ctl[XB_TMO], 1u); break; } } }
        __builtin_amdgcn_fence(__ATOMIC_ACQUIRE, "agent");
        asm volatile("s_waitcnt vmcnt(0)" ::: "memory");
    }
    __syncthreads();
}

constexpr int LDS_BYTES = 152576;
__global__ void __launch_bounds__(512, 2) fwd(Args a) {
    extern __shared__ __attribute__((aligned(16))) unsigned char lds_raw[];
    LAS unsigned char* lds = (LAS unsigned char*)lds_raw;
    cg::grid_group grid = cg::this_grid();
    const int G = gridDim.x;
    const int vcu0 = (G % 8 == 0) ? ((int)blockIdx.x % 8) * (G / 8) + (int)blockIdx.x / 8 : (int)blockIdx.x;
    unsigned char* ws = a.ws;
    unsigned* ctl = (unsigned*)(ws + WS_CTL);
    bf16_t* XB = (bf16_t*)(ws + WS_XB); bf16_t* ACT = (bf16_t*)(ws + WS_A); float* P = (float*)(ws + WS_SSQ); float* CS = (float*)(ws + WS_ROPE);

    LAS float* RT = (LAS float*)(lds + 149760);
    volatile LAS unsigned* BST = (volatile LAS unsigned*)(lds + 149760 + 2048);
    const unsigned xcc = xb_xcc_id();
    if (threadIdx.x == 0) { BST[0] = 0u; BST[1] = 0u; BST[2] = xb_add(&ctl[XL_RANK(xcc)], 1u); BST[3] = 0u; }
    __syncthreads();
    const XcdBarrier bar = xcd_barrier_post(ctl, BST);
    if (a.never) grid.sync();
    prologue(a, lds, vcu0, G);
    xcd_barrier(bar);
    if (threadIdx.x == 0) {
        bool ok = (G == 256);
        for (unsigned j = 0; j < 16; ++j) { const unsigned cnt = xb_ld(&ctl[XB_XCNT(j)]); ok = ok && (cnt == (j < 8 ? 32u : 0u)); }
        BST[3] = (ok && xb_ld(&ctl[XB_TMO]) == 0u) ? 1u : 0u;
    }
    __syncthreads();
    const bool local = BST[3] != 0u;
    const int rank = (int)BST[2];
    const int bx = local ? rank * 8 + (int)xcc : (int)blockIdx.x;
    const int wv0 = local ? rank * 8 : vcu0 * 8, nwv = local ? 256 : G * 8, tok0 = local ? (int)xcc * SEQ : 0, ntok = local ? SEQ : M;
#define SEAM() do { if (local) local_barrier(ctl, xcc); else xcd_barrier(bar); } while (0)
    for (int st = 0; st < 3 * DEPTH; ++st) {
        const int l = st / 3, kind = st % 3;
        unsigned char* wl = ws + WS_W + (size_t)l * LW_SIZE;
        asm volatile("" : "+s"(wl));
        if (kind != 1) {
            const bf16_t* Wgu = (const bf16_t*)(wl + (kind ? LW_GU2 : LW_GU1)); const bf16_t* Wd = (const bf16_t*)(wl + (kind ? LW_D2 : LW_D1));
            { pg8::Gemm g{XB, Wgu, M, NGU, DM}; epi::RinvOrder<pg8::StaticOrder> S; S.init(M, NGU, G, bx); S.P = P; S.tab = RT;
              const int nfull = S.nwg / G; const bool split = false && (S.nwg - nfull * G) * 2 == G && (G % 16 == 0);
              if (split) S.imax = nfull;
              { epi::EpiSwiGLU<2> E{ACT, RT}; pg8::gemm_phase<epi::EpiSwiGLU<2>, epi::RinvOrder<pg8::StaticOrder>, true, true>(lds, g, S, E); }
              if (split) { epi::RinvOrder<pg8::HalfOrder> H; H.init(M, NGU, G, bx); H.nfull = nfull; H.P = P; H.tab = RT; epi::EpiSwiGLU<1> E{ACT, RT};
                pg8::gemm_phase<epi::EpiSwiGLU<1>, epi::RinvOrder<pg8::HalfOrder>, true, true, true>(lds, g, H, E); } }
            SEAM();
            { pg8::Gemm g{ACT, Wd, M, DM, DFF}; pg8::StaticOrder S; S.init(M, DM, G, bx); epi::EpiResid E{st == 0 ? a.x : nullptr, XB, (bf16_t*)(ws + WS_XL), P, 0.5f};
              pg8::gemm_phase<epi::EpiResid, pg8::StaticOrder, true, true>(lds, g, S, E); }
            SEAM();
        } else {
            { pg8::Gemm g{XB, (const bf16_t*)(wl + LW_IN), M, NIN, DM}; epi::RinvOrder<pg8::StaticOrder> S; S.init(M, NIN, G, bx); S.P = P; S.tab = RT; const int bb = bx & 7;
              const int nfull = S.nwg / G; const bool split = false && (S.nwg - nfull * G) * 2 == G && (G % 16 == 0);
              if (split) S.imax = nfull;
              bf16_t* vp_ = (bf16_t*)(ws + off_vp(bb)); bf16_t* q_ = (bf16_t*)(ws + off_q(bb)); bf16_t* k_ = (bf16_t*)(ws + off_k(bb)); bf16_t* v_ = (bf16_t*)(ws + off_v(bb));
              { epi::EpiProj<2> E{vp_, q_, k_, v_, RT, CS}; pg8::gemm_phase<epi::EpiProj<2>, epi::RinvOrder<pg8::StaticOrder>, true, true>(lds, g, S, E); }
              if (split) { epi::RinvOrder<pg8::HalfOrder> H; H.init(M, NIN, G, bx); H.nfull = nfull; H.P = P; H.tab = RT; epi::EpiProj<1> E{vp_, q_, k_, v_, RT, CS};
                pg8::gemm_phase<epi::EpiProj<1>, epi::RinvOrder<pg8::HalfOrder>, true, true, true>(lds, g, H, E); } }
            SEAM();
            if (local) att::phase(lds, ws, (unsigned char*)a.out, (int)xcc * NH * 24 + rank, 32, ((int)xcc + 1) * NH * 24); else att::phase(lds, ws, (unsigned char*)a.out, bx, G, BATCH * NH * 24);
            SEAM();
            combine_phase(a, wv0, nwv, tok0, ntok);
            SEAM();
            { pg8::Gemm g{(const bf16_t*)(ws + off_mix(bx & 7)), (const bf16_t*)(wl + LW_OUT), M, DM, DM}; pg8::StaticOrder S; S.init(M, DM, G, bx); epi::EpiResid E{nullptr, XB, (bf16_t*)(ws + WS_XL), P, 1.0f};
              pg8::gemm_phase<epi::EpiResid, pg8::StaticOrder, true, true>(lds, g, S, E); }
            SEAM();
        }
    }
    final_norm(a, wv0, nwv, tok0, ntok);
}

extern "C" void kernel_launch(void* const* d_in, const int* in_sizes, int n_in, void* d_out, int out_size, void* d_ws, size_t ws_size, hipStream_t stream) {
    static int grid = 0;
    if (grid == 0) {
        if (n_in != 16 || in_sizes[0] != M * DM || out_size != M * DM || ws_size < WS_END) { fprintf(stderr, "kernel_launch: unexpected shapes (n_in %d in0 %d out %d ws %zu)\n", n_in, n_in > 0 ? in_sizes[0] : -1, out_size, ws_size); grid = -1; return; }
        int dev = 0, cus = 0, per_cu = 0;
        if (hipGetDevice(&dev) != hipSuccess || hipDeviceGetAttribute(&cus, hipDeviceAttributeMultiprocessorCount, dev) != hipSuccess) { grid = -1; return; }
        if (hipFuncSetAttribute((const void*)fwd, hipFuncAttributeMaxDynamicSharedMemorySize, LDS_BYTES) != hipSuccess) { fprintf(stderr, "kernel_launch: hipFuncSetAttribute failed\n"); grid = -1; return; }
        if (hipOccupancyMaxActiveBlocksPerMultiprocessor(&per_cu, (const void*)fwd, 512, LDS_BYTES) != hipSuccess || per_cu < 1) fprintf(stderr, "kernel_launch: occupancy query says %d\n", per_cu);
        (void)hipGetLastError();
        grid = cus;
    }
    if (grid < 0) return;
    if (hipMemsetAsync((char*)d_ws + WS_CTL, 0, CTL_BYTES, stream) != hipSuccess) { fprintf(stderr, "kernel_launch: memset failed\n"); return; }
    Args a{};
    a.x = (const float*)d_in[0]; a.pos = (const int*)d_in[1];
    a.n1 = (const float*)d_in[2]; a.g1 = (const float*)d_in[3]; a.u1 = (const float*)d_in[4]; a.d1 = (const float*)d_in[5];
    a.nm = (const float*)d_in[6]; a.win = (const float*)d_in[7]; a.pw = (const float*)d_in[8]; a.ps = (const float*)d_in[9]; a.wout = (const float*)d_in[10];
    a.n2 = (const float*)d_in[11]; a.g2 = (const float*)d_in[12]; a.u2 = (const float*)d_in[13]; a.d2 = (const float*)d_in[14]; a.nf = (const float*)d_in[15];
    a.out = (float*)d_out; a.ws = (unsigned char*)d_ws;
    for (int i = 0; i < 8; ++i) a.inv_freq[i] = (float)pow(500000.0, -(double)i / 8.0);
    void* args[] = {&a};
    hipError_t e = hipLaunchCooperativeKernel((const void*)fwd, dim3(grid), dim3(512), args, LDS_BYTES, stream);
    if (e != hipSuccess) fprintf(stderr, "cooperative launch failed: %s (grid %d)\n", hipGetErrorString(e), grid);
}
```

```cpp
#include <hip/hip_runtime.h>
#include <hip/hip_cooperative_groups.h>
#include <cstdio>
#include <cstdint>
#include <cmath>
namespace cg = cooperative_groups;
namespace pg8 {
#define PG8_LAS __attribute__((address_space(3)))
typedef unsigned short bf16_t;
typedef short bf16x8 __attribute__((ext_vector_type(8)));
typedef float f32x4 __attribute__((ext_vector_type(4)));
typedef unsigned u32x4 __attribute__((ext_vector_type(4)));
constexpr int BM = 256, BK = 64, HALF = 128, HTB = HALF * BK * 2  , STAGE_BYTES = 8 * HTB, NXCD = 8, WGM = 8;

__host__ __device__ __forceinline__ int lds_byte(int r, int c) { const int st = (r >> 4) * 2 + (c >> 5), rr = r & 15, cc = c & 31, ob = rr * 64 + cc * 2; return st * 1024 + (ob ^ (((ob >> 9) & 1) << 5)); }
__host__ __device__ __forceinline__ void stage_rc(int b, int& R, int& C) { const int st = b / 1024, sb = b % 1024, swz = sb ^ (((sb >> 9) & 1) << 5); R = (st >> 1) * 16 + swz / 64; C = (st & 1) * 32 + (swz % 64) / 2; }
__host__ __device__ __forceinline__ int perm32(int rho) { const int n = rho >> 4, i = rho & 15; return 8 * (i >> 2) + 4 * n + (i & 3); }

struct Unit { int pm, pn, par, roff; };
struct Gemm { const bf16_t* A; const bf16_t* Bt; int M, N, K, nkt; };

struct StaticOrder {
    int nM, nN, nwg, G, c, imax;
    __host__ __device__ void init(int M, int N, int G_, int c_) { nM = M / BM; nN = N / BM; nwg = nM * nN; G = G_; c = c_; imax = 1 << 30; }
    __host__ __device__ void decode(long L, Unit& u) const {
        int wgid = (int)L; { const int q = nwg / NXCD, r = nwg % NXCD, xcd = wgid % NXCD, off = wgid / NXCD; wgid = (xcd < r ? xcd * (q + 1) : r * (q + 1) + (xcd - r) * q) + off; }
        const int nig = WGM * nN, gid = wgid / nig, fm = gid * WGM, gsz = (nM - fm) < WGM ? (nM - fm) : WGM;
        u.pm = fm + ((wgid % nig) % gsz); u.pn = (wgid % nig) / gsz;
    }
    __host__ __device__ bool next(int i, Unit& u) const {
        const long L = (long)i * G + c; if (i >= imax || L >= nwg) return false;
        decode(L, u); u.par = i & 1; u.roff = 0; return true;
    }
    __device__ __forceinline__ void a_ready(const Unit&) const {}
    __device__ __forceinline__ void done(const Unit&) const {}
};
struct HalfOrder : StaticOrder {
    int nfull;
    __host__ __device__ bool next(int i, Unit& u) const {
        if (i != 0) return false;
        const int xcd = c % NXCD, rho = c / NXCD; const long L = ((long)nfull * (G / NXCD) + (rho >> 1)) * NXCD + xcd; if (L >= nwg) return false;
        decode(L, u); u.par = 0; u.roff = 0; return true;
    }
};
__device__ __forceinline__ unsigned cvt_pk_bf16(float lo, float hi) { unsigned r; asm volatile("v_cvt_pk_bf16_f32 %0, %1, %2" : "=v"(r) : "v"(lo), "v"(hi)); return r; }
template <class Epi, class Sched, bool ALIGN_EPI = false, bool SP2 = false, bool HALFM = false>
__device__ __forceinline__ void gemm_phase(PG8_LAS unsigned char* lds, const Gemm g, const Sched& S, const Epi& E) {
    int tid_ = threadIdx.x; asm volatile("" : "+v"(tid_));
    const int tid = tid_, wid = __builtin_amdgcn_readfirstlane(tid >> 6), lane = tid & 63, wr = wid >> 2, wc = wid & 3, fr = lane & 15, fq = lane >> 4;
    static_assert(!HALFM || SP2, "HALFM is written for the SP2 loop");
    const int K = g.K, nt = g.nkt ? g.nkt : K / BK;
    unsigned voffA[2], voffB[2];
#pragma unroll
    for (int i = 0; i < 2; ++i) { int R, C; stage_rc(tid * 16 + i * 8192, R, C); const int Rb = Epi::PERM ? ((R & ~31) + perm32(R & 31)) : R;
        voffA[i] = (unsigned)(R * K + C) * 2u; voffB[i] = (unsigned)(Rb * K + C) * 2u; }
    const size_t kstep = (size_t)(BK * 2);
    const size_t hstep = (size_t)HALF * K * 2;
    const size_t tstep = 2 * hstep;
    const unsigned ldsw = (unsigned)wid * 1024u;
    const int aoff = lds_byte(wr * 64 + fr, fq * 8), boff = lds_byte(wc * 32 + fr, fq * 8);
#define PG8_SA(b, h) (((b) * 2 + (h)) * HTB)
#define PG8_SB(b, h) ((4 + (b) * 2 + (h)) * HTB)
#define PG8_STAGE(bufoff, gbase, voff) do { _Pragma("unroll") for (int _i = 0; _i < 2; ++_i) \
        __builtin_amdgcn_global_load_lds((const unsigned*)((const char*)(gbase) + (voff)[_i]), (PG8_LAS unsigned*)(lds + (bufoff) + ldsw + _i * 8192), 16, 0, 0); } while (0)
#define PG8_LDA(dst, b, h) do { _Pragma("unroll") for (int m = 0; m < 4; ++m) _Pragma("unroll") for (int k = 0; k < 2; ++k) dst[m][k] = *(const PG8_LAS bf16x8*)(lds + PG8_SA(b, h) + aoff + m * 2048 + k * 1024); } while (0)
#define PG8_LDB(dst, b, h) do { _Pragma("unroll") for (int n = 0; n < 2; ++n) _Pragma("unroll") for (int k = 0; k < 2; ++k) dst[n][k] = *(const PG8_LAS bf16x8*)(lds + PG8_SB(b, h) + boff + n * 2048 + k * 1024); } while (0)
#define PG8_MMA(ai, bj, At, Bt) do { __builtin_amdgcn_s_setprio(1); _Pragma("unroll") for (int m = 0; m < 4; ++m) _Pragma("unroll") for (int n = 0; n < 2; ++n) _Pragma("unroll") for (int k = 0; k < 2; ++k) \
        acc[ai][bj][m][n] = __builtin_amdgcn_mfma_f32_16x16x32_bf16(Bt[n][k], At[m][k], acc[ai][bj][m][n], 0, 0, 0); __builtin_amdgcn_s_setprio(0); } while (0)
#define PG8_WAIT_V(n) asm volatile("s_waitcnt vmcnt(" #n ")" ::: "memory")
#define PG8_WAIT_L(n) asm volatile("s_waitcnt lgkmcnt(" #n ")" ::: "memory")
#define PG8_BAR __builtin_amdgcn_s_barrier()
#define PG8_SCHED __builtin_amdgcn_sched_barrier(0)
    Unit cur, nxt; int ui = 0;
    if (!S.next(0, cur)) return;
    f32x4 acc[2][2][4][2];
#pragma unroll
    for (int a = 0; a < 2; ++a)
#pragma unroll
        for (int b = 0; b < 2; ++b)
#pragma unroll
            for (int m = 0; m < 4; ++m)
#pragma unroll
                for (int n = 0; n < 2; ++n) acc[a][b][m][n] = (f32x4){0.f, 0.f, 0.f, 0.f};
    bf16x8 At[4][2], B0[2][2], B1[2][2];
    const char* cA = (const char*)g.A + (size_t)cur.pm * tstep + (size_t)cur.roff * K * 2; const char* cB = (const char*)g.Bt + (size_t)cur.pn * tstep;
    S.a_ready(cur);
    if constexpr (SP2) {
        PG8_STAGE(PG8_SB(0, 0), cB, voffB); PG8_STAGE(PG8_SB(0, 1), cB + hstep, voffB); PG8_STAGE(PG8_SA(0, 0), cA, voffA); PG8_STAGE(PG8_SA(0, 1), cA + hstep, voffA);
        if (wr == 1) PG8_BAR;
        PG8_WAIT_V(2); PG8_BAR;
        PG8_STAGE(PG8_SB(1, 0), cB + kstep, voffB); PG8_STAGE(PG8_SA(1, 0), cA + kstep, voffA); PG8_STAGE(PG8_SB(1, 1), cB + hstep + kstep, voffB);
        PG8_WAIT_V(6); PG8_BAR;
    } else {
        PG8_STAGE(PG8_SB(0, 0), cB, voffB); PG8_STAGE(PG8_SA(0, 0), cA, voffA); PG8_STAGE(PG8_SB(0, 1), cB + hstep, voffB); PG8_STAGE(PG8_SA(0, 1), cA + hstep, voffA);
        if (wr == 1) PG8_BAR;
        PG8_WAIT_V(4); PG8_BAR;
        PG8_STAGE(PG8_SB(1, 0), cB + kstep, voffB); PG8_STAGE(PG8_SA(1, 0), cA + kstep, voffA); PG8_STAGE(PG8_SB(1, 1), cB + hstep + kstep, voffB);
        PG8_WAIT_V(6); PG8_BAR;
    }
    for (;;) {
        const bool has_next = S.next(ui + 1, nxt);
        const char* nA = has_next ? (const char*)g.A + (size_t)nxt.pm * tstep + (size_t)nxt.roff * K * 2 : cA; const char* nB = has_next ? (const char*)g.Bt + (size_t)nxt.pn * tstep : cB;
        for (int t = 0; t < nt; t += 2) {
            const bool last = (t == nt - 2);
            const char* a1 = cA + (size_t)(t + 1) * kstep;
            const char* a2 = last ? nA : cA + (size_t)(t + 2) * kstep; const char* b2 = last ? nB : cB + (size_t)(t + 2) * kstep;
            const char* a3 = a2 + kstep; const char* b3 = b2 + kstep;
            if (last && has_next) S.a_ready(nxt);
            if constexpr (SP2) {
            PG8_LDB(B0, 0, 0); PG8_LDB(B1, 0, 1); PG8_SCHED; PG8_LDA(At, 0, 0); PG8_STAGE(PG8_SA(1, 1), a1 + hstep, voffA);
            PG8_WAIT_V(8); PG8_WAIT_L(0); PG8_BAR; PG8_MMA(0, 0, At, B0); PG8_MMA(0, 1, At, B1); PG8_BAR; PG8_SCHED;
            if constexpr (!HALFM) PG8_LDA(At, 0, 1); PG8_STAGE(PG8_SB(0, 0), b2, voffB); PG8_STAGE(PG8_SB(0, 1), b2 + hstep, voffB); PG8_STAGE(PG8_SA(0, 0), a2, voffA);
            PG8_WAIT_V(8); PG8_WAIT_L(0); PG8_BAR; if constexpr (!HALFM) { PG8_MMA(1, 0, At, B0); PG8_MMA(1, 1, At, B1); } PG8_BAR; PG8_SCHED;
            PG8_LDB(B0, 1, 0); PG8_LDB(B1, 1, 1); PG8_SCHED; PG8_LDA(At, 1, 0); PG8_STAGE(PG8_SA(0, 1), a2 + hstep, voffA);
            PG8_WAIT_V(8); PG8_WAIT_L(0); PG8_BAR; PG8_MMA(0, 0, At, B0); PG8_MMA(0, 1, At, B1); PG8_BAR; PG8_SCHED;
            if constexpr (!HALFM) PG8_LDA(At, 1, 1); PG8_STAGE(PG8_SB(1, 0), b3, voffB); PG8_STAGE(PG8_SB(1, 1), b3 + hstep, voffB); PG8_STAGE(PG8_SA(1, 0), a3, voffA);
            PG8_WAIT_V(8); PG8_WAIT_L(0); PG8_BAR; if constexpr (!HALFM) { PG8_MMA(1, 0, At, B0); PG8_MMA(1, 1, At, B1); } PG8_BAR; PG8_SCHED;
            } else {
            PG8_LDB(B0, 0, 0); PG8_SCHED; PG8_LDA(At, 0, 0); PG8_STAGE(PG8_SA(1, 1), a1 + hstep, voffA);
            PG8_WAIT_L(8); PG8_BAR; PG8_WAIT_L(0); PG8_MMA(0, 0, At, B0); PG8_BAR; PG8_SCHED;
            PG8_LDB(B1, 0, 1); PG8_STAGE(PG8_SB(0, 0), b2, voffB);
            PG8_BAR; PG8_WAIT_L(0); PG8_MMA(0, 1, At, B1); PG8_BAR;
            PG8_LDA(At, 0, 1); PG8_STAGE(PG8_SA(0, 0), a2, voffA);
            PG8_BAR; PG8_WAIT_L(0); PG8_MMA(1, 0, At, B0); PG8_BAR; PG8_SCHED;
            PG8_STAGE(PG8_SB(0, 1), b2 + hstep, voffB);
            PG8_WAIT_V(6); PG8_BAR; PG8_MMA(1, 1, At, B1); PG8_BAR;
            PG8_LDB(B0, 1, 0); PG8_SCHED; PG8_LDA(At, 1, 0); PG8_STAGE(PG8_SA(0, 1), a2 + hstep, voffA);
            PG8_WAIT_L(8); PG8_BAR; PG8_WAIT_L(0); PG8_MMA(0, 0, At, B0); PG8_BAR; PG8_SCHED;
            PG8_LDB(B1, 1, 1); PG8_STAGE(PG8_SB(1, 0), b3, voffB);
            PG8_BAR; PG8_WAIT_L(0); PG8_MMA(0, 1, At, B1); PG8_BAR;
            PG8_LDA(At, 1, 1); PG8_STAGE(PG8_SA(1, 0), a3, voffA);
            PG8_BAR; PG8_WAIT_L(0); PG8_MMA(1, 0, At, B0); PG8_BAR; PG8_SCHED;
            PG8_STAGE(PG8_SB(1, 1), b3 + hstep, voffB);
            PG8_WAIT_V(6); PG8_BAR; PG8_MMA(1, 1, At, B1); PG8_BAR;
            }
        }
        if constexpr (ALIGN_EPI) { if (wr == 0) PG8_BAR; }
        if constexpr (!Epi::AFTER_DRAIN) { E(acc, cur, wr, wc, fr, fq); S.done(cur); }
        if (!has_next) break;
#pragma unroll
        for (int a = 0; a < 2; ++a)
#pragma unroll
            for (int b = 0; b < 2; ++b)
#pragma unroll
                for (int m = 0; m < 4; ++m)
#pragma unroll
                    for (int n = 0; n < 2; ++n) acc[a][b][m][n] = (f32x4){0.f, 0.f, 0.f, 0.f};
        cur = nxt; cA = nA; cB = nB; ++ui;
        if constexpr (ALIGN_EPI) { if (wr == 1) PG8_BAR; }
    }
    PG8_WAIT_V(0);
    if constexpr (!ALIGN_EPI) { if (wr == 0) PG8_BAR; }
    PG8_BAR;
    if constexpr (Epi::AFTER_DRAIN) { E.fused(acc, cur, wr, wc, fr, fq, lds, wid, lane); S.done(cur); }
#undef PG8_SA
#undef PG8_SB
#undef PG8_STAGE
#undef PG8_LDA
#undef PG8_LDB
#undef PG8_MMA
#undef PG8_WAIT_V
#undef PG8_WAIT_L
#undef PG8_BAR
#undef PG8_SCHED
}
}

constexpr int DM = 1024, BATCH = 8, SEQ = 2048, DEPTH = 4, M = BATCH * SEQ;
constexpr int DFF = 2816, NGU = 2 * DFF, NIN = 2560, AW = 768, PWD = 256, NH = 12, HD = 64;
constexpr float NORM_EPS = 1e-6f;
constexpr float QSCALE = 0.125f * 1.4426950408889634f;

#define GAS __attribute__((address_space(1)))
#define LAS __attribute__((address_space(3)))
typedef unsigned short bf16_t;
typedef unsigned u32x4 __attribute__((ext_vector_type(4)));
typedef unsigned u32x2 __attribute__((ext_vector_type(2)));
typedef float f32x4 __attribute__((ext_vector_type(4)));
typedef float f32x16 __attribute__((ext_vector_type(16)));
typedef short bf16x8 __attribute__((ext_vector_type(8)));
typedef short s16x4 __attribute__((ext_vector_type(4)));

constexpr size_t MiB = 1u << 20;
constexpr size_t W_GU = (size_t)NGU * DM * 2, W_D = (size_t)DM * DFF * 2, W_IN = (size_t)NIN * DM * 2, W_OUT = (size_t)DM * DM * 2;
constexpr size_t LW_GU1 = 0, LW_D1 = LW_GU1 + W_GU, LW_IN = LW_D1 + W_D, LW_OUT = LW_IN + W_IN, LW_GU2 = LW_OUT + W_OUT, LW_D2 = LW_GU2 + W_GU, LW_SIZE = LW_D2 + W_D;
static_assert(LW_SIZE == 40 * MiB, "per-layer weight block");
constexpr size_t WS_W = 0;
constexpr size_t WS_XB = 160 * MiB;
constexpr size_t WS_A = 192 * MiB;
__host__ __device__ constexpr size_t off_q(int b) { return WS_A + (size_t)b * 8 * MiB; }
__host__ __device__ constexpr size_t off_vp(int b) { return WS_A + 4 * MiB + (size_t)b * 10 * MiB; }
__host__ __device__ constexpr size_t off_k(int b) { return WS_A + 5 * MiB + (size_t)b * 8 * MiB; }
__host__ __device__ constexpr size_t off_v(int b) { return WS_A + 8 * MiB + (size_t)b * 8 * MiB; }
__host__ __device__ constexpr size_t off_mix(int b) { return WS_A + (size_t)b * 7 * MiB; }
constexpr size_t WS_O = 280 * MiB;
constexpr size_t WS_STAT = 360 * MiB;
constexpr size_t WS_SSQ = 365 * MiB;
constexpr size_t WS_ROPE = 366 * MiB;
constexpr size_t WS_CTL = 367 * MiB, CTL_BYTES = 32768;
constexpr size_t WS_END = 368 * MiB;
__device__ __forceinline__ bf16_t* o_base(unsigned char* ws, unsigned char* dout, int br, int b) { return br < 2 ? (bf16_t*)(ws + WS_O) + (size_t)br * M * AW : (bf16_t*)(dout + (size_t)b * 5 * MiB); }
static_assert((size_t)M * DFF * 2 <= 88 * MiB && (size_t)3 * M * NH * 2 * 4 <= 5 * MiB, "ws map");

struct Args {
    const float* x; const int* pos;
    const float *n1, *g1, *u1, *d1, *nm, *win, *pw, *ps, *wout, *n2, *g2, *u2, *d2, *nf;
    float* out; unsigned char* ws;
    float inv_freq[8];
    int never, pad;
};

namespace epi {
using pg8::Unit; using pg8::BM; using pg8::HALF;
__device__ __forceinline__ float rinv_of(const float* P, int row) {
    const f32x4* p = (const f32x4*)(P + (size_t)row * 16);
    const f32x4 a = p[0], b = p[1], c = p[2], d = p[3];
    const float s = ((a[0] + a[1]) + (a[2] + a[3])) + ((b[0] + b[1]) + (b[2] + b[3])) + ((c[0] + c[1]) + (c[2] + c[3])) + ((d[0] + d[1]) + (d[2] + d[3]));
    return __builtin_amdgcn_rsqf(s * (1.0f / DM) + NORM_EPS);
}
template <class Base> struct RinvOrder : Base {
    const float* P; LAS float* tab;
    __device__ __forceinline__ void a_ready(const Unit& u) const { int t = threadIdx.x; asm volatile("" : "+v"(t)); if (t < 256 - u.roff) tab[u.par * 256 + t] = rinv_of(P, u.pm * BM + u.roff + t); }
};
__device__ __forceinline__ float silu_mul(float g, float u) {
    const float e = __builtin_amdgcn_exp2f(-1.4426950408889634f * g);
    return g * __builtin_amdgcn_rcpf(1.0f + e) * u;
}
template <int NAI> struct EpiSwiGLU {
    static constexpr bool PERM = true, AFTER_DRAIN = false;
    bf16_t* O; const LAS float* tab;
    __device__ __forceinline__ void operator()(const f32x4 (&acc)[2][2][4][2], const Unit& u, int wr, int wc, int fr, int fq) const {
        const int row0 = u.pm * BM + u.roff + wr * 64 + fr, col0 = u.pn * HALF + wc * 32 + 8 * fq;
#pragma unroll
        for (int ai = 0; ai < NAI; ++ai)
#pragma unroll
            for (int m = 0; m < 4; ++m) {
                const int row = row0 + ai * HALF + m * 16; const float ri = tab[u.par * 256 + ai * HALF + wr * 64 + m * 16 + fr];
                const f32x4 g0 = acc[ai][0][m][0] * ri, g1 = acc[ai][0][m][1] * ri, u0 = acc[ai][1][m][0] * ri, u1 = acc[ai][1][m][1] * ri;
                u32x4 w;
                w.x = pg8::cvt_pk_bf16(silu_mul(g0[0], u0[0]), silu_mul(g0[1], u0[1])); w.y = pg8::cvt_pk_bf16(silu_mul(g0[2], u0[2]), silu_mul(g0[3], u0[3]));
                w.z = pg8::cvt_pk_bf16(silu_mul(g1[0], u1[0]), silu_mul(g1[1], u1[1])); w.w = pg8::cvt_pk_bf16(silu_mul(g1[2], u1[2]), silu_mul(g1[3], u1[3]));
                *(u32x4*)(O + (size_t)row * DFF + col0) = w;
                if (m & 1) asm volatile("" ::: "memory");
            }
    }
};
struct EpiResid {
    static constexpr bool PERM = true, AFTER_DRAIN = false;
    const float* X0; bf16_t* XH; float* P; float scale;
    __device__ __forceinline__ void operator()(const f32x4 (&acc)[2][2][4][2], const Unit& u, int wr, int wc, int fr, int fq) const {
        const int row0 = u.pm * BM + wr * 64 + fr, col0 = u.pn * BM + wc * 32 + 8 * fq;
        if (X0) {
#pragma unroll
            for (int g2 = 0; g2 < 4; ++g2) {
                const int ai = g2 >> 1;
                f32x4 xa[2][2][2];
#pragma unroll
                for (int mm = 0; mm < 2; ++mm)
#pragma unroll
                    for (int bj = 0; bj < 2; ++bj) { const float* xp = X0 + (size_t)(row0 + ai * HALF + ((g2 & 1) * 2 + mm) * 16) * DM + col0 + bj * HALF; xa[mm][bj][0] = *(const f32x4*)xp; xa[mm][bj][1] = *(const f32x4*)(xp + 4); }
#pragma unroll
                for (int mm = 0; mm < 2; ++mm) { const int m = (g2 & 1) * 2 + mm; row_out(acc, u, ai, m, row0 + ai * HALF + m * 16, col0, wc, fq, xa[mm][0][0], xa[mm][0][1], xa[mm][1][0], xa[mm][1][1]); }
                asm volatile("" ::: "memory");
            }
        } else {
#pragma unroll
            for (int ai = 0; ai < 2; ++ai) {
                u32x4 hh[4][2];
#pragma unroll
                for (int mm = 0; mm < 4; ++mm)
#pragma unroll
                    for (int bj = 0; bj < 2; ++bj) hh[mm][bj] = *(const u32x4*)(XH + (size_t)(row0 + ai * HALF + mm * 16) * DM + col0 + bj * HALF);
#pragma unroll
                for (int m = 0; m < 4; ++m) { const u32x4 h0 = hh[m][0], h1 = hh[m][1];
                    row_out(acc, u, ai, m, row0 + ai * HALF + m * 16, col0, wc, fq,
                            (f32x4){__uint_as_float(h0.x << 16), __uint_as_float(h0.x & 0xffff0000u), __uint_as_float(h0.y << 16), __uint_as_float(h0.y & 0xffff0000u)}, (f32x4){__uint_as_float(h0.z << 16), __uint_as_float(h0.z & 0xffff0000u), __uint_as_float(h0.w << 16), __uint_as_float(h0.w & 0xffff0000u)},
                            (f32x4){__uint_as_float(h1.x << 16), __uint_as_float(h1.x & 0xffff0000u), __uint_as_float(h1.y << 16), __uint_as_float(h1.y & 0xffff0000u)}, (f32x4){__uint_as_float(h1.z << 16), __uint_as_float(h1.z & 0xffff0000u), __uint_as_float(h1.w << 16), __uint_as_float(h1.w & 0xffff0000u)}); }
                asm volatile("" ::: "memory");
            }
        }
    }
    __device__ __forceinline__ void row_out(const f32x4 (&acc)[2][2][4][2], const Unit& u, int ai, int m, int row, int col0, int wc, int fq, f32x4 x00, f32x4 x01, f32x4 x10, f32x4 x11) const {
        float ss = 0.f;
#pragma unroll
        for (int bj = 0; bj < 2; ++bj) {
            const f32x4 a = (bj ? x10 : x00) + acc[ai][bj][m][0] * scale, b = (bj ? x11 : x01) + acc[ai][bj][m][1] * scale;
            u32x4 w; w.x = pg8::cvt_pk_bf16(a[0], a[1]); w.y = pg8::cvt_pk_bf16(a[2], a[3]); w.z = pg8::cvt_pk_bf16(b[0], b[1]); w.w = pg8::cvt_pk_bf16(b[2], b[3]);
            *(u32x4*)(XH + (size_t)row * DM + col0 + bj * HALF) = w;
            ss += (a[0] * a[0] + a[1] * a[1]) + (a[2] * a[2] + a[3] * a[3]) + (b[0] * b[0] + b[1] * b[1]) + (b[2] * b[2] + b[3] * b[3]);
        }
        ss += __shfl_xor(ss, 16); ss += __shfl_xor(ss, 32);
        if (fq == 0) P[(size_t)row * 16 + u.pn * 4 + wc] = ss;
    }
};
template <int NAI> struct EpiProj {
    static constexpr bool PERM = true, AFTER_DRAIN = false;
    bf16_t *VP, *Q, *K, *V; const LAS float* tab; const float* CS;
    __device__ __forceinline__ void operator()(const f32x4 (&acc)[2][2][4][2], const Unit& u, int wr, int wc, int fr, int fq) const {
        const int pn = u.pn;
        bf16_t* dst; int ld, cb;
        if (pn == 0) { dst = VP; ld = PWD; cb = 0; } else if (pn < 4) { dst = Q; ld = AW; cb = (pn - 1) * 256; } else if (pn < 7) { dst = K; ld = AW; cb = (pn - 4) * 256; } else { dst = V; ld = AW; cb = (pn - 7) * 256; }
        const bool ropetile = (pn >= 1 && pn <= 6);
        const bool ropelane = ropetile && !(wc & 1) && (fq < 2);
        const float sgn = (fq == 0) ? -1.f : 1.f;
        const float qs = (pn >= 1 && pn < 4) ? QSCALE : 1.f;
        const int row0 = u.pm * BM + u.roff + wr * 64 + fr, col0 = cb + wc * 32 + 8 * fq;
#pragma unroll
        for (int ai = 0; ai < NAI; ++ai)
#pragma unroll
            for (int m = 0; m < 4; ++m) {
                const int row = row0 + ai * HALF + m * 16; const float ri = tab[u.par * 256 + ai * HALF + wr * 64 + m * 16 + fr];
                f32x4 c0 = {1.f, 1.f, 1.f, 1.f}, c1 = c0, s0 = {0.f, 0.f, 0.f, 0.f}, s1 = s0;
                if (ropelane) { const f32x4* cs = (const f32x4*)(CS + (size_t)row * 16); c0 = cs[0]; c1 = cs[1]; s0 = cs[2]; s1 = cs[3]; }
#pragma unroll
                for (int bj = 0; bj < 2; ++bj) {
                    f32x4 v0 = acc[ai][bj][m][0] * ri, v1 = acc[ai][bj][m][1] * ri;
                    if (ropetile) {
                        f32x4 p0, p1;
#pragma unroll
                        for (int j = 0; j < 4; ++j) { p0[j] = __shfl_xor(v0[j], 16); p1[j] = __shfl_xor(v1[j], 16); }
                        if (ropelane) { v0 = v0 * c0 + p0 * s0 * sgn; v1 = v1 * c1 + p1 * s1 * sgn; }
                    }
                    v0 = v0 * qs; v1 = v1 * qs;
                    u32x4 w; w.x = pg8::cvt_pk_bf16(v0[0], v0[1]); w.y = pg8::cvt_pk_bf16(v0[2], v0[3]); w.z = pg8::cvt_pk_bf16(v1[0], v1[1]); w.w = pg8::cvt_pk_bf16(v1[2], v1[3]);
                    *(u32x4*)(dst + (size_t)row * ld + col0 + bj * HALF) = w;
                }
                if (m & 1) asm volatile("" ::: "memory");
            }
    }
};
}

namespace att {
constexpr int NSLOT = 448, KCS = NSLOT * 16 + 16, VDS = NSLOT * 64 + 64;
constexpr int L_K = 0, L_V = 8 * KCS, L_WS = L_V + 2 * VDS, L_OST = L_WS + 8 * 256, L_END = L_OST + 8 * 4096;
static_assert(L_END <= 149760, "attention LDS");
__device__ __forceinline__ int crow(int r, int hi) { return (r & 3) + 8 * (r >> 2) + 4 * hi; }
__device__ __forceinline__ s16x4 vtr(const LAS unsigned char* p) { return __builtin_bit_cast(s16x4, __builtin_amdgcn_ds_read_tr16_b64_v4i16((LAS s16x4*)p)); }
struct UD { int b, h, br, u; };
__device__ __forceinline__ UD decode(int uidg) { UD x; x.u = uidg & 7; x.br = (uidg >> 3) % 3; const int bh = uidg / 24; x.b = bh / NH; x.h = bh % NH; return x; }

__device__ __forceinline__ void load_kv(u32x4 (&val)[14], const UD& x, const unsigned char* ws, int tid) {
    const int br = x.br, u = x.u, sub = tid & 15, s0 = tid >> 4;
    const bf16_t* base = (const bf16_t*)(ws + ((sub < 8) ? off_k(x.b) : off_v(x.b))) + (size_t)x.b * SEQ * AW + x.h * HD + (sub & 7) * 8;
    if (br < 2) {
        const int d = (br == 0) ? 1 : 4, L = SEQ / d, T0 = (br == 0) ? 256 * u : 256 * (u & 1), cls = (br == 0) ? 0 : (u >> 1);
        const int k0 = T0 - 64 + s0;
        const bf16_t* p0 = base + ((long)k0 * d + cls) * AW; const long stride = (long)32 * d * AW;
#pragma unroll
        for (int i = 0; i < 14; ++i) { const int key = k0 + 32 * i; val[i] = (u32x4){0u, 0u, 0u, 0u};
            if ((i < 12) && (key >= 0) && (key < L)) val[i] = *(const u32x4*)(p0 + i * stride); }
    } else {
        const bf16_t* pa = base + ((long)(s0 - 64) * 16 + 2 * u) * AW; const bf16_t* pb = base + ((long)s0 * 16 + 2 * u + 1) * AW; const long stride = (long)32 * 16 * AW;
#pragma unroll
        for (int i = 0; i < 14; ++i) { val[i] = (u32x4){0u, 0u, 0u, 0u};
            if (i < 8) { const int key = s0 + 32 * i - 64; if ((key >= 0) && (key < 128)) val[i] = *(const u32x4*)(pa + i * stride); }
            else if (i < 12) val[i] = *(const u32x4*)(pb + (i - 8) * stride); }
    }
}
__device__ __forceinline__ void store_kv(LAS unsigned char* lds, const u32x4 (&val)[14], int tid) {
#pragma unroll
    for (int i = 0; i < 14; ++i) {
        const int piece = tid + 512 * i, slot = piece >> 4, sub = piece & 15;
        const int off = (sub < 8) ? (L_K + sub * KCS + slot * 16) : (L_V + ((sub - 8) >> 2) * VDS + slot * 64 + ((sub - 8) & 3) * 16);
        *(LAS u32x4*)(lds + off) = val[i];
    }
}
__device__ __forceinline__ void wave_geo(const UD& x, int wid, int& d, int& L, int& cls, int& t0, int& sbase) {
    const int br = x.br, u = x.u; d = (br == 0) ? 1 : (br == 1) ? 4 : 16; L = SEQ / d;
    if (br < 2) { const int T0 = (br == 0) ? 256 * u : 256 * (u & 1); cls = (br == 0) ? 0 : (u >> 1); t0 = T0 + 32 * wid; sbase = 32 * wid; }
    else { const int hw = wid >> 2; cls = 2 * u + hw; t0 = 32 * (wid & 3); sbase = 192 * hw + 32 * (wid & 3); }
}
__device__ __forceinline__ void load_q(bf16x8 (&qr)[4], const UD& x, const unsigned char* ws, int wid, int r32, int hi) {
    int d, L, cls, t0, sbase; wave_geo(x, wid, d, L, cls, t0, sbase);
    const bf16_t* Qb = (const bf16_t*)(ws + off_q(x.b));
    const size_t qtok = (size_t)x.b * SEQ + (size_t)(t0 + r32) * d + cls;
#pragma unroll
    for (int d0 = 0; d0 < 4; ++d0) qr[d0] = *(const bf16x8*)(Qb + qtok * AW + x.h * HD + d0 * 16 + hi * 8);
}
__device__ __forceinline__ void compute_a(LAS unsigned char* lds, const UD& x, const bf16x8 (&qr)[4], int wid, int lane, u32x4 (&pw)[10], float& mx_o, float& l_o) {
    const int r32 = lane & 31, hi = lane >> 5;
    int d, L, cls, t0, sbase; wave_geo(x, wid, d, L, cls, t0, sbase);
    f32x16 s[5];
#pragma unroll
    for (int ht = 0; ht < 5; ++ht) {
        const LAS unsigned char* kb = lds + L_K + hi * KCS + (sbase + 32 * ht + r32) * 16;
        f32x16 a = {};
#pragma unroll
        for (int d0 = 0; d0 < 4; ++d0) { const bf16x8 kf = *(const LAS bf16x8*)(kb + d0 * 2 * KCS); a = __builtin_amdgcn_mfma_f32_32x32x16_bf16(kf, qr[d0], a, 0, 0, 0); }
        s[ht] = a;
    }
    {
        const int dq = r32 - 4 * hi;
#pragma unroll
        for (int r = 0; r < 16; ++r) { const int cr = (r & 3) + 8 * (r >> 2); s[0][r] = (cr >= dq) ? s[0][r] : -INFINITY; s[4][r] = (cr <= dq) ? s[4][r] : -INFINITY; }
        if (t0 < 64) {
#pragma unroll
            for (int r = 0; r < 16; ++r) s[0][r] = -INFINITY;
            if (t0 < 32) {
#pragma unroll
                for (int r = 0; r < 16; ++r) s[1][r] = -INFINITY;
            }
        }
        if (t0 + 96 > L) {
#pragma unroll
            for (int r = 0; r < 16; ++r) s[4][r] = -INFINITY;
            if (t0 + 64 > L) {
#pragma unroll
                for (int r = 0; r < 16; ++r) s[3][r] = -INFINITY;
            }
        }
    }
    float mx = s[2][0];
#pragma unroll
    for (int ht = 0; ht < 5; ++ht)
#pragma unroll
        for (int r = 0; r < 16; ++r) mx = fmaxf(mx, s[ht][r]);
    mx = fmaxf(mx, __shfl_xor(mx, 32));
    float lsum = 0.f;
#pragma unroll
    for (int ht = 0; ht < 5; ++ht)
#pragma unroll
        for (int r = 0; r < 16; ++r) { const float p = __builtin_amdgcn_exp2f(s[ht][r] - mx); s[ht][r] = p; lsum += p; }
    lsum += __shfl_xor(lsum, 32);
#pragma unroll
    for (int g = 0; g < 10; ++g) {
        const int ht = g >> 1, rb = (g & 1) * 8;
        pw[g].x = pg8::cvt_pk_bf16(s[ht][rb + 0], s[ht][rb + 1]); pw[g].y = pg8::cvt_pk_bf16(s[ht][rb + 2], s[ht][rb + 3]); pw[g].z = pg8::cvt_pk_bf16(s[ht][rb + 4], s[ht][rb + 5]); pw[g].w = pg8::cvt_pk_bf16(s[ht][rb + 6], s[ht][rb + 7]);
    }
    mx_o = mx; l_o = lsum;
}
__device__ __forceinline__ void compute_b(LAS unsigned char* lds, const UD& x, unsigned char* ws, unsigned char* dout, int wid, int lane, const u32x4 (&pw)[10], float mx, float lsum) {
    const int r32 = lane & 31, hi = lane >> 5;
    int d, L, cls, t0, sbase; wave_geo(x, wid, d, L, cls, t0, sbase);
    const size_t tokb = (size_t)x.b * SEQ;
    const size_t qtok = tokb + (size_t)(t0 + r32) * d + cls;
    f32x16 o[2]; o[0] = f32x16{}; o[1] = f32x16{};
    const int vlane = ((lane >> 4) & 1) * 32 + (lane & 3) * 8 + (4 * hi + ((lane & 15) >> 2)) * 64;
#pragma unroll
    for (int g = 0; g < 10; ++g) {
        const bf16x8 pa = __builtin_bit_cast(bf16x8, pw[g]);
#pragma unroll
        for (int d0 = 0; d0 < 2; ++d0) {
            const LAS unsigned char* vp = lds + L_V + d0 * VDS + (sbase + 16 * g) * 64 + vlane;
            const s16x4 lo = vtr(vp), hh = vtr(vp + 512);
            const bf16x8 vf = (bf16x8){lo[0], lo[1], lo[2], lo[3], hh[0], hh[1], hh[2], hh[3]};
            o[d0] = __builtin_amdgcn_mfma_f32_32x32x16_bf16(pa, vf, o[d0], 0, 0, 0);
        }
    }
    LAS float* wsf = (LAS float*)(lds + L_WS + wid * 256);
    LAS bf16_t* stg = (LAS bf16_t*)(lds + L_OST + wid * 4096);
    if (hi == 0) {
        wsf[r32] = lsum;
        float* st = (float*)(ws + WS_STAT) + (((size_t)x.br * M + qtok) * NH + x.h) * 2; st[0] = mx; st[1] = lsum;
    }
    asm volatile("s_waitcnt lgkmcnt(0)" ::: "memory");
#pragma unroll
    for (int r = 0; r < 16; ++r) {
        const int qrow = crow(r, hi); const float rl = __builtin_amdgcn_rcpf(wsf[qrow]);
        const unsigned a = pg8::cvt_pk_bf16(o[0][r] * rl, o[1][r] * rl);
        stg[qrow * 64 + r32] = (bf16_t)(a & 0xffffu); stg[qrow * 64 + 32 + r32] = (bf16_t)(a >> 16);
    }
    asm volatile("s_waitcnt lgkmcnt(0)" ::: "memory");
    bf16_t* Ob = o_base(ws, dout, x.br, x.b);
#pragma unroll
    for (int i = 0; i < 4; ++i) {
        const int row = i * 8 + (lane >> 3), ch = lane & 7;
        const u32x4 v = *(const LAS u32x4*)(stg + row * 64 + ch * 8);
        *(u32x4*)(Ob + (tokb + (size_t)(t0 + row) * d + cls) * AW + x.h * HD + ch * 8) = v;
    }
}
__device__ __forceinline__ void phase(LAS unsigned char* lds, unsigned char* ws, unsigned char* dout, int first, int step, int limit) {
    int tid_ = threadIdx.x; asm volatile("" : "+v"(tid_));
    const int tid = tid_, lane = tid & 63; const int wid = __builtin_amdgcn_readfirstlane(tid >> 6);
    if (first >= limit) return;
    u32x4 val[14];
    load_kv(val, decode(first), ws, tid);
    for (int uid = first; uid < limit; uid += step) {
        const UD x = decode(uid);
        bf16x8 qr[4]; load_q(qr, x, ws, wid, lane & 31, lane >> 5);
        store_kv(lds, val, tid);
        __syncthreads();
        u32x4 pw[10]; float mx, lsum;
        compute_a(lds, x, qr, wid, lane, pw, mx, lsum);
        if (uid + step < limit) load_kv(val, decode(uid + step), ws, tid);
        compute_b(lds, x, ws, dout, wid, lane, pw, mx, lsum);
        __syncthreads();
    }
}
}

__device__ __forceinline__ float bf2f(unsigned short h) { return __uint_as_float((unsigned)h << 16); }
__device__ __forceinline__ float wave_sum(float v) {
#pragma unroll
    for (int o = 1; o < 64; o <<= 1) v += __shfl_xor(v, o);
    return v;
}
__device__ __forceinline__ unsigned f2bf(float f) { unsigned u = __float_as_uint(f); return (u + 0x7fffu + ((u >> 16) & 1u)) >> 16; }
__device__ __forceinline__ unsigned pk2(float lo, float hi) { return f2bf(lo) | (f2bf(hi) << 16); }

struct TrItem { const float* W; const float* gain; bf16_t* WT; int N, k0, n0, ldw, drow0; };
__device__ __forceinline__ void tr_load(f32x4 (&v)[16], const TrItem& t, int lane) {
    const int kr = lane >> 4, nc = 4 * (lane & 15);
#pragma unroll
    for (int i = 0; i < 16; ++i) v[i] = *(const f32x4*)(t.W + (size_t)(t.k0 + 4 * i + kr) * t.N + t.n0 + nc);
}
__device__ __forceinline__ void tr_finish(const f32x4 (&v)[16], const TrItem& t, LAS float* scr, int lane) {
    const int kr = lane >> 4, nc = 4 * (lane & 15);
#pragma unroll
    for (int i = 0; i < 16; ++i) { const int kk = 4 * i + kr; const float gg = t.gain ? t.gain[t.k0 + kk] : 1.f; LAS float* s = scr + kk * 65 + nc;
        s[0] = v[i][0] * gg; s[1] = v[i][1] * gg; s[2] = v[i][2] * gg; s[3] = v[i][3] * gg; }
    asm volatile("s_waitcnt lgkmcnt(0)" ::: "memory");
    const int c = lane & 7;
#pragma unroll
    for (int j = 0; j < 8; ++j) { const int n = (lane >> 3) + 8 * j; const LAS float* s = scr + (8 * c) * 65 + n;
        u32x4 o; o.x = pk2(s[0 * 65], s[1 * 65]); o.y = pk2(s[2 * 65], s[3 * 65]); o.z = pk2(s[4 * 65], s[5 * 65]); o.w = pk2(s[6 * 65], s[7 * 65]);
        *(u32x4*)(t.WT + (size_t)(t.drow0 + n) * t.ldw + t.k0 + 8 * c) = o; }
    asm volatile("s_waitcnt lgkmcnt(0)" ::: "memory");
}
constexpr int I_G = 16 * 44, I_D = 44 * 16, I_IN = 16 * 40, I_O = 12 * 16, I_LAYER = 6 * I_G + I_IN + I_O;
static_assert(I_G == I_D, "item counts");
__device__ __forceinline__ TrItem tr_decode(const Args& a, int it) {
    TrItem t; const int l = it / I_LAYER; int r = it % I_LAYER;
    unsigned char* wl = a.ws + WS_W + (size_t)l * LW_SIZE;
    if (r < 6 * I_G) {
        const int seg = r / I_G; r = r % I_G;
        const int ffn = seg / 3, kind = seg % 3;
        if (kind < 2) {
            t.W = (kind == 0 ? (ffn ? a.g2 : a.g1) : (ffn ? a.u2 : a.u1)) + (size_t)l * DM * DFF; t.gain = (ffn ? a.n2 : a.n1) + (size_t)l * DM;
            t.WT = (bf16_t*)(wl + (ffn ? LW_GU2 : LW_GU1)); t.N = DFF; t.ldw = DM;
            const int kb = r / 44, nb = r % 44; t.k0 = 64 * kb; t.n0 = 64 * nb; t.drow0 = 256 * (t.n0 / 128) + 128 * kind + (t.n0 % 128);
        } else {
            t.W = (ffn ? a.d2 : a.d1) + (size_t)l * DFF * DM; t.gain = nullptr; t.WT = (bf16_t*)(wl + (ffn ? LW_D2 : LW_D1)); t.N = DM; t.ldw = DFF;
            const int kb = r / 16, nb = r % 16; t.k0 = 64 * kb; t.n0 = 64 * nb; t.drow0 = 64 * nb;
        }
    } else if (r < 6 * I_G + I_IN) {
        r -= 6 * I_G; const int kb = r / 40, nb = r % 40;
        t.W = a.win + (size_t)l * DM * NIN; t.gain = a.nm + (size_t)l * DM; t.WT = (bf16_t*)(wl + LW_IN); t.N = NIN; t.ldw = DM; t.k0 = 64 * kb; t.n0 = 64 * nb; t.drow0 = 64 * nb;
    } else {
        r -= 6 * I_G + I_IN; const int kb = 4 + r / 16, nb = r % 16;
        t.W = a.wout + (size_t)l * DM * DM; t.gain = nullptr; t.WT = (bf16_t*)(wl + LW_OUT); t.N = DM; t.ldw = DM; t.k0 = 64 * kb; t.n0 = 64 * nb; t.drow0 = 64 * nb;
    }
    return t;
}

__device__ __forceinline__ void prologue(const Args& a, LAS unsigned char* lds, int vcu, int G) {
    const int tid = threadIdx.x, lane = tid & 63, wave = __builtin_amdgcn_readfirstlane(tid >> 6);
    LAS float* scr = (LAS float*)(lds + wave * 16640);
    const int gw = vcu * 8 + wave, NGW = G * 8;
    unsigned char* ws = a.ws;
    if (gw < DEPTH * I_LAYER) {
        TrItem cur = tr_decode(a, gw); f32x4 va[16]; tr_load(va, cur, lane);
        for (int it = gw; it < DEPTH * I_LAYER; it += NGW) {
            const bool more = it + NGW < DEPTH * I_LAYER;
            TrItem nxt = cur; f32x4 vb[16];
            if (more) { nxt = tr_decode(a, it + NGW); tr_load(vb, nxt, lane); }
            tr_finish(va, cur, scr, lane);
            if (more) {
#pragma unroll
                for (int i = 0; i < 16; ++i) va[i] = vb[i];
                cur = nxt; }
        }
    }
    for (int it = gw; it < DEPTH * 4 * 8 * 16; it += NGW) {
        const int l = it >> 9, g = (it >> 7) & 3, c8 = (it >> 4) & 7, n = (it & 15) * 64 + lane;
        const float* wo = a.wout + (size_t)l * DM * DM + (size_t)(g * 64) * DM + n;
        const float* sc = a.ps + (size_t)l * PWD + g * 64;
        const float* pr = a.pw + (((size_t)l * 4 + g) * 64 + c8 * 8) * 64;
        float acc[8] = {0.f, 0.f, 0.f, 0.f, 0.f, 0.f, 0.f, 0.f};
#pragma unroll 4
        for (int dd = 0; dd < 64; ++dd) { const float wv = wo[(size_t)dd * DM] * sc[dd];
#pragma unroll
            for (int e = 0; e < 8; ++e) acc[e] += pr[e * 64 + dd] * wv; }
        u32x4 o; o.x = pk2(acc[0], acc[1]); o.y = pk2(acc[2], acc[3]); o.z = pk2(acc[4], acc[5]); o.w = pk2(acc[6], acc[7]);
        *(u32x4*)((bf16_t*)(ws + WS_W + (size_t)l * LW_SIZE + LW_OUT) + (size_t)n * DM + g * 64 + c8 * 8) = o;
    }
    bf16_t* XB = (bf16_t*)(ws + WS_XB); float* P = (float*)(ws + WS_SSQ); float* CS = (float*)(ws + WS_ROPE);
    for (int mp = gw; mp < M; mp += 2 * NGW) {
        f32x4 v[2][4];
#pragma unroll
        for (int q = 0; q < 2; ++q) { const int m = (mp + q * NGW < M) ? mp + q * NGW : mp; const f32x4* xr = (const f32x4*)(a.x + (size_t)m * DM) + lane;
#pragma unroll
            for (int j = 0; j < 4; ++j) v[q][j] = xr[64 * j]; }
#pragma unroll
        for (int q = 0; q < 2; ++q) {
            const int m = (mp + q * NGW < M) ? mp + q * NGW : mp;
            u32x2* xb = (u32x2*)(XB + (size_t)m * DM) + lane;
            float s = 0.f;
#pragma unroll
            for (int j = 0; j < 4; ++j) { const f32x4 x4 = v[q][j]; s += (x4[0] * x4[0] + x4[1] * x4[1]) + (x4[2] * x4[2] + x4[3] * x4[3]);
                u32x2 w; w.x = pk2(x4[0], x4[1]); w.y = pk2(x4[2], x4[3]); xb[64 * j] = w; }
            s = wave_sum(s);
            if (lane < 16) P[(size_t)m * 16 + lane] = (lane == 0) ? s : 0.f;
            if (lane < 8) {
                const float ang = (float)a.pos[m] * a.inv_freq[lane];
                double rev = (double)ang * 0.15915494309189535; rev -= floor(rev);
                const float fr = (float)rev;
                CS[(size_t)m * 16 + lane] = __builtin_amdgcn_cosf(fr); CS[(size_t)m * 16 + 8 + lane] = __builtin_amdgcn_sinf(fr);
            }
        }
    }
}

__device__ __forceinline__ void combine_phase(const Args& a, int wv0, int nwv, int tok0, int ntok) {
    int tid_ = threadIdx.x; asm volatile("" : "+v"(tid_));
    const int tid = tid_, lane = tid & 63, wave = __builtin_amdgcn_readfirstlane(tid >> 6);
    const int gw = wv0 + wave, NGW = nwv;
    unsigned char* ws = a.ws;
    const float* __restrict__ ST = (const float*)(ws + WS_STAT);
    const int g = lane >> 4, hw = 1 << g;
    for (int tokp = tok0 + gw; tokp < tok0 + ntok; tokp += 2 * NGW) {
        u32x2 vv[2][16], me[2]; int cnt[2]; float mm[2][2][3], ll[2][2][3]; u32x4 ov[2][2][3];
#pragma unroll
        for (int q = 0; q < 2; ++q) {
            const int tok = (tokp + q * NGW < tok0 + ntok) ? tokp + q * NGW : tokp;
            const int bb = tok >> 11, s = tok & (SEQ - 1);
            const bf16_t* base = (const bf16_t*)(ws + off_vp(bb)) + (size_t)(tok - s) * PWD + 4 * lane;
            cnt[q] = 0;
#pragma unroll
            for (int jj = 0; jj < 16; ++jj) { const int j = s - hw + jj; const bool ok = (jj < 2 * hw) && (j >= 0) && (j < SEQ);
                vv[q][jj] = (u32x2){0u, 0u}; if (ok) vv[q][jj] = *(const u32x2*)(base + (size_t)j * PWD); cnt[q] += ok ? 1 : 0; }
            me[q] = *(const u32x2*)(base + (size_t)s * PWD);
#pragma unroll
            for (int it = 0; it < 2; ++it) {
                const int chunk = (it * 64 + lane < 96) ? it * 64 + lane : 95, h = chunk >> 3;
#pragma unroll
                for (int i = 0; i < 3; ++i) { const float* st = ST + (((size_t)i * M + tok) * NH + h) * 2; mm[q][it][i] = st[0]; ll[q][it][i] = st[1]; ov[q][it][i] = *(const u32x4*)(o_base(ws, (unsigned char*)a.out, i, bb) + (size_t)tok * AW + chunk * 8); }
            }
        }
#pragma unroll
        for (int q = 0; q < 2; ++q) {
            const int tok = (tokp + q * NGW < tok0 + ntok) ? tokp + q * NGW : tokp;
            bf16_t* MIX = (bf16_t*)(ws + off_mix(tok >> 11));
            float s0 = 0.f, s1 = 0.f, s2 = 0.f, s3 = 0.f;
#pragma unroll
            for (int jj = 0; jj < 16; ++jj) { s0 += __uint_as_float(vv[q][jj].x << 16); s1 += __uint_as_float(vv[q][jj].x & 0xffff0000u); s2 += __uint_as_float(vv[q][jj].y << 16); s3 += __uint_as_float(vv[q][jj].y & 0xffff0000u); }
            const float rc = 1.0f / (float)cnt[q];
            u32x2 w2; w2.x = pk2(s0 * rc - __uint_as_float(me[q].x << 16), s1 * rc - __uint_as_float(me[q].x & 0xffff0000u)); w2.y = pk2(s2 * rc - __uint_as_float(me[q].y << 16), s3 * rc - __uint_as_float(me[q].y & 0xffff0000u));
            *(u32x2*)(MIX + (size_t)tok * DM + 4 * lane) = w2;
#pragma unroll
            for (int it = 0; it < 2; ++it) {
                const int chunk = it * 64 + lane;
                float mxx = fmaxf(fmaxf(mm[q][it][0], mm[q][it][1]), mm[q][it][2]);
                float wgt[3], den = 0.f;
#pragma unroll
                for (int i = 0; i < 3; ++i) { wgt[i] = __builtin_amdgcn_exp2f(mm[q][it][i] - mxx) * ll[q][it][i]; den += wgt[i]; }
                const float rd = 1.0f / den;
                float acc[8] = {0.f, 0.f, 0.f, 0.f, 0.f, 0.f, 0.f, 0.f};
#pragma unroll
                for (int i = 0; i < 3; ++i) { const u32x4 v = ov[q][it][i]; const float wi = wgt[i] * rd;
                    acc[0] += wi * __uint_as_float(v.x << 16); acc[1] += wi * __uint_as_float(v.x & 0xffff0000u); acc[2] += wi * __uint_as_float(v.y << 16); acc[3] += wi * __uint_as_float(v.y & 0xffff0000u);
                    acc[4] += wi * __uint_as_float(v.z << 16); acc[5] += wi * __uint_as_float(v.z & 0xffff0000u); acc[6] += wi * __uint_as_float(v.w << 16); acc[7] += wi * __uint_as_float(v.w & 0xffff0000u); }
                u32x4 w; w.x = pk2(acc[0], acc[1]); w.y = pk2(acc[2], acc[3]); w.z = pk2(acc[4], acc[5]); w.w = pk2(acc[6], acc[7]);
                if (chunk < 96) *(u32x4*)(MIX + (size_t)tok * DM + PWD + chunk * 8) = w;
            }
        }
    }
}

__device__ __forceinline__ void final_norm(const Args& a, int wv0, int nwv, int tok0, int ntok) {
    const int tid = threadIdx.x, lane = tid & 63, wave = __builtin_amdgcn_readfirstlane(tid >> 6);
    const int gw = wv0 + wave, NGW = nwv;
    const f32x4* gr = (const f32x4*)a.nf + lane;
    const bf16_t* XH = (const bf16_t*)(a.ws + WS_XB);
    for (int mp = tok0 + gw; mp < tok0 + ntok; mp += 2 * NGW) {
        u32x2 hh[2][4];
#pragma unroll
        for (int q = 0; q < 2; ++q) { const int m = (mp + q * NGW < tok0 + ntok) ? mp + q * NGW : mp; const u32x2* ph = (const u32x2*)(XH + (size_t)m * DM) + lane;
#pragma unroll
            for (int j = 0; j < 4; ++j) hh[q][j] = ph[64 * j]; }
        f32x4 v[2][4]; float ri[2];
#pragma unroll
        for (int q = 0; q < 2; ++q) { float s = 0.f;
#pragma unroll
            for (int j = 0; j < 4; ++j) { const u32x2 h = hh[q][j];
                v[q][j] = (f32x4){__uint_as_float(h.x << 16), __uint_as_float(h.x & 0xffff0000u), __uint_as_float(h.y << 16), __uint_as_float(h.y & 0xffff0000u)};
                s += (v[q][j][0] * v[q][j][0] + v[q][j][1] * v[q][j][1]) + (v[q][j][2] * v[q][j][2] + v[q][j][3] * v[q][j][3]); }
            ri[q] = 1.0f / sqrtf(wave_sum(s) * (1.0f / DM) + NORM_EPS); }
#pragma unroll
        for (int q = 0; q < 2; ++q) { if (q == 1 && mp + NGW >= tok0 + ntok) break; const int m = mp + q * NGW; f32x4* xr = (f32x4*)(a.out + (size_t)m * DM) + lane;
#pragma unroll
            for (int j = 0; j < 4; ++j) xr[64 * j] = v[q][j] * ri[q] * gr[64 * j]; }
    }
}

#define XB_TMO      128
#define XB_XCNT(j)  (256  + 64 * (j))
#define XB_XSUB(j)  (1280 + 64 * (j))
#define XB_XGEN(j)  (2304 + 64 * (j))
#define XB_TOP      3328
#define XB_TOPGEN   3392
#define XCD_BAR_WORDS 3456
#define XB_SPIN_CAP (1u << 18)

__device__ __forceinline__ unsigned xb_ld(unsigned* p)              { return __hip_atomic_load(p, __ATOMIC_RELAXED, __HIP_MEMORY_SCOPE_AGENT); }
__device__ __forceinline__ unsigned xb_add(unsigned* p, unsigned v) { return __hip_atomic_fetch_add(p, v, __ATOMIC_RELAXED, __HIP_MEMORY_SCOPE_AGENT); }
__device__ __forceinline__ unsigned xb_xcc_id() { return (unsigned)__builtin_amdgcn_s_getreg((3 << 11) | 20) & 0xFu; }
#define XB_SPIN(cond, bar) do { unsigned _sp = 0; while (cond) { __builtin_amdgcn_s_sleep(1); \
    if ((++_sp & 255u) == 0u) { if (xb_ld(&(bar)[XB_TMO])) break; if (_sp > XB_SPIN_CAP) { atomicAdd(&(bar)[XB_TMO], 1u); break; } } } } while (0)

struct XcdBarrier {
    unsigned* bar; unsigned x;
    volatile LAS unsigned* st;
};

__device__ __forceinline__ XcdBarrier xcd_barrier_post(unsigned* bar, volatile LAS unsigned* st) {
    XcdBarrier b; b.bar = bar; b.x = xb_xcc_id(); b.st = st;
    if (threadIdx.x == 0) (void)xb_add(&bar[XB_XCNT(b.x)], 1u);
    return b;
}
__device__ __forceinline__ void xcd_barrier_complete(unsigned* bar, unsigned x, unsigned& nloc, unsigned& nx) {
    const unsigned G = gridDim.x * gridDim.y * gridDim.z;
    unsigned sum, cnt, mine, sp = 0u;
    for (;;) {
        sum = 0u; cnt = 0u; mine = 0u;
#pragma unroll
        for (unsigned j = 0; j < 16; ++j) { const unsigned c = xb_ld(&bar[XB_XCNT(j)]); sum += c; cnt += (c > 0u) ? 1u : 0u; mine = (j == x) ? c : mine; }
        if (sum == G) break;
        __builtin_amdgcn_s_sleep(1);
        if ((++sp & 255u) == 0u) { if (xb_ld(&bar[XB_TMO])) break; if (sp > XB_SPIN_CAP) { atomicAdd(&bar[XB_TMO], 1u); break; } }
    }
    nloc = mine > 0u ? mine : 1u; nx = cnt > 0u ? cnt : 1u;
}

__device__ __forceinline__ void xcd_barrier(const XcdBarrier& b) {
    asm volatile("s_waitcnt vmcnt(0)" ::: "memory");
    __syncthreads();
    if (threadIdx.x == 0) {
        unsigned* bar = b.bar;
        __builtin_amdgcn_s_waitcnt(0);
        unsigned nloc = b.st[0], nx = b.st[1];
        if (nloc == 0u) { xcd_barrier_complete(bar, b.x, nloc, nx); b.st[0] = nloc; b.st[1] = nx; }
        const unsigned old = xb_add(&bar[XB_XSUB(b.x)], 1u);
        const unsigned gen = old / nloc;
        if (old + 1u == (gen + 1u) * nloc) {
            __builtin_amdgcn_fence(__ATOMIC_RELEASE, "agent");
            asm volatile("s_waitcnt vmcnt(0)" ::: "memory");
            const unsigned og = xb_add(&bar[XB_TOP], 1u);
            const unsigned tg = og / nx;
            if (og + 1u == (tg + 1u) * nx) xb_add(&bar[XB_TOPGEN], 1u);
            else XB_SPIN(xb_ld(&bar[XB_TOPGEN]) == tg, bar);
            __builtin_amdgcn_fence(__ATOMIC_ACQUIRE, "agent");
            xb_add(&bar[XB_XGEN(b.x)], 1u);
            asm volatile("s_waitcnt vmcnt(0)" ::: "memory");
        } else {
            XB_SPIN(xb_ld(&bar[XB_XGEN(b.x)]) == gen, bar);
            __builtin_amdgcn_fence(__ATOMIC_ACQUIRE, "agent");
            asm volatile("s_waitcnt vmcnt(0)" ::: "memory");
        }
    }
    __syncthreads();
}

#define XL_RANK(j) (3520 + 64 * (j))
#define XL_CNT(j)  (4608 + 64 * (j))
__device__ __forceinline__ unsigned l2_fetch_add(unsigned* p, unsigned v) {
    unsigned r; asm volatile("global_atomic_add %0, %1, %2, off sc0\n\ts_waitcnt vmcnt(0)" : "=&v"(r) : "v"(p), "v"(v) : "memory"); return r;
}
__device__ __forceinline__ void local_barrier(unsigned* ctl, unsigned x) {
    asm volatile("s_waitcnt vmcnt(0)" ::: "memory");
    __syncthreads();
    if (threadIdx.x == 0) {
        __builtin_amdgcn_s_waitcnt(0);
        unsigned* cw = &ctl[XL_CNT(x)];
        const unsigned old = l2_fetch_add(cw, 1u), target = (old / 32u + 1u) * 32u;
        unsigned sp = 0;
        while (l2_fetch_add(cw, 0u) < target) {
            __builtin_amdgcn_s_sleep(1);
            if ((++sp & 255u) == 0u) { if (xb_ld(&ctl[XB_TMO])) break; if (sp > XB_SPIN_CAP) { atomicAdd(&ctl[XB_TMO], 1u); break; } } }
        __builtin_amdgcn_fence(__ATOMIC_ACQUIRE, "agent");
        asm volatile("s_waitcnt vmcnt(0)" ::: "memory");
    }
    __syncthreads();
}

constexpr int LDS_BYTES = 152576;
__global__ void __launch_bounds__(512, 2) fwd(Args a) {
    extern __shared__ __attribute__((aligned(16))) unsigned char lds_raw[];
    LAS unsigned char* lds = (LAS unsigned char*)lds_raw;
    cg::grid_group grid = cg::this_grid();
    const int G = gridDim.x;
    const int vcu0 = (G % 8 == 0) ? ((int)blockIdx.x % 8) * (G / 8) + (int)blockIdx.x / 8 : (int)blockIdx.x;
    unsigned char* ws = a.ws;
    unsigned* ctl = (unsigned*)(ws + WS_CTL);
    bf16_t* XB = (bf16_t*)(ws + WS_XB); bf16_t* ACT = (bf16_t*)(ws + WS_A); float* P = (float*)(ws + WS_SSQ); float* CS = (float*)(ws + WS_ROPE);

    LAS float* RT = (LAS float*)(lds + 149760);
    volatile LAS unsigned* BST = (volatile LAS unsigned*)(lds + 149760 + 2048);
    const unsigned xcc = xb_xcc_id();
    if (threadIdx.x == 0) { BST[0] = 0u; BST[1] = 0u; BST[2] = xb_add(&ctl[XL_RANK(xcc)], 1u); BST[3] = 0u; }
    __syncthreads();
    const XcdBarrier bar = xcd_barrier_post(ctl, BST);
    if (a.never) grid.sync();
    prologue(a, lds, vcu0, G);
    xcd_barrier(bar);
    if (threadIdx.x == 0) {
        bool ok = (G == 256);
        for (unsigned j = 0; j < 16; ++j) { const unsigned cnt = xb_ld(&ctl[XB_XCNT(j)]); ok = ok && (cnt == (j < 8 ? 32u : 0u)); }
        BST[3] = (ok && xb_ld(&ctl[XB_TMO]) == 0u) ? 1u : 0u;
    }
    __syncthreads();
    const bool local = BST[3] != 0u;
    const int rank = (int)BST[2];
    const int bx = local ? rank * 8 + (int)xcc : (int)blockIdx.x;
    const int wv0 = local ? rank * 8 : vcu0 * 8, nwv = local ? 256 : G * 8, tok0 = local ? (int)xcc * SEQ : 0, ntok = local ? SEQ : M;
#define SEAM() do { if (local) local_barrier(ctl, xcc); else xcd_barrier(bar); } while (0)
    for (int st = 0; st < 3 * DEPTH; ++st) {
        const int l = st / 3, kind = st % 3;
        unsigned char* wl = ws + WS_W + (size_t)l * LW_SIZE;
        asm volatile("" : "+s"(wl));
        if (kind != 1) {
            const bf16_t* Wgu = (const bf16_t*)(wl + (kind ? LW_GU2 : LW_GU1)); const bf16_t* Wd = (const bf16_t*)(wl + (kind ? LW_D2 : LW_D1));
            { pg8::Gemm g{XB, Wgu, M, NGU, DM}; epi::RinvOrder<pg8::StaticOrder> S; S.init(M, NGU, G, bx); S.P = P; S.tab = RT;
              const int nfull = S.nwg / G; const bool split = false && (S.nwg - nfull * G) * 2 == G && (G % 16 == 0);
              if (split) S.imax = nfull;
              { epi::EpiSwiGLU<2> E{ACT, RT}; pg8::gemm_phase<epi::EpiSwiGLU<2>, epi::RinvOrder<pg8::StaticOrder>, true, true>(lds, g, S, E); }
              if (split) { epi::RinvOrder<pg8::HalfOrder> H; H.init(M, NGU, G, bx); H.nfull = nfull; H.P = P; H.tab = RT; epi::EpiSwiGLU<1> E{ACT, RT};
                pg8::gemm_phase<epi::EpiSwiGLU<1>, epi::RinvOrder<pg8::HalfOrder>, true, true, true>(lds, g, H, E); } }
            SEAM();
            { pg8::Gemm g{ACT, Wd, M, DM, DFF}; pg8::StaticOrder S; S.init(M, DM, G, bx); epi::EpiResid E{st == 0 ? a.x : nullptr, XB, P, 0.5f};
              pg8::gemm_phase<epi::EpiResid, pg8::StaticOrder, true, true>(lds, g, S, E); }
            SEAM();
        } else {
            { pg8::Gemm g{XB, (const bf16_t*)(wl + LW_IN), M, NIN, DM}; epi::RinvOrder<pg8::StaticOrder> S; S.init(M, NIN, G, bx); S.P = P; S.tab = RT; const int bb = bx & 7;
              const int nfull = S.nwg / G; const bool split = false && (S.nwg - nfull * G) * 2 == G && (G % 16 == 0);
              if (split) S.imax = nfull;
              bf16_t* vp_ = (bf16_t*)(ws + off_vp(bb)); bf16_t* q_ = (bf16_t*)(ws + off_q(bb)); bf16_t* k_ = (bf16_t*)(ws + off_k(bb)); bf16_t* v_ = (bf16_t*)(ws + off_v(bb));
              { epi::EpiProj<2> E{vp_, q_, k_, v_, RT, CS}; pg8::gemm_phase<epi::EpiProj<2>, epi::RinvOrder<pg8::StaticOrder>, true, true>(lds, g, S, E); }
              if (split) { epi::RinvOrder<pg8::HalfOrder> H; H.init(M, NIN, G, bx); H.nfull = nfull; H.P = P; H.tab = RT; epi::EpiProj<1> E{vp_, q_, k_, v_, RT, CS};
                pg8::gemm_phase<epi::EpiProj<1>, epi::RinvOrder<pg8::HalfOrder>, true, true, true>(lds, g, H, E); } }
            SEAM();
            if (local) att::phase(lds, ws, (unsigned char*)a.out, (int)xcc * NH * 24 + rank, 32, ((int)xcc + 1) * NH * 24); else att::phase(lds, ws, (unsigned char*)a.out, bx, G, BATCH * NH * 24);
            SEAM();
            combine_phase(a, wv0, nwv, tok0, ntok);
            SEAM();
            { pg8::Gemm g{(const bf16_t*)(ws + off_mix(bx & 7)), (const bf16_t*)(wl + LW_OUT), M, DM, DM}; pg8::StaticOrder S; S.init(M, DM, G, bx); epi::EpiResid E{nullptr, XB, P, 1.0f};
              pg8::gemm_phase<epi::EpiResid, pg8::StaticOrder, true, true>(lds, g, S, E); }
            SEAM();
        }
    }
    final_norm(a, wv0, nwv, tok0, ntok);
}

extern "C" void kernel_launch(void* const* d_in, const int* in_sizes, int n_in, void* d_out, int out_size, void* d_ws, size_t ws_size, hipStream_t stream) {
    static int grid = 0;
    if (grid == 0) {
        if (n_in != 16 || in_sizes[0] != M * DM || out_size != M * DM || ws_size < WS_END) { fprintf(stderr, "kernel_launch: unexpected shapes (n_in %d in0 %d out %d ws %zu)\n", n_in, n_in > 0 ? in_sizes[0] : -1, out_size, ws_size); grid = -1; return; }
        int dev = 0, cus = 0, per_cu = 0;
        if (hipGetDevice(&dev) != hipSuccess || hipDeviceGetAttribute(&cus, hipDeviceAttributeMultiprocessorCount, dev) != hipSuccess) { grid = -1; return; }
        if (hipFuncSetAttribute((const void*)fwd, hipFuncAttributeMaxDynamicSharedMemorySize, LDS_BYTES) != hipSuccess) { fprintf(stderr, "kernel_launch: hipFuncSetAttribute failed\n"); grid = -1; return; }
        if (hipOccupancyMaxActiveBlocksPerMultiprocessor(&per_cu, (const void*)fwd, 512, LDS_BYTES) != hipSuccess || per_cu < 1) fprintf(stderr, "kernel_launch: occupancy query says %d\n", per_cu);
        (void)hipGetLastError();
        grid = cus;
    }
    if (grid < 0) return;
    if (hipMemsetAsync((char*)d_ws + WS_CTL, 0, CTL_BYTES, stream) != hipSuccess) { fprintf(stderr, "kernel_launch: memset failed\n"); return; }
    Args a{};
    a.x = (const float*)d_in[0]; a.pos = (const int*)d_in[1];
    a.n1 = (const float*)d_in[2]; a.g1 = (const float*)d_in[3]; a.u1 = (const float*)d_in[4]; a.d1 = (const float*)d_in[5];
    a.nm = (const float*)d_in[6]; a.win = (const float*)d_in[7]; a.pw = (const float*)d_in[8]; a.ps = (const float*)d_in[9]; a.wout = (const float*)d_in[10];
    a.n2 = (const float*)d_in[11]; a.g2 = (const float*)d_in[12]; a.u2 = (const float*)d_in[13]; a.d2 = (const float*)d_in[14]; a.nf = (const float*)d_in[15];
    a.out = (float*)d_out; a.ws = (unsigned char*)d_ws;
    for (int i = 0; i < 8; ++i) a.inv_freq[i] = (float)pow(500000.0, -(double)i / 8.0);
    void* args[] = {&a};
    hipError_t e = hipLaunchCooperativeKernel((const void*)fwd, dim3(grid), dim3(512), args, LDS_BYTES, stream);
    if (e != hipSuccess) fprintf(stderr, "cooperative launch failed: %s (grid %d)\n", hipGetErrorString(e), grid);
}
```

```cpp
#include <hip/hip_runtime.h>
#include <hip/hip_cooperative_groups.h>
#include <cstdio>
#include <cstdint>
#include <cmath>
namespace cg = cooperative_groups;
namespace pg8 {
#define PG8_LAS __attribute__((address_space(3)))
typedef unsigned short bf16_t;
typedef short bf16x8 __attribute__((ext_vector_type(8)));
typedef float f32x4 __attribute__((ext_vector_type(4)));
typedef unsigned u32x4 __attribute__((ext_vector_type(4)));
constexpr int BM = 256, BK = 64, HALF = 128, HTB = HALF * BK * 2  , STAGE_BYTES = 8 * HTB, NXCD = 8, WGM = 8;

__host__ __device__ __forceinline__ int lds_byte(int r, int c) { const int st = (r >> 4) * 2 + (c >> 5), rr = r & 15, cc = c & 31, ob = rr * 64 + cc * 2; return st * 1024 + (ob ^ (((ob >> 9) & 1) << 5)); }
__host__ __device__ __forceinline__ void stage_rc(int b, int& R, int& C) { const int st = b / 1024, sb = b % 1024, swz = sb ^ (((sb >> 9) & 1) << 5); R = (st >> 1) * 16 + swz / 64; C = (st & 1) * 32 + (swz % 64) / 2; }
__host__ __device__ __forceinline__ int perm32(int rho) { const int n = rho >> 4, i = rho & 15; return 8 * (i >> 2) + 4 * n + (i & 3); }

struct Unit { int pm, pn, par, roff; };
struct Gemm { const bf16_t* A; const bf16_t* Bt; int M, N, K, nkt; };

struct StaticOrder {
    int nM, nN, nwg, G, c, imax;
    __host__ __device__ void init(int M, int N, int G_, int c_) { nM = M / BM; nN = N / BM; nwg = nM * nN; G = G_; c = c_; imax = 1 << 30; }
    __host__ __device__ void decode(long L, Unit& u) const {
        int wgid = (int)L; { const int q = nwg / NXCD, r = nwg % NXCD, xcd = wgid % NXCD, off = wgid / NXCD; wgid = (xcd < r ? xcd * (q + 1) : r * (q + 1) + (xcd - r) * q) + off; }
        const int nig = WGM * nN, gid = wgid / nig, fm = gid * WGM, gsz = (nM - fm) < WGM ? (nM - fm) : WGM;
        u.pm = fm + ((wgid % nig) % gsz); u.pn = (wgid % nig) / gsz;
    }
    __host__ __device__ bool next(int i, Unit& u) const {
        const long L = (long)i * G + c; if (i >= imax || L >= nwg) return false;
        decode(L, u); u.par = i & 1; u.roff = 0; return true;
    }
    __device__ __forceinline__ void a_ready(const Unit&) const {}
    __device__ __forceinline__ void done(const Unit&) const {}
};
struct HalfOrder : StaticOrder {
    int nfull;
    __host__ __device__ bool next(int i, Unit& u) const {
        if (i != 0) return false;
        const int xcd = c % NXCD, rho = c / NXCD; const long L = ((long)nfull * (G / NXCD) + (rho >> 1)) * NXCD + xcd; if (L >= nwg) return false;
        decode(L, u); u.par = 0; u.roff = 0; return true;
    }
};
__device__ __forceinline__ unsigned cvt_pk_bf16(float lo, float hi) { unsigned r; asm volatile("v_cvt_pk_bf16_f32 %0, %1, %2" : "=v"(r) : "v"(lo), "v"(hi)); return r; }
template <class Epi, class Sched, bool ALIGN_EPI = false, bool SP2 = false, bool HALFM = false>
__device__ __forceinline__ void gemm_phase(PG8_LAS unsigned char* lds, const Gemm g, const Sched& S, const Epi& E) {
    int tid_ = threadIdx.x; asm volatile("" : "+v"(tid_));
    const int tid = tid_, wid = __builtin_amdgcn_readfirstlane(tid >> 6), lane = tid & 63, wr = wid >> 2, wc = wid & 3, fr = lane & 15, fq = lane >> 4;
    static_assert(!HALFM || SP2, "HALFM is written for the SP2 loop");
    const int K = g.K, nt = g.nkt ? g.nkt : K / BK;
    unsigned voffA[2], voffB[2];
#pragma unroll
    for (int i = 0; i < 2; ++i) { int R, C; stage_rc(tid * 16 + i * 8192, R, C); const int Rb = Epi::PERM ? ((R & ~31) + perm32(R & 31)) : R;
        voffA[i] = (unsigned)(R * K + C) * 2u; voffB[i] = (unsigned)(Rb * K + C) * 2u; }
    const size_t kstep = (size_t)(BK * 2);
    const size_t hstep = (size_t)HALF * K * 2;
    const size_t tstep = 2 * hstep;
    const unsigned ldsw = (unsigned)wid * 1024u;
    const int aoff = lds_byte(wr * 64 + fr, fq * 8), boff = lds_byte(wc * 32 + fr, fq * 8);
#define PG8_SA(b, h) (((b) * 2 + (h)) * HTB)
#define PG8_SB(b, h) ((4 + (b) * 2 + (h)) * HTB)
#define PG8_STAGE(bufoff, gbase, voff) do { _Pragma("unroll") for (int _i = 0; _i < 2; ++_i) \
        __builtin_amdgcn_global_load_lds((const unsigned*)((const char*)(gbase) + (voff)[_i]), (PG8_LAS unsigned*)(lds + (bufoff) + ldsw + _i * 8192), 16, 0, 0); } while (0)
#define PG8_LDA(dst, b, h) do { _Pragma("unroll") for (int m = 0; m < 4; ++m) _Pragma("unroll") for (int k = 0; k < 2; ++k) dst[m][k] = *(const PG8_LAS bf16x8*)(lds + PG8_SA(b, h) + aoff + m * 2048 + k * 1024); } while (0)
#define PG8_LDB(dst, b, h) do { _Pragma("unroll") for (int n = 0; n < 2; ++n) _Pragma("unroll") for (int k = 0; k < 2; ++k) dst[n][k] = *(const PG8_LAS bf16x8*)(lds + PG8_SB(b, h) + boff + n * 2048 + k * 1024); } while (0)
#define PG8_MMA(ai, bj, At, Bt) do { __builtin_amdgcn_s_setprio(1); _Pragma("unroll") for (int m = 0; m < 4; ++m) _Pragma("unroll") for (int n = 0; n < 2; ++n) _Pragma("unroll") for (int k = 0; k < 2; ++k) \
        acc[ai][bj][m][n] = __builtin_amdgcn_mfma_f32_16x16x32_bf16(Bt[n][k], At[m][k], acc[ai][bj][m][n], 0, 0, 0); __builtin_amdgcn_s_setprio(0); } while (0)
#define PG8_WAIT_V(n) asm volatile("s_waitcnt vmcnt(" #n ")" ::: "memory")
#define PG8_WAIT_L(n) asm volatile("s_waitcnt lgkmcnt(" #n ")" ::: "memory")
#define PG8_BAR __builtin_amdgcn_s_barrier()
#define PG8_SCHED __builtin_amdgcn_sched_barrier(0)
    Unit cur, nxt; int ui = 0;
    if (!S.next(0, cur)) return;
    f32x4 acc[2][2][4][2];
#pragma unroll
    for (int a = 0; a < 2; ++a)
#pragma unroll
        for (int b = 0; b < 2; ++b)
#pragma unroll
            for (int m = 0; m < 4; ++m)
#pragma unroll
                for (int n = 0; n < 2; ++n) acc[a][b][m][n] = (f32x4){0.f, 0.f, 0.f, 0.f};
    bf16x8 At[4][2], B0[2][2], B1[2][2];
    const char* cA = (const char*)g.A + (size_t)cur.pm * tstep + (size_t)cur.roff * K * 2; const char* cB = (const char*)g.Bt + (size_t)cur.pn * tstep;
    S.a_ready(cur);
    if constexpr (SP2) {
        PG8_STAGE(PG8_SB(0, 0), cB, voffB); PG8_STAGE(PG8_SB(0, 1), cB + hstep, voffB); PG8_STAGE(PG8_SA(0, 0), cA, voffA); PG8_STAGE(PG8_SA(0, 1), cA + hstep, voffA);
        if (wr == 1) PG8_BAR;
        PG8_WAIT_V(2); PG8_BAR;
        PG8_STAGE(PG8_SB(1, 0), cB + kstep, voffB); PG8_STAGE(PG8_SA(1, 0), cA + kstep, voffA); PG8_STAGE(PG8_SB(1, 1), cB + hstep + kstep, voffB);
        PG8_WAIT_V(6); PG8_BAR;
    } else {
        PG8_STAGE(PG8_SB(0, 0), cB, voffB); PG8_STAGE(PG8_SA(0, 0), cA, voffA); PG8_STAGE(PG8_SB(0, 1), cB + hstep, voffB); PG8_STAGE(PG8_SA(0, 1), cA + hstep, voffA);
        if (wr == 1) PG8_BAR;
        PG8_WAIT_V(4); PG8_BAR;
        PG8_STAGE(PG8_SB(1, 0), cB + kstep, voffB); PG8_STAGE(PG8_SA(1, 0), cA + kstep, voffA); PG8_STAGE(PG8_SB(1, 1), cB + hstep + kstep, voffB);
        PG8_WAIT_V(6); PG8_BAR;
    }
    for (;;) {
        const bool has_next = S.next(ui + 1, nxt);
        const char* nA = has_next ? (const char*)g.A + (size_t)nxt.pm * tstep + (size_t)nxt.roff * K * 2 : cA; const char* nB = has_next ? (const char*)g.Bt + (size_t)nxt.pn * tstep : cB;
        for (int t = 0; t < nt; t += 2) {
            const bool last = (t == nt - 2);
            const char* a1 = cA + (size_t)(t + 1) * kstep;
            const char* a2 = last ? nA : cA + (size_t)(t + 2) * kstep; const char* b2 = last ? nB : cB + (size_t)(t + 2) * kstep;
            const char* a3 = a2 + kstep; const char* b3 = b2 + kstep;
            if (last && has_next) S.a_ready(nxt);
            if constexpr (SP2) {
            PG8_LDB(B0, 0, 0); PG8_LDB(B1, 0, 1); PG8_SCHED; PG8_LDA(At, 0, 0); PG8_STAGE(PG8_SA(1, 1), a1 + hstep, voffA);
            PG8_WAIT_V(8); PG8_WAIT_L(0); PG8_BAR; PG8_MMA(0, 0, At, B0); PG8_MMA(0, 1, At, B1); PG8_BAR; PG8_SCHED;
            if constexpr (!HALFM) PG8_LDA(At, 0, 1); PG8_STAGE(PG8_SB(0, 0), b2, voffB); PG8_STAGE(PG8_SB(0, 1), b2 + hstep, voffB); PG8_STAGE(PG8_SA(0, 0), a2, voffA);
            PG8_WAIT_V(8); PG8_WAIT_L(0); PG8_BAR; if constexpr (!HALFM) { PG8_MMA(1, 0, At, B0); PG8_MMA(1, 1, At, B1); } PG8_BAR; PG8_SCHED;
            PG8_LDB(B0, 1, 0); PG8_LDB(B1, 1, 1); PG8_SCHED; PG8_LDA(At, 1, 0); PG8_STAGE(PG8_SA(0, 1), a2 + hstep, voffA);
            PG8_WAIT_V(8); PG8_WAIT_L(0); PG8_BAR; PG8_MMA(0, 0, At, B0); PG8_MMA(0, 1, At, B1); PG8_BAR; PG8_SCHED;
            if constexpr (!HALFM) PG8_LDA(At, 1, 1); PG8_STAGE(PG8_SB(1, 0), b3, voffB); PG8_STAGE(PG8_SB(1, 1), b3 + hstep, voffB); PG8_STAGE(PG8_SA(1, 0), a3, voffA);
            PG8_WAIT_V(8); PG8_WAIT_L(0); PG8_BAR; if constexpr (!HALFM) { PG8_MMA(1, 0, At, B0); PG8_MMA(1, 1, At, B1); } PG8_BAR; PG8_SCHED;
            } else {
            PG8_LDB(B0, 0, 0); PG8_SCHED; PG8_LDA(At, 0, 0); PG8_STAGE(PG8_SA(1, 1), a1 + hstep, voffA);
            PG8_WAIT_L(8); PG8_BAR; PG8_WAIT_L(0); PG8_MMA(0, 0, At, B0); PG8_BAR; PG8_SCHED;
            PG8_LDB(B1, 0, 1); PG8_STAGE(PG8_SB(0, 0), b2, voffB);
            PG8_BAR; PG8_WAIT_L(0); PG8_MMA(0, 1, At, B1); PG8_BAR;
            PG8_LDA(At, 0, 1); PG8_STAGE(PG8_SA(0, 0), a2, voffA);
            PG8_BAR; PG8_WAIT_L(0); PG8_MMA(1, 0, At, B0); PG8_BAR; PG8_SCHED;
            PG8_STAGE(PG8_SB(0, 1), b2 + hstep, voffB);
            PG8_WAIT_V(6); PG8_BAR; PG8_MMA(1, 1, At, B1); PG8_BAR;
            PG8_LDB(B0, 1, 0); PG8_SCHED; PG8_LDA(At, 1, 0); PG8_STAGE(PG8_SA(0, 1), a2 + hstep, voffA);
            PG8_WAIT_L(8); PG8_BAR; PG8_WAIT_L(0); PG8_MMA(0, 0, At, B0); PG8_BAR; PG8_SCHED;
            PG8_LDB(B1, 1, 1); PG8_STAGE(PG8_SB(1, 0), b3, voffB);
            PG8_BAR; PG8_WAIT_L(0); PG8_MMA(0, 1, At, B1); PG8_BAR;
            PG8_LDA(At, 1, 1); PG8_STAGE(PG8_SA(1, 0), a3, voffA);
            PG8_BAR; PG8_WAIT_L(0); PG8_MMA(1, 0, At, B0); PG8_BAR; PG8_SCHED;
            PG8_STAGE(PG8_SB(1, 1), b3 + hstep, voffB);
            PG8_WAIT_V(6); PG8_BAR; PG8_MMA(1, 1, At, B1); PG8_BAR;
            }
        }
        if constexpr (ALIGN_EPI) { if (wr == 0) PG8_BAR; }
        if constexpr (!Epi::AFTER_DRAIN) { E(acc, cur, wr, wc, fr, fq); S.done(cur); }
        if (!has_next) break;
#pragma unroll
        for (int a = 0; a < 2; ++a)
#pragma unroll
            for (int b = 0; b < 2; ++b)
#pragma unroll
                for (int m = 0; m < 4; ++m)
#pragma unroll
                    for (int n = 0; n < 2; ++n) acc[a][b][m][n] = (f32x4){0.f, 0.f, 0.f, 0.f};
        cur = nxt; cA = nA; cB = nB; ++ui;
        if constexpr (ALIGN_EPI) { if (wr == 1) PG8_BAR; }
    }
    PG8_WAIT_V(0);
    if constexpr (!ALIGN_EPI) { if (wr == 0) PG8_BAR; }
    PG8_BAR;
    if constexpr (Epi::AFTER_DRAIN) { E.fused(acc, cur, wr, wc, fr, fq, lds, wid, lane); S.done(cur); }
#undef PG8_SA
#undef PG8_SB
#undef PG8_STAGE
#undef PG8_LDA
#undef PG8_LDB
#undef PG8_MMA
#undef PG8_WAIT_V
#undef PG8_WAIT_L
#undef PG8_BAR
#undef PG8_SCHED
}
}

constexpr int DM = 1024, BATCH = 8, SEQ = 2048, DEPTH = 4, M = BATCH * SEQ;
constexpr int DFF = 2816, NGU = 2 * DFF, NIN = 2560, AW = 768, PWD = 256, NH = 12, HD = 64;
constexpr float NORM_EPS = 1e-6f;
constexpr float QSCALE = 0.125f * 1.4426950408889634f;

#define GAS __attribute__((address_space(1)))
#define LAS __attribute__((address_space(3)))
typedef unsigned short bf16_t;
typedef unsigned u32x4 __attribute__((ext_vector_type(4)));
typedef unsigned u32x2 __attribute__((ext_vector_type(2)));
typedef float f32x4 __attribute__((ext_vector_type(4)));
typedef float f32x16 __attribute__((ext_vector_type(16)));
typedef short bf16x8 __attribute__((ext_vector_type(8)));
typedef short s16x4 __attribute__((ext_vector_type(4)));

constexpr size_t MiB = 1u << 20;
constexpr size_t W_GU = (size_t)NGU * DM * 2, W_D = (size_t)DM * DFF * 2, W_IN = (size_t)NIN * DM * 2, W_OUT = (size_t)DM * DM * 2;
constexpr size_t LW_GU1 = 0, LW_D1 = LW_GU1 + W_GU, LW_IN = LW_D1 + W_D, LW_OUT = LW_IN + W_IN, LW_GU2 = LW_OUT + W_OUT, LW_D2 = LW_GU2 + W_GU, LW_SIZE = LW_D2 + W_D;
static_assert(LW_SIZE == 40 * MiB, "per-layer weight block");
constexpr size_t WS_W = 0;
constexpr size_t WS_XB = 160 * MiB;
constexpr size_t WS_A = 192 * MiB;
__host__ __device__ constexpr size_t off_q(int b) { return WS_A + (size_t)b * 8 * MiB; }
__host__ __device__ constexpr size_t off_vp(int b) { return WS_A + 4 * MiB + (size_t)b * 10 * MiB; }
__host__ __device__ constexpr size_t off_k(int b) { return WS_A + 5 * MiB + (size_t)b * 8 * MiB; }
__host__ __device__ constexpr size_t off_v(int b) { return WS_A + 8 * MiB + (size_t)b * 8 * MiB; }
__host__ __device__ constexpr size_t off_mix(int b) { return WS_A + (size_t)b * 7 * MiB; }
constexpr size_t WS_O = 280 * MiB;
constexpr size_t WS_MIXN = 328 * MiB;
constexpr size_t WS_STAT = 360 * MiB;
constexpr size_t WS_SSQ = 365 * MiB;
constexpr size_t WS_ROPE = 366 * MiB;
constexpr size_t WS_CTL = 367 * MiB, CTL_BYTES = 32768;
constexpr size_t WS_END = 368 * MiB;
__device__ __forceinline__ bf16_t* o_base(unsigned char* ws, unsigned char* dout, int br, int b) { return br < 2 ? (bf16_t*)(ws + WS_O) + (size_t)br * M * AW : (bf16_t*)(dout + (size_t)b * 5 * MiB); }
static_assert((size_t)M * DFF * 2 <= 88 * MiB && (size_t)3 * M * NH * 2 * 4 <= 5 * MiB, "ws map");

struct Args {
    const float* x; const int* pos;
    const float *n1, *g1, *u1, *d1, *nm, *win, *pw, *ps, *wout, *n2, *g2, *u2, *d2, *nf;
    float* out; unsigned char* ws;
    float inv_freq[8];
    int never, pad;
};

namespace epi {
using pg8::Unit; using pg8::BM; using pg8::HALF;
__device__ __forceinline__ float rinv_of(const float* P, int row) {
    const f32x4* p = (const f32x4*)(P + (size_t)row * 16);
    const f32x4 a = p[0], b = p[1], c = p[2], d = p[3];
    const float s = ((a[0] + a[1]) + (a[2] + a[3])) + ((b[0] + b[1]) + (b[2] + b[3])) + ((c[0] + c[1]) + (c[2] + c[3])) + ((d[0] + d[1]) + (d[2] + d[3]));
    return __builtin_amdgcn_rsqf(s * (1.0f / DM) + NORM_EPS);
}
template <class Base> struct RinvOrder : Base {
    const float* P; LAS float* tab;
    __device__ __forceinline__ void a_ready(const Unit& u) const { int t = threadIdx.x; asm volatile("" : "+v"(t)); if (t < 256 - u.roff) tab[u.par * 256 + t] = rinv_of(P, u.pm * BM + u.roff + t); }
};
__device__ __forceinline__ float silu_mul(float g, float u) {
    const float e = __builtin_amdgcn_exp2f(-1.4426950408889634f * g);
    return g * __builtin_amdgcn_rcpf(1.0f + e) * u;
}
template <int NAI> struct EpiSwiGLU {
    static constexpr bool PERM = true, AFTER_DRAIN = false;
    bf16_t* O; const LAS float* tab;
    __device__ __forceinline__ void operator()(const f32x4 (&acc)[2][2][4][2], const Unit& u, int wr, int wc, int fr, int fq) const {
        const int row0 = u.pm * BM + u.roff + wr * 64 + fr, col0 = u.pn * HALF + wc * 32 + 8 * fq;
#pragma unroll
        for (int ai = 0; ai < NAI; ++ai)
#pragma unroll
            for (int m = 0; m < 4; ++m) {
                const int row = row0 + ai * HALF + m * 16; const float ri = tab[u.par * 256 + ai * HALF + wr * 64 + m * 16 + fr];
                const f32x4 g0 = acc[ai][0][m][0] * ri, g1 = acc[ai][0][m][1] * ri, u0 = acc[ai][1][m][0] * ri, u1 = acc[ai][1][m][1] * ri;
                u32x4 w;
                w.x = pg8::cvt_pk_bf16(silu_mul(g0[0], u0[0]), silu_mul(g0[1], u0[1])); w.y = pg8::cvt_pk_bf16(silu_mul(g0[2], u0[2]), silu_mul(g0[3], u0[3]));
                w.z = pg8::cvt_pk_bf16(silu_mul(g1[0], u1[0]), silu_mul(g1[1], u1[1])); w.w = pg8::cvt_pk_bf16(silu_mul(g1[2], u1[2]), silu_mul(g1[3], u1[3]));
                *(u32x4*)(O + (size_t)row * DFF + col0) = w;
                if (m & 1) asm volatile("" ::: "memory");
            }
    }
};
struct EpiResid {
    static constexpr bool PERM = true, AFTER_DRAIN = false;
    const float* X0; bf16_t* XH; float* P; float scale;
    __device__ __forceinline__ void operator()(const f32x4 (&acc)[2][2][4][2], const Unit& u, int wr, int wc, int fr, int fq) const {
        const int row0 = u.pm * BM + wr * 64 + fr, col0 = u.pn * BM + wc * 32 + 8 * fq;
        if (X0) {
#pragma unroll
            for (int g2 = 0; g2 < 4; ++g2) {
                const int ai = g2 >> 1;
                f32x4 xa[2][2][2];
#pragma unroll
                for (int mm = 0; mm < 2; ++mm)
#pragma unroll
                    for (int bj = 0; bj < 2; ++bj) { const float* xp = X0 + (size_t)(row0 + ai * HALF + ((g2 & 1) * 2 + mm) * 16) * DM + col0 + bj * HALF; xa[mm][bj][0] = *(const f32x4*)xp; xa[mm][bj][1] = *(const f32x4*)(xp + 4); }
#pragma unroll
                for (int mm = 0; mm < 2; ++mm) { const int m = (g2 & 1) * 2 + mm; row_out(acc, u, ai, m, row0 + ai * HALF + m * 16, col0, wc, fq, xa[mm][0][0], xa[mm][0][1], xa[mm][1][0], xa[mm][1][1]); }
                asm volatile("" ::: "memory");
            }
        } else {
#pragma unroll
            for (int ai = 0; ai < 2; ++ai) {
                u32x4 hh[4][2];
#pragma unroll
                for (int mm = 0; mm < 4; ++mm)
#pragma unroll
                    for (int bj = 0; bj < 2; ++bj) hh[mm][bj] = *(const u32x4*)(XH + (size_t)(row0 + ai * HALF + mm * 16) * DM + col0 + bj * HALF);
#pragma unroll
                for (int m = 0; m < 4; ++m) { const u32x4 h0 = hh[m][0], h1 = hh[m][1];
                    row_out(acc, u, ai, m, row0 + ai * HALF + m * 16, col0, wc, fq,
                            (f32x4){__uint_as_float(h0.x << 16), __uint_as_float(h0.x & 0xffff0000u), __uint_as_float(h0.y << 16), __uint_as_float(h0.y & 0xffff0000u)}, (f32x4){__uint_as_float(h0.z << 16), __uint_as_float(h0.z & 0xffff0000u), __uint_as_float(h0.w << 16), __uint_as_float(h0.w & 0xffff0000u)},
                            (f32x4){__uint_as_float(h1.x << 16), __uint_as_float(h1.x & 0xffff0000u), __uint_as_float(h1.y << 16), __uint_as_float(h1.y & 0xffff0000u)}, (f32x4){__uint_as_float(h1.z << 16), __uint_as_float(h1.z & 0xffff0000u), __uint_as_float(h1.w << 16), __uint_as_float(h1.w & 0xffff0000u)}); }
                asm volatile("" ::: "memory");
            }
        }
    }
    __device__ __forceinline__ void row_out(const f32x4 (&acc)[2][2][4][2], const Unit& u, int ai, int m, int row, int col0, int wc, int fq, f32x4 x00, f32x4 x01, f32x4 x10, f32x4 x11) const {
        float ss = 0.f;
#pragma unroll
        for (int bj = 0; bj < 2; ++bj) {
            const f32x4 a = (bj ? x10 : x00) + acc[ai][bj][m][0] * scale, b = (bj ? x11 : x01) + acc[ai][bj][m][1] * scale;
            u32x4 w; w.x = pg8::cvt_pk_bf16(a[0], a[1]); w.y = pg8::cvt_pk_bf16(a[2], a[3]); w.z = pg8::cvt_pk_bf16(b[0], b[1]); w.w = pg8::cvt_pk_bf16(b[2], b[3]);
            *(u32x4*)(XH + (size_t)row * DM + col0 + bj * HALF) = w;
            ss += (a[0] * a[0] + a[1] * a[1]) + (a[2] * a[2] + a[3] * a[3]) + (b[0] * b[0] + b[1] * b[1]) + (b[2] * b[2] + b[3] * b[3]);
        }
        ss += __shfl_xor(ss, 16); ss += __shfl_xor(ss, 32);
        if (fq == 0) P[(size_t)row * 16 + u.pn * 4 + wc] = ss;
    }
};
template <int NAI> struct EpiProj {
    static constexpr bool PERM = true, AFTER_DRAIN = false;
    bf16_t *VP, *Q, *K, *V; const LAS float* tab; const float* CS;
    __device__ __forceinline__ void operator()(const f32x4 (&acc)[2][2][4][2], const Unit& u, int wr, int wc, int fr, int fq) const {
        const int pn = u.pn;
        bf16_t* dst; int ld, cb;
        if (pn == 0) { dst = VP; ld = PWD; cb = 0; } else if (pn < 4) { dst = Q; ld = AW; cb = (pn - 1) * 256; } else if (pn < 7) { dst = K; ld = AW; cb = (pn - 4) * 256; } else { dst = V; ld = AW; cb = (pn - 7) * 256; }
        const bool ropetile = (pn >= 1 && pn <= 6);
        const bool ropelane = ropetile && !(wc & 1) && (fq < 2);
        const float sgn = (fq == 0) ? -1.f : 1.f;
        const float qs = (pn >= 1 && pn < 4) ? QSCALE : 1.f;
        const int row0 = u.pm * BM + u.roff + wr * 64 + fr, col0 = cb + wc * 32 + 8 * fq;
#pragma unroll
        for (int ai = 0; ai < NAI; ++ai)
#pragma unroll
            for (int m = 0; m < 4; ++m) {
                const int row = row0 + ai * HALF + m * 16; const float ri = tab[u.par * 256 + ai * HALF + wr * 64 + m * 16 + fr];
                f32x4 c0 = {1.f, 1.f, 1.f, 1.f}, c1 = c0, s0 = {0.f, 0.f, 0.f, 0.f}, s1 = s0;
                if (ropelane) { const f32x4* cs = (const f32x4*)(CS + (size_t)row * 16); c0 = cs[0]; c1 = cs[1]; s0 = cs[2]; s1 = cs[3]; }
#pragma unroll
                for (int bj = 0; bj < 2; ++bj) {
                    f32x4 v0 = acc[ai][bj][m][0] * ri, v1 = acc[ai][bj][m][1] * ri;
                    if (ropetile) {
                        f32x4 p0, p1;
#pragma unroll
                        for (int j = 0; j < 4; ++j) { p0[j] = __shfl_xor(v0[j], 16); p1[j] = __shfl_xor(v1[j], 16); }
                        if (ropelane) { v0 = v0 * c0 + p0 * s0 * sgn; v1 = v1 * c1 + p1 * s1 * sgn; }
                    }
                    v0 = v0 * qs; v1 = v1 * qs;
                    u32x4 w; w.x = pg8::cvt_pk_bf16(v0[0], v0[1]); w.y = pg8::cvt_pk_bf16(v0[2], v0[3]); w.z = pg8::cvt_pk_bf16(v1[0], v1[1]); w.w = pg8::cvt_pk_bf16(v1[2], v1[3]);
                    *(u32x4*)(dst + (size_t)row * ld + col0 + bj * HALF) = w;
                }
                if (m & 1) asm volatile("" ::: "memory");
            }
    }
};
}

namespace att {
constexpr int NSLOT = 448, KCS = NSLOT * 16 + 16, VDS = NSLOT * 64 + 64;
constexpr int L_K = 0, L_V = 8 * KCS, L_WS = L_V + 2 * VDS, L_OST = L_WS + 8 * 256, L_END = L_OST + 8 * 4096;
static_assert(L_END <= 149760, "attention LDS");
__device__ __forceinline__ int crow(int r, int hi) { return (r & 3) + 8 * (r >> 2) + 4 * hi; }
__device__ __forceinline__ s16x4 vtr(const LAS unsigned char* p) { return __builtin_bit_cast(s16x4, __builtin_amdgcn_ds_read_tr16_b64_v4i16((LAS s16x4*)p)); }
struct UD { int b, h, br, u; };
template <int MODE> __device__ __forceinline__ UD decode(int j) { UD x; x.u = j & 7; int bh; if (MODE == 1) { bh = j >> 4; x.br = 1 + ((j >> 3) & 1); } else { bh = j >> 3; x.br = 0; } x.b = bh / NH; x.h = bh % NH; return x; }

__device__ __forceinline__ void load_kv(u32x4 (&val)[14], const UD& x, const unsigned char* ws, int tid) {
    const int br = x.br, u = x.u, sub = tid & 15, s0 = tid >> 4;
    const bf16_t* base = (const bf16_t*)(ws + ((sub < 8) ? off_k(x.b) : off_v(x.b))) + (size_t)x.b * SEQ * AW + x.h * HD + (sub & 7) * 8;
    if (br < 2) {
        const int d = (br == 0) ? 1 : 4, L = SEQ / d, T0 = (br == 0) ? 256 * u : 256 * (u & 1), cls = (br == 0) ? 0 : (u >> 1);
        const int k0 = T0 - 64 + s0;
        const bf16_t* p0 = base + ((long)k0 * d + cls) * AW; const long stride = (long)32 * d * AW;
#pragma unroll
        for (int i = 0; i < 14; ++i) { const int key = k0 + 32 * i; val[i] = (u32x4){0u, 0u, 0u, 0u};
            if ((i < 12) && (key >= 0) && (key < L)) val[i] = *(const u32x4*)(p0 + i * stride); }
    } else {
        const bf16_t* pa = base + ((long)(s0 - 64) * 16 + 2 * u) * AW; const bf16_t* pb = base + ((long)s0 * 16 + 2 * u + 1) * AW; const long stride = (long)32 * 16 * AW;
#pragma unroll
        for (int i = 0; i < 14; ++i) { val[i] = (u32x4){0u, 0u, 0u, 0u};
            if (i < 8) { const int key = s0 + 32 * i - 64; if ((key >= 0) && (key < 128)) val[i] = *(const u32x4*)(pa + i * stride); }
            else if (i < 12) val[i] = *(const u32x4*)(pb + (i - 8) * stride); }
    }
}
__device__ __forceinline__ void store_kv(LAS unsigned char* lds, const u32x4 (&val)[14], int tid) {
#pragma unroll
    for (int i = 0; i < 14; ++i) {
        const int piece = tid + 512 * i, slot = piece >> 4, sub = piece & 15;
        const int off = (sub < 8) ? (L_K + sub * KCS + slot * 16) : (L_V + ((sub - 8) >> 2) * VDS + slot * 64 + ((sub - 8) & 3) * 16);
        *(LAS u32x4*)(lds + off) = val[i];
    }
}
__device__ __forceinline__ void wave_geo(const UD& x, int wid, int& d, int& L, int& cls, int& t0, int& sbase) {
    const int br = x.br, u = x.u; d = (br == 0) ? 1 : (br == 1) ? 4 : 16; L = SEQ / d;
    if (br < 2) { const int T0 = (br == 0) ? 256 * u : 256 * (u & 1); cls = (br == 0) ? 0 : (u >> 1); t0 = T0 + 32 * wid; sbase = 32 * wid; }
    else { const int hw = wid >> 2; cls = 2 * u + hw; t0 = 32 * (wid & 3); sbase = 192 * hw + 32 * (wid & 3); }
}
__device__ __forceinline__ void load_q(bf16x8 (&qr)[4], const UD& x, const unsigned char* ws, int wid, int r32, int hi) {
    int d, L, cls, t0, sbase; wave_geo(x, wid, d, L, cls, t0, sbase);
    const bf16_t* Qb = (const bf16_t*)(ws + off_q(x.b));
    const size_t qtok = (size_t)x.b * SEQ + (size_t)(t0 + r32) * d + cls;
#pragma unroll
    for (int d0 = 0; d0 < 4; ++d0) qr[d0] = *(const bf16x8*)(Qb + qtok * AW + x.h * HD + d0 * 16 + hi * 8);
}
__device__ __forceinline__ void compute_a(LAS unsigned char* lds, const UD& x, const bf16x8 (&qr)[4], int wid, int lane, u32x4 (&pw)[10], float& mx_o, float& l_o) {
    const int r32 = lane & 31, hi = lane >> 5;
    int d, L, cls, t0, sbase; wave_geo(x, wid, d, L, cls, t0, sbase);
    f32x16 s[5];
#pragma unroll
    for (int ht = 0; ht < 5; ++ht) {
        const LAS unsigned char* kb = lds + L_K + hi * KCS + (sbase + 32 * ht + r32) * 16;
        f32x16 a = {};
#pragma unroll
        for (int d0 = 0; d0 < 4; ++d0) { const bf16x8 kf = *(const LAS bf16x8*)(kb + d0 * 2 * KCS); a = __builtin_amdgcn_mfma_f32_32x32x16_bf16(kf, qr[d0], a, 0, 0, 0); }
        s[ht] = a;
    }
    {
        const int dq = r32 - 4 * hi;
#pragma unroll
        for (int r = 0; r < 16; ++r) { const int cr = (r & 3) + 8 * (r >> 2); s[0][r] = (cr >= dq) ? s[0][r] : -INFINITY; s[4][r] = (cr <= dq) ? s[4][r] : -INFINITY; }
        if (t0 < 64) {
#pragma unroll
            for (int r = 0; r < 16; ++r) s[0][r] = -INFINITY;
            if (t0 < 32) {
#pragma unroll
                for (int r = 0; r < 16; ++r) s[1][r] = -INFINITY;
            }
        }
        if (t0 + 96 > L) {
#pragma unroll
            for (int r = 0; r < 16; ++r) s[4][r] = -INFINITY;
            if (t0 + 64 > L) {
#pragma unroll
                for (int r = 0; r < 16; ++r) s[3][r] = -INFINITY;
            }
        }
    }
    float mx = s[2][0];
#pragma unroll
    for (int ht = 0; ht < 5; ++ht)
#pragma unroll
        for (int r = 0; r < 16; ++r) mx = fmaxf(mx, s[ht][r]);
    mx = fmaxf(mx, __shfl_xor(mx, 32));
    float lsum = 0.f;
#pragma unroll
    for (int ht = 0; ht < 5; ++ht)
#pragma unroll
        for (int r = 0; r < 16; ++r) { const float p = __builtin_amdgcn_exp2f(s[ht][r] - mx); s[ht][r] = p; lsum += p; }
    lsum += __shfl_xor(lsum, 32);
#pragma unroll
    for (int g = 0; g < 10; ++g) {
        const int ht = g >> 1, rb = (g & 1) * 8;
        pw[g].x = pg8::cvt_pk_bf16(s[ht][rb + 0], s[ht][rb + 1]); pw[g].y = pg8::cvt_pk_bf16(s[ht][rb + 2], s[ht][rb + 3]); pw[g].z = pg8::cvt_pk_bf16(s[ht][rb + 4], s[ht][rb + 5]); pw[g].w = pg8::cvt_pk_bf16(s[ht][rb + 6], s[ht][rb + 7]);
    }
    mx_o = mx; l_o = lsum;
}
template <bool MERGE> __device__ __forceinline__ void compute_b(LAS unsigned char* lds, const UD& x, unsigned char* ws, unsigned char* dout, int wid, int lane, const u32x4 (&pw)[10], float mx, float lsum) {
    const int r32 = lane & 31, hi = lane >> 5;
    int d, L, cls, t0, sbase; wave_geo(x, wid, d, L, cls, t0, sbase);
    const size_t tokb = (size_t)x.b * SEQ;
    const size_t qtok = tokb + (size_t)(t0 + r32) * d + cls;
    f32x16 o[2]; o[0] = f32x16{}; o[1] = f32x16{};
    const int vlane = ((lane >> 4) & 1) * 32 + (lane & 3) * 8 + (4 * hi + ((lane & 15) >> 2)) * 64;
#pragma unroll
    for (int g = 0; g < 10; ++g) {
        const bf16x8 pa = __builtin_bit_cast(bf16x8, pw[g]);
#pragma unroll
        for (int d0 = 0; d0 < 2; ++d0) {
            const LAS unsigned char* vp = lds + L_V + d0 * VDS + (sbase + 16 * g) * 64 + vlane;
            const s16x4 lo = vtr(vp), hh = vtr(vp + 512);
            const bf16x8 vf = (bf16x8){lo[0], lo[1], lo[2], lo[3], hh[0], hh[1], hh[2], hh[3]};
            o[d0] = __builtin_amdgcn_mfma_f32_32x32x16_bf16(pa, vf, o[d0], 0, 0, 0);
        }
    }
    LAS float* wsf = (LAS float*)(lds + L_WS + wid * 256);
    LAS bf16_t* stg = (LAS bf16_t*)(lds + L_OST + wid * 4096);
    if (hi == 0) {
        wsf[r32] = lsum;
        if (MERGE) wsf[32 + r32] = mx;
        else { float* st = (float*)(ws + WS_STAT) + (((size_t)x.br * M + qtok) * NH + x.h) * 2; st[0] = mx; st[1] = lsum; }
    }
    asm volatile("s_waitcnt lgkmcnt(0)" ::: "memory");
#pragma unroll
    for (int r = 0; r < 16; ++r) {
        const int qrow = crow(r, hi); const float rl = __builtin_amdgcn_rcpf(wsf[qrow]);
        const unsigned a = pg8::cvt_pk_bf16(o[0][r] * rl, o[1][r] * rl);
        stg[qrow * 64 + r32] = (bf16_t)(a & 0xffffu); stg[qrow * 64 + 32 + r32] = (bf16_t)(a >> 16);
    }
    asm volatile("s_waitcnt lgkmcnt(0)" ::: "memory");
    if (!MERGE) {
        bf16_t* Ob = o_base(ws, dout, x.br, x.b);
#pragma unroll
        for (int i = 0; i < 4; ++i) {
            const int row = i * 8 + (lane >> 3), ch = lane & 7;
            const u32x4 v = *(const LAS u32x4*)(stg + row * 64 + ch * 8);
            *(u32x4*)(Ob + (tokb + (size_t)(t0 + row) * d + cls) * AW + x.h * HD + ch * 8) = v;
        }
    } else {
        const float* ST = (const float*)(ws + WS_STAT); bf16_t* MIX = (bf16_t*)(ws + WS_MIXN);
#pragma unroll
        for (int i0 = 0; i0 < 4; i0 += 2) {
            u32x4 o1[2], o2[2]; float m1[2], l1[2], m2[2], l2[2];
#pragma unroll
            for (int ii = 0; ii < 2; ++ii) {
                const int row = (i0 + ii) * 8 + (lane >> 3), ch = lane & 7; const size_t tok = tokb + (size_t)(t0 + row);
                const float* s1 = ST + (((size_t)1 * M + tok) * NH + x.h) * 2; const float* s2 = ST + (((size_t)2 * M + tok) * NH + x.h) * 2;
                m1[ii] = s1[0]; l1[ii] = s1[1]; m2[ii] = s2[0]; l2[ii] = s2[1];
                o1[ii] = *(const u32x4*)(o_base(ws, dout, 1, x.b) + tok * AW + x.h * HD + ch * 8); o2[ii] = *(const u32x4*)(o_base(ws, dout, 2, x.b) + tok * AW + x.h * HD + ch * 8);
            }
#pragma unroll
            for (int ii = 0; ii < 2; ++ii) {
                const int row = (i0 + ii) * 8 + (lane >> 3), ch = lane & 7; const size_t tok = tokb + (size_t)(t0 + row);
                const u32x4 v0 = *(const LAS u32x4*)(stg + row * 64 + ch * 8);
                const float m0 = wsf[32 + row], l0 = wsf[row];
                const float mxx = fmaxf(fmaxf(m0, m1[ii]), m2[ii]);
                float w0 = __builtin_amdgcn_exp2f(m0 - mxx) * l0, w1 = __builtin_amdgcn_exp2f(m1[ii] - mxx) * l1[ii], w2 = __builtin_amdgcn_exp2f(m2[ii] - mxx) * l2[ii];
                const float rd = 1.0f / (w0 + w1 + w2); w0 *= rd; w1 *= rd; w2 *= rd;
                const u32x4 a1 = o1[ii], a2 = o2[ii];
                u32x4 w;
                w.x = pg8::cvt_pk_bf16(w0 * __uint_as_float(v0.x << 16) + w1 * __uint_as_float(a1.x << 16) + w2 * __uint_as_float(a2.x << 16), w0 * __uint_as_float(v0.x & 0xffff0000u) + w1 * __uint_as_float(a1.x & 0xffff0000u) + w2 * __uint_as_float(a2.x & 0xffff0000u));
                w.y = pg8::cvt_pk_bf16(w0 * __uint_as_float(v0.y << 16) + w1 * __uint_as_float(a1.y << 16) + w2 * __uint_as_float(a2.y << 16), w0 * __uint_as_float(v0.y & 0xffff0000u) + w1 * __uint_as_float(a1.y & 0xffff0000u) + w2 * __uint_as_float(a2.y & 0xffff0000u));
                w.z = pg8::cvt_pk_bf16(w0 * __uint_as_float(v0.z << 16) + w1 * __uint_as_float(a1.z << 16) + w2 * __uint_as_float(a2.z << 16), w0 * __uint_as_float(v0.z & 0xffff0000u) + w1 * __uint_as_float(a1.z & 0xffff0000u) + w2 * __uint_as_float(a2.z & 0xffff0000u));
                w.w = pg8::cvt_pk_bf16(w0 * __uint_as_float(v0.w << 16) + w1 * __uint_as_float(a1.w << 16) + w2 * __uint_as_float(a2.w << 16), w0 * __uint_as_float(v0.w & 0xffff0000u) + w1 * __uint_as_float(a1.w & 0xffff0000u) + w2 * __uint_as_float(a2.w & 0xffff0000u));
                *(u32x4*)(MIX + tok * DM + PWD + x.h * HD + ch * 8) = w;
            }
        }
        if (x.h < 4) {
            const int g = x.h, hw = 1 << g;
            const bf16_t* VP = (const bf16_t*)(ws + off_vp(x.b));
#pragma unroll 1
            for (int p = 0; p < 8; ++p) {
                const int s = t0 + 4 * p + (lane >> 4);
                const bf16_t* base = VP + tokb * PWD + g * 64 + 4 * (lane & 15);
                float s0 = 0.f, s1 = 0.f, s2 = 0.f, s3 = 0.f; int cnt = 0;
                const u32x2 me = *(const u32x2*)(base + (size_t)s * PWD);
#pragma unroll
                for (int j0 = 0; j0 < 16; j0 += 8) {
                    if (j0 < 2 * hw) {
                        u32x2 vv[8];
#pragma unroll
                        for (int jj = 0; jj < 8; ++jj) { const int j = s - hw + j0 + jj; const bool ok = (j0 + jj < 2 * hw) && (j >= 0) && (j < SEQ);
                            vv[jj] = (u32x2){0u, 0u}; if (ok) vv[jj] = *(const u32x2*)(base + (size_t)j * PWD); cnt += ok ? 1 : 0; }
#pragma unroll
                        for (int jj = 0; jj < 8; ++jj) { s0 += __uint_as_float(vv[jj].x << 16); s1 += __uint_as_float(vv[jj].x & 0xffff0000u); s2 += __uint_as_float(vv[jj].y << 16); s3 += __uint_as_float(vv[jj].y & 0xffff0000u); }
                    }
                }
                const float rc = 1.0f / (float)cnt;
                u32x2 w2; w2.x = pg8::cvt_pk_bf16(s0 * rc - __uint_as_float(me.x << 16), s1 * rc - __uint_as_float(me.x & 0xffff0000u)); w2.y = pg8::cvt_pk_bf16(s2 * rc - __uint_as_float(me.y << 16), s3 * rc - __uint_as_float(me.y & 0xffff0000u));
                *(u32x2*)(MIX + (tokb + (size_t)s) * DM + g * 64 + 4 * (lane & 15)) = w2;
            }
        }
    }
}
template <int MODE> __device__ __forceinline__ void phase(LAS unsigned char* lds, unsigned char* ws, unsigned char* dout, int first, int step, int limit) {
    int tid_ = threadIdx.x; asm volatile("" : "+v"(tid_));
    const int tid = tid_, lane = tid & 63; const int wid = __builtin_amdgcn_readfirstlane(tid >> 6);
    if (first >= limit) return;
    u32x4 val[14];
    load_kv(val, decode<MODE>(first), ws, tid);
    for (int uid = first; uid < limit; uid += step) {
        const UD x = decode<MODE>(uid);
        bf16x8 qr[4]; load_q(qr, x, ws, wid, lane & 31, lane >> 5);
        store_kv(lds, val, tid);
        __syncthreads();
        u32x4 pw[10]; float mx, lsum;
        compute_a(lds, x, qr, wid, lane, pw, mx, lsum);
        if (uid + step < limit) load_kv(val, decode<MODE>(uid + step), ws, tid);
        compute_b<MODE == 2>(lds, x, ws, dout, wid, lane, pw, mx, lsum);
        __syncthreads();
    }
}
}

__device__ __forceinline__ float bf2f(unsigned short h) { return __uint_as_float((unsigned)h << 16); }
__device__ __forceinline__ float wave_sum(float v) {
#pragma unroll
    for (int o = 1; o < 64; o <<= 1) v += __shfl_xor(v, o);
    return v;
}
__device__ __forceinline__ unsigned f2bf(float f) { unsigned u = __float_as_uint(f); return (u + 0x7fffu + ((u >> 16) & 1u)) >> 16; }
__device__ __forceinline__ unsigned pk2(float lo, float hi) { return f2bf(lo) | (f2bf(hi) << 16); }

struct TrItem { const float* W; const float* gain; bf16_t* WT; int N, k0, n0, ldw, drow0; };
__device__ __forceinline__ void tr_load(f32x4 (&v)[16], const TrItem& t, int lane) {
    const int kr = lane >> 4, nc = 4 * (lane & 15);
#pragma unroll
    for (int i = 0; i < 16; ++i) v[i] = *(const f32x4*)(t.W + (size_t)(t.k0 + 4 * i + kr) * t.N + t.n0 + nc);
}
__device__ __forceinline__ void tr_finish(const f32x4 (&v)[16], const TrItem& t, LAS float* scr, int lane) {
    const int kr = lane >> 4, nc = 4 * (lane & 15);
#pragma unroll
    for (int i = 0; i < 16; ++i) { const int kk = 4 * i + kr; const float gg = t.gain ? t.gain[t.k0 + kk] : 1.f; LAS float* s = scr + kk * 65 + nc;
        s[0] = v[i][0] * gg; s[1] = v[i][1] * gg; s[2] = v[i][2] * gg; s[3] = v[i][3] * gg; }
    asm volatile("s_waitcnt lgkmcnt(0)" ::: "memory");
    const int c = lane & 7;
#pragma unroll
    for (int j = 0; j < 8; ++j) { const int n = (lane >> 3) + 8 * j; const LAS float* s = scr + (8 * c) * 65 + n;
        u32x4 o; o.x = pk2(s[0 * 65], s[1 * 65]); o.y = pk2(s[2 * 65], s[3 * 65]); o.z = pk2(s[4 * 65], s[5 * 65]); o.w = pk2(s[6 * 65], s[7 * 65]);
        *(u32x4*)(t.WT + (size_t)(t.drow0 + n) * t.ldw + t.k0 + 8 * c) = o; }
    asm volatile("s_waitcnt lgkmcnt(0)" ::: "memory");
}
constexpr int I_G = 16 * 44, I_D = 44 * 16, I_IN = 16 * 40, I_O = 12 * 16, I_LAYER = 6 * I_G + I_IN + I_O;
static_assert(I_G == I_D, "item counts");
__device__ __forceinline__ TrItem tr_decode(const Args& a, int it) {
    TrItem t; const int l = it / I_LAYER; int r = it % I_LAYER;
    unsigned char* wl = a.ws + WS_W + (size_t)l * LW_SIZE;
    if (r < 6 * I_G) {
        const int seg = r / I_G; r = r % I_G;
        const int ffn = seg / 3, kind = seg % 3;
        if (kind < 2) {
            t.W = (kind == 0 ? (ffn ? a.g2 : a.g1) : (ffn ? a.u2 : a.u1)) + (size_t)l * DM * DFF; t.gain = (ffn ? a.n2 : a.n1) + (size_t)l * DM;
            t.WT = (bf16_t*)(wl + (ffn ? LW_GU2 : LW_GU1)); t.N = DFF; t.ldw = DM;
            const int kb = r / 44, nb = r % 44; t.k0 = 64 * kb; t.n0 = 64 * nb; t.drow0 = 256 * (t.n0 / 128) + 128 * kind + (t.n0 % 128);
        } else {
            t.W = (ffn ? a.d2 : a.d1) + (size_t)l * DFF * DM; t.gain = nullptr; t.WT = (bf16_t*)(wl + (ffn ? LW_D2 : LW_D1)); t.N = DM; t.ldw = DFF;
            const int kb = r / 16, nb = r % 16; t.k0 = 64 * kb; t.n0 = 64 * nb; t.drow0 = 64 * nb;
        }
    } else if (r < 6 * I_G + I_IN) {
        r -= 6 * I_G; const int kb = r / 40, nb = r % 40;
        t.W = a.win + (size_t)l * DM * NIN; t.gain = a.nm + (size_t)l * DM; t.WT = (bf16_t*)(wl + LW_IN); t.N = NIN; t.ldw = DM; t.k0 = 64 * kb; t.n0 = 64 * nb; t.drow0 = 64 * nb;
    } else {
        r -= 6 * I_G + I_IN; const int kb = 4 + r / 16, nb = r % 16;
        t.W = a.wout + (size_t)l * DM * DM; t.gain = nullptr; t.WT = (bf16_t*)(wl + LW_OUT); t.N = DM; t.ldw = DM; t.k0 = 64 * kb; t.n0 = 64 * nb; t.drow0 = 64 * nb;
    }
    return t;
}

__device__ __forceinline__ void prologue(const Args& a, LAS unsigned char* lds, int vcu, int G) {
    const int tid = threadIdx.x, lane = tid & 63, wave = __builtin_amdgcn_readfirstlane(tid >> 6);
    LAS float* scr = (LAS float*)(lds + wave * 16640);
    const int gw = vcu * 8 + wave, NGW = G * 8;
    unsigned char* ws = a.ws;
    if (gw < DEPTH * I_LAYER) {
        TrItem cur = tr_decode(a, gw); f32x4 va[16]; tr_load(va, cur, lane);
        for (int it = gw; it < DEPTH * I_LAYER; it += NGW) {
            const bool more = it + NGW < DEPTH * I_LAYER;
            TrItem nxt = cur; f32x4 vb[16];
            if (more) { nxt = tr_decode(a, it + NGW); tr_load(vb, nxt, lane); }
            tr_finish(va, cur, scr, lane);
            if (more) {
#pragma unroll
                for (int i = 0; i < 16; ++i) va[i] = vb[i];
                cur = nxt; }
        }
    }
    for (int it = gw; it < DEPTH * 4 * 8 * 16; it += NGW) {
        const int l = it >> 9, g = (it >> 7) & 3, c8 = (it >> 4) & 7, n = (it & 15) * 64 + lane;
        const float* wo = a.wout + (size_t)l * DM * DM + (size_t)(g * 64) * DM + n;
        const float* sc = a.ps + (size_t)l * PWD + g * 64;
        const float* pr = a.pw + (((size_t)l * 4 + g) * 64 + c8 * 8) * 64;
        float acc[8] = {0.f, 0.f, 0.f, 0.f, 0.f, 0.f, 0.f, 0.f};
#pragma unroll 4
        for (int dd = 0; dd < 64; ++dd) { const float wv = wo[(size_t)dd * DM] * sc[dd];
#pragma unroll
            for (int e = 0; e < 8; ++e) acc[e] += pr[e * 64 + dd] * wv; }
        u32x4 o; o.x = pk2(acc[0], acc[1]); o.y = pk2(acc[2], acc[3]); o.z = pk2(acc[4], acc[5]); o.w = pk2(acc[6], acc[7]);
        *(u32x4*)((bf16_t*)(ws + WS_W + (size_t)l * LW_SIZE + LW_OUT) + (size_t)n * DM + g * 64 + c8 * 8) = o;
    }
    bf16_t* XB = (bf16_t*)(ws + WS_XB); float* P = (float*)(ws + WS_SSQ); float* CS = (float*)(ws + WS_ROPE);
    for (int mp = gw; mp < M; mp += 2 * NGW) {
        f32x4 v[2][4];
#pragma unroll
        for (int q = 0; q < 2; ++q) { const int m = (mp + q * NGW < M) ? mp + q * NGW : mp; const f32x4* xr = (const f32x4*)(a.x + (size_t)m * DM) + lane;
#pragma unroll
            for (int j = 0; j < 4; ++j) v[q][j] = xr[64 * j]; }
#pragma unroll
        for (int q = 0; q < 2; ++q) {
            const int m = (mp + q * NGW < M) ? mp + q * NGW : mp;
            u32x2* xb = (u32x2*)(XB + (size_t)m * DM) + lane;
            float s = 0.f;
#pragma unroll
            for (int j = 0; j < 4; ++j) { const f32x4 x4 = v[q][j]; s += (x4[0] * x4[0] + x4[1] * x4[1]) + (x4[2] * x4[2] + x4[3] * x4[3]);
                u32x2 w; w.x = pk2(x4[0], x4[1]); w.y = pk2(x4[2], x4[3]); xb[64 * j] = w; }
            s = wave_sum(s);
            if (lane < 16) P[(size_t)m * 16 + lane] = (lane == 0) ? s : 0.f;
            if (lane < 8) {
                const float ang = (float)a.pos[m] * a.inv_freq[lane];
                double rev = (double)ang * 0.15915494309189535; rev -= floor(rev);
                const float fr = (float)rev;
                CS[(size_t)m * 16 + lane] = __builtin_amdgcn_cosf(fr); CS[(size_t)m * 16 + 8 + lane] = __builtin_amdgcn_sinf(fr);
            }
        }
    }
}

__device__ __forceinline__ void combine_phase(const Args& a, int wv0, int nwv, int tok0, int ntok) {
    int tid_ = threadIdx.x; asm volatile("" : "+v"(tid_));
    const int tid = tid_, lane = tid & 63, wave = __builtin_amdgcn_readfirstlane(tid >> 6);
    const int gw = wv0 + wave, NGW = nwv;
    unsigned char* ws = a.ws;
    const float* __restrict__ ST = (const float*)(ws + WS_STAT);
    const int g = lane >> 4, hw = 1 << g;
    for (int tokp = tok0 + gw; tokp < tok0 + ntok; tokp += 2 * NGW) {
        u32x2 vv[2][16], me[2]; int cnt[2]; float mm[2][2][3], ll[2][2][3]; u32x4 ov[2][2][3];
#pragma unroll
        for (int q = 0; q < 2; ++q) {
            const int tok = (tokp + q * NGW < tok0 + ntok) ? tokp + q * NGW : tokp;
            const int bb = tok >> 11, s = tok & (SEQ - 1);
            const bf16_t* base = (const bf16_t*)(ws + off_vp(bb)) + (size_t)(tok - s) * PWD + 4 * lane;
            cnt[q] = 0;
#pragma unroll
            for (int jj = 0; jj < 16; ++jj) { const int j = s - hw + jj; const bool ok = (jj < 2 * hw) && (j >= 0) && (j < SEQ);
                vv[q][jj] = (u32x2){0u, 0u}; if (ok) vv[q][jj] = *(const u32x2*)(base + (size_t)j * PWD); cnt[q] += ok ? 1 : 0; }
            me[q] = *(const u32x2*)(base + (size_t)s * PWD);
#pragma unroll
            for (int it = 0; it < 2; ++it) {
                const int chunk = (it * 64 + lane < 96) ? it * 64 + lane : 95, h = chunk >> 3;
#pragma unroll
                for (int i = 0; i < 3; ++i) { const float* st = ST + (((size_t)i * M + tok) * NH + h) * 2; mm[q][it][i] = st[0]; ll[q][it][i] = st[1]; ov[q][it][i] = *(const u32x4*)(o_base(ws, (unsigned char*)a.out, i, bb) + (size_t)tok * AW + chunk * 8); }
            }
        }
#pragma unroll
        for (int q = 0; q < 2; ++q) {
            const int tok = (tokp + q * NGW < tok0 + ntok) ? tokp + q * NGW : tokp;
            bf16_t* MIX = (bf16_t*)(ws + off_mix(tok >> 11));
            float s0 = 0.f, s1 = 0.f, s2 = 0.f, s3 = 0.f;
#pragma unroll
            for (int jj = 0; jj < 16; ++jj) { s0 += __uint_as_float(vv[q][jj].x << 16); s1 += __uint_as_float(vv[q][jj].x & 0xffff0000u); s2 += __uint_as_float(vv[q][jj].y << 16); s3 += __uint_as_float(vv[q][jj].y & 0xffff0000u); }
            const float rc = 1.0f / (float)cnt[q];
            u32x2 w2; w2.x = pk2(s0 * rc - __uint_as_float(me[q].x << 16), s1 * rc - __uint_as_float(me[q].x & 0xffff0000u)); w2.y = pk2(s2 * rc - __uint_as_float(me[q].y << 16), s3 * rc - __uint_as_float(me[q].y & 0xffff0000u));
            *(u32x2*)(MIX + (size_t)tok * DM + 4 * lane) = w2;
#pragma unroll
            for (int it = 0; it < 2; ++it) {
                const int chunk = it * 64 + lane;
                float mxx = fmaxf(fmaxf(mm[q][it][0], mm[q][it][1]), mm[q][it][2]);
                float wgt[3], den = 0.f;
#pragma unroll
                for (int i = 0; i < 3; ++i) { wgt[i] = __builtin_amdgcn_exp2f(mm[q][it][i] - mxx) * ll[q][it][i]; den += wgt[i]; }
                const float rd = 1.0f / den;
                float acc[8] = {0.f, 0.f, 0.f, 0.f, 0.f, 0.f, 0.f, 0.f};
#pragma unroll
                for (int i = 0; i < 3; ++i) { const u32x4 v = ov[q][it][i]; const float wi = wgt[i] * rd;
                    acc[0] += wi * __uint_as_float(v.x << 16); acc[1] += wi * __uint_as_float(v.x & 0xffff0000u); acc[2] += wi * __uint_as_float(v.y << 16); acc[3] += wi * __uint_as_float(v.y & 0xffff0000u);
                    acc[4] += wi * __uint_as_float(v.z << 16); acc[5] += wi * __uint_as_float(v.z & 0xffff0000u); acc[6] += wi * __uint_as_float(v.w << 16); acc[7] += wi * __uint_as_float(v.w & 0xffff0000u); }
                u32x4 w; w.x = pk2(acc[0], acc[1]); w.y = pk2(acc[2], acc[3]); w.z = pk2(acc[4], acc[5]); w.w = pk2(acc[6], acc[7]);
                if (chunk < 96) *(u32x4*)(MIX + (size_t)tok * DM + PWD + chunk * 8) = w;
            }
        }
    }
}

__device__ __forceinline__ void final_norm(const Args& a, int wv0, int nwv, int tok0, int ntok) {
    int tid_ = threadIdx.x; asm volatile("" : "+v"(tid_));
    const int tid = tid_, lane = tid & 63, wave = __builtin_amdgcn_readfirstlane(tid >> 6);
    const int gw = wv0 + wave, NGW = nwv;
    const f32x4* gr = (const f32x4*)a.nf + lane;
    const bf16_t* XH = (const bf16_t*)(a.ws + WS_XB);
    for (int mp = tok0 + gw; mp < tok0 + ntok; mp += 2 * NGW) {
        u32x2 hh[2][4];
#pragma unroll
        for (int q = 0; q < 2; ++q) { const int m = (mp + q * NGW < tok0 + ntok) ? mp + q * NGW : mp; const u32x2* ph = (const u32x2*)(XH + (size_t)m * DM) + lane;
#pragma unroll
            for (int j = 0; j < 4; ++j) hh[q][j] = ph[64 * j]; }
        f32x4 v[2][4]; float ri[2];
#pragma unroll
        for (int q = 0; q < 2; ++q) { float s = 0.f;
#pragma unroll
            for (int j = 0; j < 4; ++j) { const u32x2 h = hh[q][j];
                v[q][j] = (f32x4){__uint_as_float(h.x << 16), __uint_as_float(h.x & 0xffff0000u), __uint_as_float(h.y << 16), __uint_as_float(h.y & 0xffff0000u)};
                s += (v[q][j][0] * v[q][j][0] + v[q][j][1] * v[q][j][1]) + (v[q][j][2] * v[q][j][2] + v[q][j][3] * v[q][j][3]); }
            ri[q] = 1.0f / sqrtf(wave_sum(s) * (1.0f / DM) + NORM_EPS); }
#pragma unroll
        for (int q = 0; q < 2; ++q) { if (q == 1 && mp + NGW >= tok0 + ntok) break; const int m = mp + q * NGW; f32x4* xr = (f32x4*)(a.out + (size_t)m * DM) + lane;
#pragma unroll
            for (int j = 0; j < 4; ++j) xr[64 * j] = v[q][j] * ri[q] * gr[64 * j]; }
    }
}

#define XB_TMO      128
#define XB_XCNT(j)  (256  + 64 * (j))
#define XB_XSUB(j)  (1280 + 64 * (j))
#define XB_XGEN(j)  (2304 + 64 * (j))
#define XB_TOP      3328
#define XB_TOPGEN   3392
#define XCD_BAR_WORDS 3456
#define XB_SPIN_CAP (1u << 18)

__device__ __forceinline__ unsigned xb_ld(unsigned* p)              { return __hip_atomic_load(p, __ATOMIC_RELAXED, __HIP_MEMORY_SCOPE_AGENT); }
__device__ __forceinline__ unsigned xb_add(unsigned* p, unsigned v) { return __hip_atomic_fetch_add(p, v, __ATOMIC_RELAXED, __HIP_MEMORY_SCOPE_AGENT); }
__device__ __forceinline__ unsigned xb_xcc_id() { return (unsigned)__builtin_amdgcn_s_getreg((3 << 11) | 20) & 0xFu; }
#define XB_SPIN(cond, bar) do { unsigned _sp = 0; while (cond) { __builtin_amdgcn_s_sleep(1); \
    if ((++_sp & 255u) == 0u) { if (xb_ld(&(bar)[XB_TMO])) break; if (_sp > XB_SPIN_CAP) { atomicAdd(&(bar)[XB_TMO], 1u); break; } } } } while (0)

struct XcdBarrier {
    unsigned* bar; unsigned x;
    volatile LAS unsigned* st;
};

__device__ __forceinline__ XcdBarrier xcd_barrier_post(unsigned* bar, volatile LAS unsigned* st) {
    XcdBarrier b; b.bar = bar; b.x = xb_xcc_id(); b.st = st;
    if (threadIdx.x == 0) (void)xb_add(&bar[XB_XCNT(b.x)], 1u);
    return b;
}
__device__ __forceinline__ void xcd_barrier_complete(unsigned* bar, unsigned x, unsigned& nloc, unsigned& nx) {
    const unsigned G = gridDim.x * gridDim.y * gridDim.z;
    unsigned sum, cnt, mine, sp = 0u;
    for (;;) {
        sum = 0u; cnt = 0u; mine = 0u;
#pragma unroll
        for (unsigned j = 0; j < 16; ++j) { const unsigned c = xb_ld(&bar[XB_XCNT(j)]); sum += c; cnt += (c > 0u) ? 1u : 0u; mine = (j == x) ? c : mine; }
        if (sum == G) break;
        __builtin_amdgcn_s_sleep(1);
        if ((++sp & 255u) == 0u) { if (xb_ld(&bar[XB_TMO])) break; if (sp > XB_SPIN_CAP) { atomicAdd(&bar[XB_TMO], 1u); break; } }
    }
    nloc = mine > 0u ? mine : 1u; nx = cnt > 0u ? cnt : 1u;
}

__device__ __forceinline__ void xcd_barrier(const XcdBarrier& b) {
    asm volatile("s_waitcnt vmcnt(0)" ::: "memory");
    __syncthreads();
    if (threadIdx.x == 0) {
        unsigned* bar = b.bar;
        __builtin_amdgcn_s_waitcnt(0);
        unsigned nloc = b.st[0], nx = b.st[1];
        if (nloc == 0u) { xcd_barrier_complete(bar, b.x, nloc, nx); b.st[0] = nloc; b.st[1] = nx; }
        const unsigned old = xb_add(&bar[XB_XSUB(b.x)], 1u);
        const unsigned gen = old / nloc;
        if (old + 1u == (gen + 1u) * nloc) {
            __builtin_amdgcn_fence(__ATOMIC_RELEASE, "agent");
            asm volatile("s_waitcnt vmcnt(0)" ::: "memory");
            const unsigned og = xb_add(&bar[XB_TOP], 1u);
            const unsigned tg = og / nx;
            if (og + 1u == (tg + 1u) * nx) xb_add(&bar[XB_TOPGEN], 1u);
            else XB_SPIN(xb_ld(&bar[XB_TOPGEN]) == tg, bar);
            __builtin_amdgcn_fence(__ATOMIC_ACQUIRE, "agent");
            xb_add(&bar[XB_XGEN(b.x)], 1u);
            asm volatile("s_waitcnt vmcnt(0)" ::: "memory");
        } else {
            XB_SPIN(xb_ld(&bar[XB_XGEN(b.x)]) == gen, bar);
            __builtin_amdgcn_fence(__ATOMIC_ACQUIRE, "agent");
            asm volatile("s_waitcnt vmcnt(0)" ::: "memory");
        }
    }
    __syncthreads();
}

#define XL_RANK(j) (3520 + 64 * (j))
#define XL_CNT(j)  (4608 + 64 * (j))
__device__ __forceinline__ unsigned l2_fetch_add(unsigned* p, unsigned v) {
    unsigned r; asm volatile("global_atomic_add %0, %1, %2, off sc0\n\ts_waitcnt vmcnt(0)" : "=&v"(r) : "v"(p), "v"(v) : "memory"); return r;
}
__device__ __forceinline__ void local_barrier(unsigned* ctl, unsigned x) {
    asm volatile("s_waitcnt vmcnt(0)" ::: "memory");
    __syncthreads();
    if (threadIdx.x == 0) {
        __builtin_amdgcn_s_waitcnt(0);
        unsigned* cw = &ctl[XL_CNT(x)];
        const unsigned old = l2_fetch_add(cw, 1u), target = (old / 32u + 1u) * 32u;
        unsigned sp = 0;
        while (l2_fetch_add(cw, 0u) < target) {
            __builtin_amdgcn_s_sleep(1);
            if ((++sp & 255u) == 0u) { if (xb_ld(&ctl[XB_TMO])) break; if (sp > XB_SPIN_CAP) { atomicAdd(&ctl[XB_TMO], 1u); break; } } }
        __builtin_amdgcn_fence(__ATOMIC_ACQUIRE, "agent");
        asm volatile("s_waitcnt vmcnt(0)" ::: "memory");
    }
    __syncthreads();
}

constexpr int LDS_BYTES = 152576;
__global__ void __launch_bounds__(512, 2) fwd(Args a) {
    extern __shared__ __attribute__((aligned(16))) unsigned char lds_raw[];
    LAS unsigned char* lds = (LAS unsigned char*)lds_raw;
    cg::grid_group grid = cg::this_grid();
    const int G = gridDim.x;
    const int vcu0 = (G % 8 == 0) ? ((int)blockIdx.x % 8) * (G / 8) + (int)blockIdx.x / 8 : (int)blockIdx.x;
    unsigned char* ws = a.ws;
    unsigned* ctl = (unsigned*)(ws + WS_CTL);
    bf16_t* XB = (bf16_t*)(ws + WS_XB); bf16_t* ACT = (bf16_t*)(ws + WS_A); float* P = (float*)(ws + WS_SSQ); float* CS = (float*)(ws + WS_ROPE);

    LAS float* RT = (LAS float*)(lds + 149760);
    volatile LAS unsigned* BST = (volatile LAS unsigned*)(lds + 149760 + 2048);
    const unsigned xcc = xb_xcc_id();
    if (threadIdx.x == 0) { BST[0] = 0u; BST[1] = 0u; BST[2] = xb_add(&ctl[XL_RANK(xcc)], 1u); BST[3] = 0u; }
    __syncthreads();
    const XcdBarrier bar = xcd_barrier_post(ctl, BST);
    if (a.never) grid.sync();
    prologue(a, lds, vcu0, G);
    xcd_barrier(bar);
    if (threadIdx.x == 0) {
        bool ok = (G == 256);
        for (unsigned j = 0; j < 16; ++j) { const unsigned cnt = xb_ld(&ctl[XB_XCNT(j)]); ok = ok && (cnt == (j < 8 ? 32u : 0u)); }
        BST[3] = (ok && xb_ld(&ctl[XB_TMO]) == 0u) ? 1u : 0u;
    }
    __syncthreads();
    const bool local = BST[3] != 0u;
    const int rank = (int)BST[2];
    const int bx = local ? rank * 8 + (int)xcc : (int)blockIdx.x;
    const int wv0 = local ? rank * 8 : vcu0 * 8, nwv = local ? 256 : G * 8, tok0 = local ? (int)xcc * SEQ : 0, ntok = local ? SEQ : M;
#define SEAM() do { if (local) local_barrier(ctl, xcc); else xcd_barrier(bar); } while (0)
    for (int st = 0; st < 3 * DEPTH; ++st) {
        const int l = st / 3, kind = st % 3;
        unsigned char* wl = ws + WS_W + (size_t)l * LW_SIZE;
        asm volatile("" : "+s"(wl));
        if (kind != 1) {
            const bf16_t* Wgu = (const bf16_t*)(wl + (kind ? LW_GU2 : LW_GU1)); const bf16_t* Wd = (const bf16_t*)(wl + (kind ? LW_D2 : LW_D1));
            { pg8::Gemm g{XB, Wgu, M, NGU, DM}; epi::RinvOrder<pg8::StaticOrder> S; S.init(M, NGU, G, bx); S.P = P; S.tab = RT;
              const int nfull = S.nwg / G; const bool split = false && (S.nwg - nfull * G) * 2 == G && (G % 16 == 0);
              if (split) S.imax = nfull;
              { epi::EpiSwiGLU<2> E{ACT, RT}; pg8::gemm_phase<epi::EpiSwiGLU<2>, epi::RinvOrder<pg8::StaticOrder>, true, true>(lds, g, S, E); }
              if (split) { epi::RinvOrder<pg8::HalfOrder> H; H.init(M, NGU, G, bx); H.nfull = nfull; H.P = P; H.tab = RT; epi::EpiSwiGLU<1> E{ACT, RT};
                pg8::gemm_phase<epi::EpiSwiGLU<1>, epi::RinvOrder<pg8::HalfOrder>, true, true, true>(lds, g, H, E); } }
            SEAM();
            { pg8::Gemm g{ACT, Wd, M, DM, DFF}; pg8::StaticOrder S; S.init(M, DM, G, bx); epi::EpiResid E{st == 0 ? a.x : nullptr, XB, P, 0.5f};
              pg8::gemm_phase<epi::EpiResid, pg8::StaticOrder, true, true>(lds, g, S, E); }
            SEAM();
        } else {
            { pg8::Gemm g{XB, (const bf16_t*)(wl + LW_IN), M, NIN, DM}; epi::RinvOrder<pg8::StaticOrder> S; S.init(M, NIN, G, bx); S.P = P; S.tab = RT; const int bb = bx & 7;
              const int nfull = S.nwg / G; const bool split = false && (S.nwg - nfull * G) * 2 == G && (G % 16 == 0);
              if (split) S.imax = nfull;
              bf16_t* vp_ = (bf16_t*)(ws + off_vp(bb)); bf16_t* q_ = (bf16_t*)(ws + off_q(bb)); bf16_t* k_ = (bf16_t*)(ws + off_k(bb)); bf16_t* v_ = (bf16_t*)(ws + off_v(bb));
              { epi::EpiProj<2> E{vp_, q_, k_, v_, RT, CS}; pg8::gemm_phase<epi::EpiProj<2>, epi::RinvOrder<pg8::StaticOrder>, true, true>(lds, g, S, E); }
              if (split) { epi::RinvOrder<pg8::HalfOrder> H; H.init(M, NIN, G, bx); H.nfull = nfull; H.P = P; H.tab = RT; epi::EpiProj<1> E{vp_, q_, k_, v_, RT, CS};
                pg8::gemm_phase<epi::EpiProj<1>, epi::RinvOrder<pg8::HalfOrder>, true, true, true>(lds, g, H, E); } }
            SEAM();
            if (local) att::phase<1>(lds, ws, (unsigned char*)a.out, (int)xcc * NH * 16 + rank, 32, ((int)xcc + 1) * NH * 16); else att::phase<1>(lds, ws, (unsigned char*)a.out, bx, G, BATCH * NH * 16);
            SEAM();
            if (local) att::phase<2>(lds, ws, (unsigned char*)a.out, (int)xcc * NH * 8 + rank, 32, ((int)xcc + 1) * NH * 8); else att::phase<2>(lds, ws, (unsigned char*)a.out, bx, G, BATCH * NH * 8);
            SEAM();
            { pg8::Gemm g{(const bf16_t*)(ws + WS_MIXN), (const bf16_t*)(wl + LW_OUT), M, DM, DM}; pg8::StaticOrder S; S.init(M, DM, G, bx); epi::EpiResid E{nullptr, XB, P, 1.0f};
              pg8::gemm_phase<epi::EpiResid, pg8::StaticOrder, true, true>(lds, g, S, E); }
            SEAM();
        }
    }
    final_norm(a, wv0, nwv, tok0, ntok);
}

extern "C" void kernel_launch(void* const* d_in, const int* in_sizes, int n_in, void* d_out, int out_size, void* d_ws, size_t ws_size, hipStream_t stream) {
    static int grid = 0;
    if (grid == 0) {
        if (n_in != 16 || in_sizes[0] != M * DM || out_size != M * DM || ws_size < WS_END) { fprintf(stderr, "kernel_launch: unexpected shapes (n_in %d in0 %d out %d ws %zu)\n", n_in, n_in > 0 ? in_sizes[0] : -1, out_size, ws_size); grid = -1; return; }
        int dev = 0, cus = 0, per_cu = 0;
        if (hipGetDevice(&dev) != hipSuccess || hipDeviceGetAttribute(&cus, hipDeviceAttributeMultiprocessorCount, dev) != hipSuccess) { grid = -1; return; }
        if (hipFuncSetAttribute((const void*)fwd, hipFuncAttributeMaxDynamicSharedMemorySize, LDS_BYTES) != hipSuccess) { fprintf(stderr, "kernel_launch: hipFuncSetAttribute failed\n"); grid = -1; return; }
        if (hipOccupancyMaxActiveBlocksPerMultiprocessor(&per_cu, (const void*)fwd, 512, LDS_BYTES) != hipSuccess || per_cu < 1) fprintf(stderr, "kernel_launch: occupancy query says %d\n", per_cu);
        (void)hipGetLastError();
        grid = cus;
    }
    if (grid < 0) return;
    if (hipMemsetAsync((char*)d_ws + WS_CTL, 0, CTL_BYTES, stream) != hipSuccess) { fprintf(stderr, "kernel_launch: memset failed\n"); return; }
    Args a{};
    a.x = (const float*)d_in[0]; a.pos = (const int*)d_in[1];
    a.n1 = (const float*)d_in[2]; a.g1 = (const float*)d_in[3]; a.u1 = (const float*)d_in[4]; a.d1 = (const float*)d_in[5];
    a.nm = (const float*)d_in[6]; a.win = (const float*)d_in[7]; a.pw = (const float*)d_in[8]; a.ps = (const float*)d_in[9]; a.wout = (const float*)d_in[10];
    a.n2 = (const float*)d_in[11]; a.g2 = (const float*)d_in[12]; a.u2 = (const float*)d_in[13]; a.d2 = (const float*)d_in[14]; a.nf = (const float*)d_in[15];
    a.out = (float*)d_out; a.ws = (unsigned char*)d_ws;
    for (int i = 0; i < 8; ++i) a.inv_freq[i] = (float)pow(500000.0, -(double)i / 8.0);
    void* args[] = {&a};
    hipError_t e = hipLaunchCooperativeKernel((const void*)fwd, dim3(grid), dim3(512), args, LDS_BYTES, stream);
    if (e != hipSuccess) fprintf(stderr, "cooperative launch failed: %s (grid %d)\n", hipGetErrorString(e), grid);
}
```
